# Optimizing an MI355X kernel written in HIP

```python
import jax, jax.numpy as jnp
from jax import lax
import numpy as np

D_MODEL = 4096
BATCH = 1
SEQ = 16384
DEPTH = 1
DEC_BATCH = 16
DEC_SEQ = 32
PAST_LEN = 4096

CHUNK = 64
HEAD_DIM = 128
N_HEADS_SB = 8
D_SB = N_HEADS_SB * HEAD_DIM
D_LRU = D_MODEL - D_SB
LRU_BLOCKS = 16
LRU_BLOCK_DIM = D_LRU // LRU_BLOCKS
LRU_CONV = 4
LRU_C = 8.0
D_MIX = D_LRU + D_SB
D_IN = 2 * D_LRU + 3 * D_SB
D_FF = 3 * D_MODEL
FFN_CONV = 3
SB_BLOCK = 128
SB_GROUP = 2048
PAD_POS = 2 ** 30
EPS = 1e-6

kernel_name = 'hymba_rglru_stickbreaking_convffn_step'


def rmsnorm(x, g):
    xf = x.astype(jnp.float32)
    y = xf * lax.rsqrt(jnp.mean(xf * xf, axis=-1, keepdims=True) + EPS)
    return (y * g.astype(jnp.float32)).astype(x.dtype)


def causal_dwconv(x, prev, w, b):
    width = w.shape[0]
    t = x.shape[1]
    xp = jnp.concatenate([prev.astype(x.dtype), x], axis=1)
    y = b + sum(xp[:, k:k + t] * w[k] for k in range(width))
    new_prev = xp[:, xp.shape[1] - (width - 1):]
    return y.astype(x.dtype), new_prev


def rg_lru(x, h0, w_a, b_a, w_x, b_x, lam):
    bsz, t, _ = x.shape
    xb = x.reshape(bsz, t, LRU_BLOCKS, LRU_BLOCK_DIM)
    r = jax.nn.sigmoid(jnp.einsum('bthi,hij->bthj', xb, w_a).reshape(bsz, t, D_LRU) + b_a)
    i = jax.nn.sigmoid(jnp.einsum('bthi,hij->bthj', xb, w_x).reshape(bsz, t, D_LRU) + b_x)
    log_a = (LRU_C * r.astype(jnp.float32)) * jax.nn.log_sigmoid(lam.astype(jnp.float32))
    a = jnp.exp(log_a)
    inp = jnp.sqrt(-jnp.expm1(2.0 * log_a)) * (i * x).astype(jnp.float32)
    inp = inp.at[:, 0].add(a[:, 0] * h0.astype(jnp.float32))

    def combine(c1, c2):
        a1, b1 = c1
        a2, b2 = c2
        return a1 * a2, a2 * b1 + b2

    _, h = lax.associative_scan(combine, (a, inp), axis=1)
    return h.astype(x.dtype), h[:, -1].astype(x.dtype)


def pad_keys(k, v, k_pos):
    n = k.shape[1]
    pad = (-n) % SB_BLOCK
    if pad == 0:
        return k, v, k_pos
    zk = jnp.zeros((k.shape[0], pad) + k.shape[2:], k.dtype)
    k = jnp.concatenate([k, zk], axis=1)
    v = jnp.concatenate([v, zk.astype(v.dtype)], axis=1)
    k_pos = jnp.concatenate([k_pos, jnp.full((pad,), PAD_POS, jnp.int32)])
    return k, v, k_pos


def sb_block(q, q_pos, k, v, k_pos):
    bsz, tq, h, _ = q.shape
    tk = k.shape[1]
    nkb = tk // SB_BLOCK
    z = jnp.einsum('bqhd,bkhd->bhqk', q, k).astype(jnp.float32) * (HEAD_DIM ** -0.5)
    mask = (k_pos[None, :] < q_pos[:, None])[None, None]
    log_1mb = jnp.where(mask, jax.nn.log_sigmoid(-z), 0.0)
    lb = log_1mb.reshape(bsz, h, tq, nkb, SB_BLOCK)
    tri_in = jnp.tri(SB_BLOCK, k=-1, dtype=jnp.float32)
    tri_out = jnp.tri(nkb, k=-1, dtype=jnp.float32)
    inner = jnp.einsum('bhqnj,js->bhqns', lb, tri_in)
    outer = jnp.einsum('bhqm,mn->bhqn', lb.sum(-1), tri_out)
    stick = (inner + outer[..., None]).reshape(bsz, h, tq, tk)
    w = jnp.where(mask, jnp.exp(z + log_1mb + stick), 0.0)
    return jnp.einsum('bhqk,bkhd->bqhd', w.astype(v.dtype), v)


def stick_breaking(q, k, v, q_pos, k_pos):
    bsz, t, h, dh = q.shape
    if t <= SB_BLOCK:
        kp, vp, pp = pad_keys(k, v, k_pos)
        return sb_block(q, q_pos, kp, vp, pp)
    past = k.shape[1] - t
    outs = []
    for start in range(0, t, SB_GROUP):
        size = min(SB_GROUP, t - start)
        end = past + start + size
        kp, vp, pp = pad_keys(k[:, :end], v[:, :end], k_pos[:end])
        nblk = size // SB_BLOCK
        qb = q[:, start:start + size].reshape(bsz, nblk, SB_BLOCK, h, dh).transpose(1, 0, 2, 3, 4)
        pb = q_pos[start:start + size].reshape(nblk, SB_BLOCK)
        out = lax.map(lambda qp: sb_block(qp[0], qp[1], kp, vp, pp), (qb, pb))
        outs.append(out.transpose(1, 0, 2, 3, 4).reshape(bsz, size, h, dh))
    return jnp.concatenate(outs, axis=1)


def layer(x, k_past, v_past, h0, conv_prev, ffn_prev, p):
    bsz, t, _ = x.shape
    past = k_past.shape[1]
    hn = rmsnorm(x, p['norm_mix_g'])
    proj = hn @ p['w_in']
    u, gate, q, k, v = jnp.split(
        proj, [D_LRU, 2 * D_LRU, 2 * D_LRU + D_SB, 2 * D_LRU + 2 * D_SB], axis=-1)
    u_conv, conv_state = causal_dwconv(u, conv_prev, p['lru_conv_w'], p['lru_conv_b'])
    h_lru, h_last = rg_lru(u_conv, h0, p['lru_w_a'], p['lru_b_a'], p['lru_w_x'],
                           p['lru_b_x'], p['lru_lambda'])
    y_lru = h_lru * jax.nn.gelu(gate)
    q = rmsnorm(q.reshape(bsz, t, N_HEADS_SB, HEAD_DIM), p['q_norm_g'])
    k = rmsnorm(k.reshape(bsz, t, N_HEADS_SB, HEAD_DIM), p['k_norm_g'])
    v = v.reshape(bsz, t, N_HEADS_SB, HEAD_DIM)
    k_all = jnp.concatenate([k_past.astype(k.dtype), k], axis=1)
    v_all = jnp.concatenate([v_past.astype(v.dtype), v], axis=1)
    q_pos = past + jnp.arange(t, dtype=jnp.int32)
    k_pos = jnp.arange(past + t, dtype=jnp.int32)
    y_sb = stick_breaking(q, k_all, v_all, q_pos, k_pos).reshape(bsz, t, D_SB)
    mix = jnp.concatenate([rmsnorm(y_lru, p['lru_out_g']), rmsnorm(y_sb, p['sb_out_g'])],
                          axis=-1) @ p['w_out']
    x = x + mix
    hn2 = rmsnorm(x, p['norm_ffn_g'])
    up = hn2 @ p['w_ffn_up']
    val, pre = jnp.split(up, [D_FF], axis=-1)
    pre_conv, ffn_state = causal_dwconv(pre, ffn_prev, p['ffn_conv_w'], p['ffn_conv_b'])
    x = x + (jax.nn.gelu(pre_conv) * val) @ p['w_ffn_down']
    return x, (k, v, h_last, conv_state, ffn_state)


def setup_inputs(seed: int = 0) -> dict:
    key = jax.random.key(seed)
    ks = jax.random.split(key, 32)
    f32 = jnp.float32
    nrm = lambda k, s, sc: jax.random.normal(k, s, f32) * sc
    u_init = jax.random.uniform(ks[14], (DEPTH, D_LRU), f32, 0.9, 0.999) ** (1.0 / LRU_C)
    return {
        'x_prompt': nrm(ks[0], (BATCH, SEQ, D_MODEL), 1.0),
        'x_sample': nrm(ks[1], (DEC_BATCH, DEC_SEQ, D_MODEL), 1.0),
        'cache_sb_k': nrm(ks[2], (DEPTH, DEC_BATCH, PAST_LEN, N_HEADS_SB, HEAD_DIM), 1.0),
        'cache_sb_v': nrm(ks[3], (DEPTH, DEC_BATCH, PAST_LEN, N_HEADS_SB, HEAD_DIM), 1.0),
        'state_lru_h': nrm(ks[4], (DEPTH, DEC_BATCH, D_LRU), 0.5),
        'state_lru_conv': nrm(ks[5], (DEPTH, DEC_BATCH, LRU_CONV - 1, D_LRU), 1.0),
        'state_ffn_conv': nrm(ks[6], (DEPTH, DEC_BATCH, FFN_CONV - 1, D_FF), 1.0),
        'norm_mix_g': 1.0 + nrm(ks[7], (DEPTH, D_MODEL), 0.01),
        'w_in': nrm(ks[8], (DEPTH, D_MODEL, D_IN), D_MODEL ** -0.5),
        'lru_conv_w': nrm(ks[9], (DEPTH, LRU_CONV, D_LRU), LRU_CONV ** -0.5),
        'lru_conv_b': nrm(ks[10], (DEPTH, D_LRU), 0.01),
        'lru_w_a': nrm(ks[11], (DEPTH, LRU_BLOCKS, LRU_BLOCK_DIM, LRU_BLOCK_DIM), LRU_BLOCK_DIM ** -0.5),
        'lru_b_a': nrm(ks[12], (DEPTH, D_LRU), 0.01),
        'lru_w_x': nrm(ks[13], (DEPTH, LRU_BLOCKS, LRU_BLOCK_DIM, LRU_BLOCK_DIM), LRU_BLOCK_DIM ** -0.5),
        'lru_b_x': nrm(ks[15], (DEPTH, D_LRU), 0.01),
        'lru_lambda': jnp.log(u_init) - jnp.log1p(-u_init),
        'q_norm_g': 1.0 + nrm(ks[16], (DEPTH, HEAD_DIM), 0.01),
        'k_norm_g': 1.0 + nrm(ks[17], (DEPTH, HEAD_DIM), 0.01),
        'lru_out_g': 1.0 + nrm(ks[18], (DEPTH, D_LRU), 0.01),
        'sb_out_g': 1.0 + nrm(ks[19], (DEPTH, D_SB), 0.01),
        'w_out': nrm(ks[20], (DEPTH, D_MIX, D_MODEL), D_MIX ** -0.5),
        'norm_ffn_g': 1.0 + nrm(ks[21], (DEPTH, D_MODEL), 0.01),
        'w_ffn_up': nrm(ks[22], (DEPTH, D_MODEL, 2 * D_FF), D_MODEL ** -0.5),
        'ffn_conv_w': nrm(ks[23], (DEPTH, FFN_CONV, D_FF), FFN_CONV ** -0.5),
        'ffn_conv_b': nrm(ks[24], (DEPTH, D_FF), 0.01),
        'w_ffn_down': nrm(ks[25], (DEPTH, D_FF, D_MODEL), D_FF ** -0.5),
    }


def reference(x_prompt, x_sample, cache_sb_k, cache_sb_v, state_lru_h, state_lru_conv,
              state_ffn_conv, norm_mix_g, w_in, lru_conv_w, lru_conv_b, lru_w_a, lru_b_a,
              lru_w_x, lru_b_x, lru_lambda, q_norm_g, k_norm_g, lru_out_g, sb_out_g, w_out,
              norm_ffn_g, w_ffn_up, ffn_conv_w, ffn_conv_b, w_ffn_down):
    bp = x_prompt.shape[0]
    dt = x_prompt.dtype
    xp, xs = x_prompt, x_sample
    st_p, st_s = [], []
    for l in range(DEPTH):
        p = {
            'norm_mix_g': norm_mix_g[l], 'w_in': w_in[l],
            'lru_conv_w': lru_conv_w[l], 'lru_conv_b': lru_conv_b[l],
            'lru_w_a': lru_w_a[l], 'lru_b_a': lru_b_a[l],
            'lru_w_x': lru_w_x[l], 'lru_b_x': lru_b_x[l], 'lru_lambda': lru_lambda[l],
            'q_norm_g': q_norm_g[l], 'k_norm_g': k_norm_g[l],
            'lru_out_g': lru_out_g[l], 'sb_out_g': sb_out_g[l], 'w_out': w_out[l],
            'norm_ffn_g': norm_ffn_g[l], 'w_ffn_up': w_ffn_up[l],
            'ffn_conv_w': ffn_conv_w[l], 'ffn_conv_b': ffn_conv_b[l],
            'w_ffn_down': w_ffn_down[l],
        }
        empty_kv = jnp.zeros((bp, 0, N_HEADS_SB, HEAD_DIM), dt)
        xp, sp = layer(xp, empty_kv, empty_kv,
                       jnp.zeros((bp, D_LRU), dt),
                       jnp.zeros((bp, LRU_CONV - 1, D_LRU), dt),
                       jnp.zeros((bp, FFN_CONV - 1, D_FF), dt), p)
        st_p.append(sp)
        xs, ss = layer(xs, cache_sb_k[l], cache_sb_v[l], state_lru_h[l], state_lru_conv[l],
                       state_ffn_conv[l], p)
        st_s.append(ss)
    new_sb_k_prompt = jnp.stack([s[0] for s in st_p])
    new_sb_v_prompt = jnp.stack([s[1] for s in st_p])
    new_lru_h_prompt = jnp.stack([s[2] for s in st_p])
    new_lru_conv_prompt = jnp.stack([s[3] for s in st_p])
    new_ffn_conv_prompt = jnp.stack([s[4] for s in st_p])
    new_sb_k_sample = jnp.stack([s[0] for s in st_s])
    new_sb_v_sample = jnp.stack([s[1] for s in st_s])
    new_lru_h_sample = jnp.stack([s[2] for s in st_s])
    new_lru_conv_sample = jnp.stack([s[3] for s in st_s])
    new_ffn_conv_sample = jnp.stack([s[4] for s in st_s])
    return (xp, xs, new_sb_k_prompt, new_sb_v_prompt, new_lru_h_prompt, new_lru_conv_prompt,
            new_ffn_conv_prompt, new_sb_k_sample, new_sb_v_sample, new_lru_h_sample,
            new_lru_conv_sample, new_ffn_conv_sample)
```

```cpp
#include <hip/hip_runtime.h>
#include <cstdio>
#include <cstdint>
#define MK_PER_PHASE 0
namespace pg8 {
#define PG8_LAS __attribute__((address_space(3)))
typedef unsigned short bf16_t;
typedef short bf16x8 __attribute__((ext_vector_type(8)));
typedef float f32x4 __attribute__((ext_vector_type(4)));
typedef unsigned u32x4 __attribute__((ext_vector_type(4)));
constexpr int BM = 256, BK = 64, HALF = 128, HTB = HALF * BK * 2  , STAGE_BYTES = 8 * HTB, NXCD = 8, WGM = 8;

__host__ __device__ __forceinline__ int lds_byte(int r, int c) { const int st = (r >> 4) * 2 + (c >> 5), rr = r & 15, cc = c & 31, ob = rr * 64 + cc * 2; return st * 1024 + (ob ^ (((ob >> 9) & 1) << 5)); }
__host__ __device__ __forceinline__ void stage_rc(int b, int& R, int& C) { const int st = b / 1024, sb = b % 1024, swz = sb ^ (((sb >> 9) & 1) << 5); R = (st >> 1) * 16 + swz / 64; C = (st & 1) * 32 + (swz % 64) / 2; }
__host__ __device__ __forceinline__ int perm32(int rho) { const int n = rho >> 4, i = rho & 15; return 8 * (i >> 2) + 4 * n + (i & 3); }

struct Unit { int pm, pn; };
struct Gemm { const bf16_t* A; const bf16_t* Bt; int M, N, K; };

struct StaticOrder {
    int nM, nN, nwg, G, c;
    __host__ __device__ void init(int M, int N, int G_, int c_) { nM = M / BM; nN = N / BM; nwg = nM * nN; G = G_; c = c_; }
    __host__ __device__ bool next(int i, Unit& u) const {
        const long L = (long)i * G + c; if (L >= nwg) return false;
        int wgid = (int)L; { const int q = nwg / NXCD, r = nwg % NXCD, xcd = wgid % NXCD, off = wgid / NXCD; wgid = (xcd < r ? xcd * (q + 1) : r * (q + 1) + (xcd - r) * q) + off; }
        const int nig = WGM * nN, gid = wgid / nig, fm = gid * WGM, gsz = (nM - fm) < WGM ? (nM - fm) : WGM;
        u.pm = fm + ((wgid % nig) % gsz); u.pn = (wgid % nig) / gsz; return true;
    }
    __device__ __forceinline__ void a_ready(const Unit&) const {}
    __device__ __forceinline__ void done(const Unit&) const {}
};

__device__ __forceinline__ unsigned cvt_pk_bf16(float lo, float hi) { unsigned r; asm volatile("v_cvt_pk_bf16_f32 %0, %1, %2" : "=v"(r) : "v"(lo), "v"(hi)); return r; }
typedef float f32x2 __attribute__((ext_vector_type(2)));
template <class Epi, class Sched, bool ALIGN_EPI = false, bool SP2 = false>
__device__ __forceinline__ void gemm_phase(PG8_LAS unsigned char* lds, const Gemm g, const Sched& S, const Epi& E) {
    const int tid = threadIdx.x, wid = __builtin_amdgcn_readfirstlane(tid >> 6), lane = tid & 63, wr = wid >> 2, wc = wid & 3, fr = lane & 15, fq = lane >> 4;
    const int K = g.K, nt = K / BK;
    unsigned voffA[2], voffB[2];
#pragma unroll
    for (int i = 0; i < 2; ++i) { int R, C; stage_rc(tid * 16 + i * 8192, R, C); const int Rb = Epi::PERM ? ((R & ~31) + perm32(R & 31)) : R;
        voffA[i] = (unsigned)(R * K + C) * 2u; voffB[i] = (unsigned)(Rb * K + C) * 2u; }
    const size_t kstep = (size_t)(BK * 2);
    const size_t hstep = (size_t)HALF * K * 2;
    const size_t tstep = 2 * hstep;
    const unsigned ldsw = (unsigned)wid * 1024u;
    const int aoff = lds_byte(wr * 64 + fr, fq * 8), boff = lds_byte(wc * 32 + fr, fq * 8);
#define PG8_SA(b, h) (((b) * 2 + (h)) * HTB)
#define PG8_SB(b, h) ((4 + (b) * 2 + (h)) * HTB)
#define PG8_STAGE(bufoff, gbase, voff) do { _Pragma("unroll") for (int _i = 0; _i < 2; ++_i) \
        __builtin_amdgcn_global_load_lds((const unsigned*)((const char*)(gbase) + (voff)[_i]), (PG8_LAS unsigned*)(lds + (bufoff) + ldsw + _i * 8192), 16, 0, 0); } while (0)
#define PG8_LDA(dst, b, h) do { _Pragma("unroll") for (int m = 0; m < 4; ++m) _Pragma("unroll") for (int k = 0; k < 2; ++k) dst[m][k] = *(const PG8_LAS bf16x8*)(lds + PG8_SA(b, h) + aoff + m * 2048 + k * 1024); } while (0)
#define PG8_LDB(dst, b, h) do { _Pragma("unroll") for (int n = 0; n < 2; ++n) _Pragma("unroll") for (int k = 0; k < 2; ++k) dst[n][k] = *(const PG8_LAS bf16x8*)(lds + PG8_SB(b, h) + boff + n * 2048 + k * 1024); } while (0)
#define PG8_MMA(ai, bj, At, Bt) do { __builtin_amdgcn_s_setprio(1); _Pragma("unroll") for (int m = 0; m < 4; ++m) _Pragma("unroll") for (int n = 0; n < 2; ++n) _Pragma("unroll") for (int k = 0; k < 2; ++k) \
        acc[ai][bj][m][n] = __builtin_amdgcn_mfma_f32_16x16x32_bf16(Bt[n][k], At[m][k], acc[ai][bj][m][n], 0, 0, 0); __builtin_amdgcn_s_setprio(0); } while (0)
#define PG8_WAIT_V(n) asm volatile("s_waitcnt vmcnt(" #n ")" ::: "memory")
#define PG8_WAIT_L(n) asm volatile("s_waitcnt lgkmcnt(" #n ")" ::: "memory")
#define PG8_BAR __builtin_amdgcn_s_barrier()
#define PG8_SCHED __builtin_amdgcn_sched_barrier(0)
    Unit cur, nxt; int ui = 0;
    if (!S.next(0, cur)) return;
    f32x4 acc[2][2][4][2];
#pragma unroll
    for (int a = 0; a < 2; ++a)
#pragma unroll
        for (int b = 0; b < 2; ++b)
#pragma unroll
            for (int m = 0; m < 4; ++m)
#pragma unroll
                for (int n = 0; n < 2; ++n) acc[a][b][m][n] = (f32x4){0.f, 0.f, 0.f, 0.f};
    bf16x8 At[4][2], B0[2][2], B1[2][2];
    const char* cA = (const char*)g.A + (size_t)cur.pm * tstep; const char* cB = (const char*)g.Bt + (size_t)cur.pn * tstep;
    S.a_ready(cur);
    if constexpr (SP2) {
        PG8_STAGE(PG8_SB(0, 0), cB, voffB); PG8_STAGE(PG8_SB(0, 1), cB + hstep, voffB); PG8_STAGE(PG8_SA(0, 0), cA, voffA); PG8_STAGE(PG8_SA(0, 1), cA + hstep, voffA);
        if (wr == 1) PG8_BAR;
        PG8_WAIT_V(2); PG8_BAR;
        PG8_STAGE(PG8_SB(1, 0), cB + kstep, voffB); PG8_STAGE(PG8_SA(1, 0), cA + kstep, voffA); PG8_STAGE(PG8_SB(1, 1), cB + hstep + kstep, voffB);
        PG8_WAIT_V(6); PG8_BAR;
    } else {
        PG8_STAGE(PG8_SB(0, 0), cB, voffB); PG8_STAGE(PG8_SA(0, 0), cA, voffA); PG8_STAGE(PG8_SB(0, 1), cB + hstep, voffB); PG8_STAGE(PG8_SA(0, 1), cA + hstep, voffA);
        if (wr == 1) PG8_BAR;
        PG8_WAIT_V(4); PG8_BAR;
        PG8_STAGE(PG8_SB(1, 0), cB + kstep, voffB); PG8_STAGE(PG8_SA(1, 0), cA + kstep, voffA); PG8_STAGE(PG8_SB(1, 1), cB + hstep + kstep, voffB);
        PG8_WAIT_V(6); PG8_BAR;
    }
    for (;;) {
        const bool has_next = S.next(ui + 1, nxt);
        const char* nA = has_next ? (const char*)g.A + (size_t)nxt.pm * tstep : cA; const char* nB = has_next ? (const char*)g.Bt + (size_t)nxt.pn * tstep : cB;
        for (int t = 0; t < nt; t += 2) {
            const bool last = (t == nt - 2);
            const char* a1 = cA + (size_t)(t + 1) * kstep;
            const char* a2 = last ? nA : cA + (size_t)(t + 2) * kstep; const char* b2 = last ? nB : cB + (size_t)(t + 2) * kstep;
            const char* a3 = a2 + kstep; const char* b3 = b2 + kstep;
            if (last && has_next) S.a_ready(nxt);
            if constexpr (SP2) {
            PG8_LDB(B0, 0, 0); PG8_LDB(B1, 0, 1); PG8_SCHED; PG8_LDA(At, 0, 0); PG8_STAGE(PG8_SA(1, 1), a1 + hstep, voffA);
            PG8_WAIT_V(8); PG8_WAIT_L(0); PG8_BAR; PG8_MMA(0, 0, At, B0); PG8_MMA(0, 1, At, B1); PG8_BAR; PG8_SCHED;
            PG8_LDA(At, 0, 1); PG8_STAGE(PG8_SB(0, 0), b2, voffB); PG8_STAGE(PG8_SB(0, 1), b2 + hstep, voffB); PG8_STAGE(PG8_SA(0, 0), a2, voffA);
            PG8_WAIT_V(8); PG8_WAIT_L(0); PG8_BAR; PG8_MMA(1, 0, At, B0); PG8_MMA(1, 1, At, B1); PG8_BAR; PG8_SCHED;
            PG8_LDB(B0, 1, 0); PG8_LDB(B1, 1, 1); PG8_SCHED; PG8_LDA(At, 1, 0); PG8_STAGE(PG8_SA(0, 1), a2 + hstep, voffA);
            PG8_WAIT_V(8); PG8_WAIT_L(0); PG8_BAR; PG8_MMA(0, 0, At, B0); PG8_MMA(0, 1, At, B1); PG8_BAR; PG8_SCHED;
            PG8_LDA(At, 1, 1); PG8_STAGE(PG8_SB(1, 0), b3, voffB); PG8_STAGE(PG8_SB(1, 1), b3 + hstep, voffB); PG8_STAGE(PG8_SA(1, 0), a3, voffA);
            PG8_WAIT_V(8); PG8_WAIT_L(0); PG8_BAR; PG8_MMA(1, 0, At, B0); PG8_MMA(1, 1, At, B1); PG8_BAR; PG8_SCHED;
            } else {
            PG8_LDB(B0, 0, 0); PG8_SCHED; PG8_LDA(At, 0, 0); PG8_STAGE(PG8_SA(1, 1), a1 + hstep, voffA);
            PG8_WAIT_L(8); PG8_BAR; PG8_WAIT_L(0); PG8_MMA(0, 0, At, B0); PG8_BAR; PG8_SCHED;
            PG8_LDB(B1, 0, 1); PG8_STAGE(PG8_SB(0, 0), b2, voffB);
            PG8_BAR; PG8_WAIT_L(0); PG8_MMA(0, 1, At, B1); PG8_BAR;
            PG8_LDA(At, 0, 1); PG8_STAGE(PG8_SA(0, 0), a2, voffA);
            PG8_BAR; PG8_WAIT_L(0); PG8_MMA(1, 0, At, B0); PG8_BAR; PG8_SCHED;
            PG8_STAGE(PG8_SB(0, 1), b2 + hstep, voffB);
            PG8_WAIT_V(6); PG8_BAR; PG8_MMA(1, 1, At, B1); PG8_BAR;
            PG8_LDB(B0, 1, 0); PG8_SCHED; PG8_LDA(At, 1, 0); PG8_STAGE(PG8_SA(0, 1), a2 + hstep, voffA);
            PG8_WAIT_L(8); PG8_BAR; PG8_WAIT_L(0); PG8_MMA(0, 0, At, B0); PG8_BAR; PG8_SCHED;
            PG8_LDB(B1, 1, 1); PG8_STAGE(PG8_SB(1, 0), b3, voffB);
            PG8_BAR; PG8_WAIT_L(0); PG8_MMA(0, 1, At, B1); PG8_BAR;
            PG8_LDA(At, 1, 1); PG8_STAGE(PG8_SA(1, 0), a3, voffA);
            PG8_BAR; PG8_WAIT_L(0); PG8_MMA(1, 0, At, B0); PG8_BAR; PG8_SCHED;
            PG8_STAGE(PG8_SB(1, 1), b3 + hstep, voffB);
            PG8_WAIT_V(6); PG8_BAR; PG8_MMA(1, 1, At, B1); PG8_BAR;
            }
        }
        if constexpr (ALIGN_EPI) { if (wr == 0) PG8_BAR; }
        if constexpr (!Epi::AFTER_DRAIN) { E(acc, cur, wr, wc, fr, fq); S.done(cur); }
        if (!has_next) break;
#pragma unroll
        for (int a = 0; a < 2; ++a)
#pragma unroll
            for (int b = 0; b < 2; ++b)
#pragma unroll
                for (int m = 0; m < 4; ++m)
#pragma unroll
                    for (int n = 0; n < 2; ++n) acc[a][b][m][n] = (f32x4){0.f, 0.f, 0.f, 0.f};
        cur = nxt; cA = nA; cB = nB; ++ui;
        if constexpr (ALIGN_EPI) { if (wr == 1) PG8_BAR; }
    }
    PG8_WAIT_V(0);
    if constexpr (!ALIGN_EPI) { if (wr == 0) PG8_BAR; }
    PG8_BAR;
    if constexpr (Epi::AFTER_DRAIN) { E.fused(acc, cur, wr, wc, fr, fq, lds, wid, lane); S.done(cur); }
#undef PG8_SA
#undef PG8_SB
#undef PG8_STAGE
#undef PG8_LDA
#undef PG8_LDB
#undef PG8_MMA
#undef PG8_WAIT_V
#undef PG8_WAIT_L
#undef PG8_BAR
#undef PG8_SCHED
}
}

constexpr int DM = 4096, SEQ = 16384, DBATCH = 16, DSEQ = 32, PAST = 4096, HD = 128, NH = 8, DSB = 1024, DLRU = 3072, NBLK = 16, BD = 192, DIN = 9216, DFF = 12288;
constexpr int MP = SEQ, MS = DBATCH * DSEQ, M = MP + MS;
constexpr float EPS = 1e-6f;
constexpr int NWAVES = 8;
#ifndef MK_PER_PHASE
#define MK_PER_PHASE 0
#endif
#ifndef MK_GRID
#define MK_GRID 0
#endif

constexpr size_t O_Y = 0, O_KP = (size_t)M * DM, O_VP = O_KP + (size_t)MP * DSB, O_HP = O_VP + (size_t)MP * DSB, O_CP = O_HP + DLRU, O_FP = O_CP + 3 * DLRU,
                 O_KS = O_FP + 2 * DFF, O_VS = O_KS + (size_t)MS * DSB, O_HS = O_VS + (size_t)MS * DSB, O_CS = O_HS + (size_t)DBATCH * DLRU, O_FS = O_CS + (size_t)DBATCH * 3 * DLRU,
                 O_END = O_FS + (size_t)DBATCH * 2 * DFF;
static_assert(O_END == 104435712, "d_out size");

constexpr size_t MiB = 1u << 20;
constexpr size_t WS_CTL = 0, CTL_ZERO_BYTES = 1 * MiB;
constexpr size_t WS_WA = 1 * MiB, WS_WX = WS_WA + (size_t)NBLK * BD * BD * 2;
constexpr size_t WS_AGGA = 4 * MiB, WS_AGGB = 7 * MiB;
constexpr size_t WS_SSQL = 10 * MiB, WS_SSQS = 11 * MiB;
constexpr size_t WS_WDOWN = 16 * MiB, WS_WUP = 112 * MiB, WS_BUFA = 304 * MiB, WS_ACT = 436 * MiB, WS_VALPRE = 832 * MiB, WS_END = 1228 * MiB;
constexpr size_t WS_WIN = 436 * MiB, WS_WOUT = 508 * MiB, WS_U = 540 * MiB, WS_G = 639 * MiB, WS_QN = 738 * MiB, WS_KN = 771 * MiB, WS_VB = 804 * MiB, WS_Y = 837 * MiB;
static_assert(WS_WX + (size_t)NBLK * BD * BD * 2 <= WS_AGGA && WS_SSQS + (size_t)M * 8 * 4 <= WS_WDOWN, "ws map (small)");
static_assert(WS_WDOWN + (size_t)DM * DFF * 2 <= WS_WUP && WS_WUP + (size_t)2 * DFF * DM * 2 <= WS_BUFA && WS_BUFA + (size_t)M * DM * 2 <= WS_ACT, "ws map (weights)");
static_assert(WS_ACT + (size_t)M * DFF * 2 <= WS_VALPRE && WS_VALPRE + (size_t)M * DFF * 2 <= WS_END, "ws map (ffn)");
static_assert(WS_WIN + (size_t)DIN * DM * 2 <= WS_WOUT && WS_WOUT + (size_t)DM * DM * 2 <= WS_U && WS_U + (size_t)M * DLRU * 2 <= WS_G && WS_G + (size_t)M * DLRU * 2 <= WS_QN, "ws map (early 1)");
static_assert(WS_QN + (size_t)M * DSB * 2 <= WS_KN && WS_KN + (size_t)M * DSB * 2 <= WS_VB && WS_VB + (size_t)M * DSB * 2 <= WS_Y && WS_Y + (size_t)M * DM * 2 <= WS_END, "ws map (early 2)");
constexpr int CW_TMO = 0, CW_CODE = 1, CW_BAR = 4096;

constexpr int RING_OFF = 0, RING_BYTES = 131072;
constexpr int EPI_OFF = RING_BYTES, EPI_BYTES = 8192;
constexpr int LDSCTL_OFF = EPI_OFF + EPI_BYTES, MISC_OFF = LDSCTL_OFF + 320;
constexpr int LDS_BYTES = 147456;
static_assert(MISC_OFF + 128 <= LDS_BYTES, "LDS map");

#define GAS __attribute__((address_space(1)))
#define LAS __attribute__((address_space(3)))
typedef unsigned short bf16;
typedef unsigned v4u __attribute__((ext_vector_type(4)));
typedef unsigned v2u __attribute__((ext_vector_type(2)));
typedef float f32x4 __attribute__((ext_vector_type(4)));
typedef short bf16x8 __attribute__((ext_vector_type(8)));
typedef GAS unsigned gu32;
#define RLX_AGENT __ATOMIC_RELAXED, __HIP_MEMORY_SCOPE_AGENT
#define LDS_WAIT() asm volatile("s_waitcnt lgkmcnt(0)" ::: "memory")
#define VM_WAIT() asm volatile("s_waitcnt vmcnt(0)" ::: "memory")
#define WG_BAR() do { asm volatile("s_waitcnt lgkmcnt(0)" ::: "memory"); __builtin_amdgcn_s_barrier(); asm volatile("" ::: "memory"); } while (0)
using pg8::cvt_pk_bf16;
__device__ __forceinline__ float bflo(unsigned w) { return __builtin_bit_cast(float, w << 16); }
__device__ __forceinline__ float bfhi(unsigned w) { return __builtin_bit_cast(float, w & 0xffff0000u); }
__device__ __forceinline__ float fexp2(float x) { return __builtin_amdgcn_exp2f(x); }
__device__ __forceinline__ float flog2(float x) { return __builtin_amdgcn_logf(x); }
__device__ __forceinline__ float frcp(float x) { return __builtin_amdgcn_rcpf(x); }
__device__ __forceinline__ float sigmoidf_(float x) { return frcp(1.0f + fexp2(-1.4426950408889634f * x)); }
__device__ __forceinline__ float gelu_tanh(float x) { const float u = x * (1.0f + 0.044715f * x * x); return x * frcp(1.0f + fexp2(-2.302208198f * u)); }
__device__ __forceinline__ float wave_sum(float v) {
#pragma unroll
    for (int o = 1; o < 64; o <<= 1) v += __shfl_xor(v, o);
    return v;
}
template <int S> __device__ __forceinline__ float dpp_shr(float oldv, float v) {
    return __builtin_bit_cast(float, __builtin_amdgcn_update_dpp(__builtin_bit_cast(int, oldv), __builtin_bit_cast(int, v), 0x110 + S, 0xF, 0xF, false));
}
__device__ __forceinline__ void row_scan_ab(float& a, float& b) {
    { const float ap = dpp_shr<1>(1.0f, a), bp = dpp_shr<1>(0.0f, b); b = a * bp + b; a = a * ap; }
    { const float ap = dpp_shr<2>(1.0f, a), bp = dpp_shr<2>(0.0f, b); b = a * bp + b; a = a * ap; }
    { const float ap = dpp_shr<4>(1.0f, a), bp = dpp_shr<4>(0.0f, b); b = a * bp + b; a = a * ap; }
    { const float ap = dpp_shr<8>(1.0f, a), bp = dpp_shr<8>(0.0f, b); b = a * bp + b; a = a * ap; }
}

#define XB_TMO      128
#define XB_XCNT(j)  (256  + 64 * (j))
#define XB_XSUB(j)  (1280 + 64 * (j))
#define XB_XGEN(j)  (2304 + 64 * (j))
#define XB_TOP      3328
#define XB_TOPGEN   3392
#define XCD_BAR_WORDS 3456
#define XB_SPIN_CAP (1u << 18)

__device__ __forceinline__ unsigned xb_ld(unsigned* p)              { return __hip_atomic_load(p, __ATOMIC_RELAXED, __HIP_MEMORY_SCOPE_AGENT); }
__device__ __forceinline__ unsigned xb_add(unsigned* p, unsigned v) { return __hip_atomic_fetch_add(p, v, __ATOMIC_RELAXED, __HIP_MEMORY_SCOPE_AGENT); }
__device__ __forceinline__ unsigned xb_xcc_id() { return (unsigned)__builtin_amdgcn_s_getreg((3 << 11) | 20) & 0xFu; }
#define XB_SPIN(cond, bar) do { unsigned _sp = 0; while (cond) { __builtin_amdgcn_s_sleep(1); \
    if ((++_sp & 255u) == 0u) { if (xb_ld(&(bar)[XB_TMO])) break; if (_sp > XB_SPIN_CAP) { atomicAdd(&(bar)[XB_TMO], 1u); break; } } } } while (0)

struct XcdBarrier {
    unsigned* bar; unsigned x;
    volatile LAS unsigned* st;
};

__device__ __forceinline__ XcdBarrier xcd_barrier_post(unsigned* bar, volatile LAS unsigned* st) {
    XcdBarrier b; b.bar = bar; b.x = xb_xcc_id(); b.st = st;
    if (threadIdx.x == 0) (void)xb_add(&bar[XB_XCNT(b.x)], 1u);
    return b;
}
__device__ __forceinline__ void xcd_barrier_complete(unsigned* bar, unsigned x, unsigned& nloc, unsigned& nx) {
    const unsigned G = gridDim.x * gridDim.y * gridDim.z;
    unsigned sum, cnt, mine, sp = 0u;
    for (;;) {
        sum = 0u; cnt = 0u; mine = 0u;
#pragma unroll
        for (unsigned j = 0; j < 16; ++j) { const unsigned c = xb_ld(&bar[XB_XCNT(j)]); sum += c; cnt += (c > 0u) ? 1u : 0u; mine = (j == x) ? c : mine; }
        if (sum == G) break;
        __builtin_amdgcn_s_sleep(1);
        if ((++sp & 255u) == 0u) { if (xb_ld(&bar[XB_TMO])) break; if (sp > XB_SPIN_CAP) { atomicAdd(&bar[XB_TMO], 1u); break; } }
    }
    nloc = mine > 0u ? mine : 1u; nx = cnt > 0u ? cnt : 1u;
}

__device__ __forceinline__ void xcd_barrier(const XcdBarrier& b) {
    asm volatile("s_waitcnt vmcnt(0)" ::: "memory");
    __syncthreads();
    if (threadIdx.x == 0) {
        unsigned* bar = b.bar;
        __builtin_amdgcn_s_waitcnt(0);
        unsigned nloc = b.st[0], nx = b.st[1];
        if (nloc == 0u) { xcd_barrier_complete(bar, b.x, nloc, nx); b.st[0] = nloc; b.st[1] = nx; }
        const unsigned old = xb_add(&bar[XB_XSUB(b.x)], 1u);
        const unsigned gen = old / nloc;
        if (old + 1u == (gen + 1u) * nloc) {
            __builtin_amdgcn_fence(__ATOMIC_RELEASE, "agent");
            asm volatile("s_waitcnt vmcnt(0)" ::: "memory");
            const unsigned og = xb_add(&bar[XB_TOP], 1u);
            const unsigned tg = og / nx;
            if (og + 1u == (tg + 1u) * nx) xb_add(&bar[XB_TOPGEN], 1u);
            else XB_SPIN(xb_ld(&bar[XB_TOPGEN]) == tg, bar);
            __builtin_amdgcn_fence(__ATOMIC_ACQUIRE, "agent");
            xb_add(&bar[XB_XGEN(b.x)], 1u);
            asm volatile("s_waitcnt vmcnt(0)" ::: "memory");
        } else {
            XB_SPIN(xb_ld(&bar[XB_XGEN(b.x)]) == gen, bar);
            __builtin_amdgcn_fence(__ATOMIC_ACQUIRE, "agent");
            asm volatile("s_waitcnt vmcnt(0)" ::: "memory");
        }
    }
    __syncthreads();
}

struct Args { const float* in[26]; float* out; unsigned char* ws; int ph_lo, ph_hi, li, pad; };
struct Frame {
    LAS unsigned char* lds;
    volatile LAS unsigned* MISC;
    gu32* ctl;
    int tid, lane, wave, vcu, G;
    const Args* a;
    __device__ __forceinline__ const float* x_p() const { return a->in[0]; }
    __device__ __forceinline__ const float* x_s() const { return a->in[1]; }
    __device__ __forceinline__ const float* cache_k() const { return a->in[2]; }
    __device__ __forceinline__ const float* cache_v() const { return a->in[3]; }
    __device__ __forceinline__ const float* st_h() const { return a->in[4]; }
    __device__ __forceinline__ const float* st_conv() const { return a->in[5]; }
    __device__ __forceinline__ const float* st_ffn() const { return a->in[6]; }
    __device__ __forceinline__ const float* g_mix() const { return a->in[7]; }
    __device__ __forceinline__ const float* w_in() const { return a->in[8]; }
    __device__ __forceinline__ const float* cw() const { return a->in[9]; }
    __device__ __forceinline__ const float* cb() const { return a->in[10]; }
    __device__ __forceinline__ const float* w_a() const { return a->in[11]; }
    __device__ __forceinline__ const float* b_a() const { return a->in[12]; }
    __device__ __forceinline__ const float* w_x() const { return a->in[13]; }
    __device__ __forceinline__ const float* b_x() const { return a->in[14]; }
    __device__ __forceinline__ const float* lam() const { return a->in[15]; }
    __device__ __forceinline__ const float* qg() const { return a->in[16]; }
    __device__ __forceinline__ const float* kg() const { return a->in[17]; }
    __device__ __forceinline__ const float* g_lru() const { return a->in[18]; }
    __device__ __forceinline__ const float* g_sb() const { return a->in[19]; }
    __device__ __forceinline__ const float* w_out() const { return a->in[20]; }
    __device__ __forceinline__ const float* g_ffn() const { return a->in[21]; }
    __device__ __forceinline__ const float* w_up() const { return a->in[22]; }
    __device__ __forceinline__ const float* fcw() const { return a->in[23]; }
    __device__ __forceinline__ const float* fcb() const { return a->in[24]; }
    __device__ __forceinline__ const float* w_down() const { return a->in[25]; }
    __device__ __forceinline__ float* out() const { return a->out; }
    __device__ __forceinline__ bf16* Wa_t() const { return (bf16*)(a->ws + WS_WA); }
    __device__ __forceinline__ bf16* Wx_t() const { return (bf16*)(a->ws + WS_WX); }
    __device__ __forceinline__ bf16* Win_t() const { return (bf16*)(a->ws + WS_WIN); }
    __device__ __forceinline__ bf16* Wout_t() const { return (bf16*)(a->ws + WS_WOUT); }
    __device__ __forceinline__ bf16* Wup_t() const { return (bf16*)(a->ws + WS_WUP); }
    __device__ __forceinline__ bf16* Wdown_t() const { return (bf16*)(a->ws + WS_WDOWN); }
    __device__ __forceinline__ bf16* BUFA() const { return (bf16*)(a->ws + WS_BUFA); }
    __device__ __forceinline__ bf16* ACT() const { return (bf16*)(a->ws + WS_ACT); }
    __device__ __forceinline__ bf16* VALPRE() const { return (bf16*)(a->ws + WS_VALPRE); }
    __device__ __forceinline__ bf16* U() const { return (bf16*)(a->ws + WS_U); }
    __device__ __forceinline__ bf16* Gt() const { return (bf16*)(a->ws + WS_G); }
    __device__ __forceinline__ bf16* Qn() const { return (bf16*)(a->ws + WS_QN); }
    __device__ __forceinline__ bf16* Kn() const { return (bf16*)(a->ws + WS_KN); }
    __device__ __forceinline__ bf16* Vb() const { return (bf16*)(a->ws + WS_VB); }
    __device__ __forceinline__ bf16* Y() const { return (bf16*)(a->ws + WS_Y); }
    __device__ __forceinline__ float* AggA() const { return (float*)(a->ws + WS_AGGA); }
    __device__ __forceinline__ float* AggB() const { return (float*)(a->ws + WS_AGGB); }
    __device__ __forceinline__ float* SsqL() const { return (float*)(a->ws + WS_SSQL); }
    __device__ __forceinline__ float* SsqS() const { return (float*)(a->ws + WS_SSQS); }
};

__device__ __forceinline__ void p0_transpose_item(const float* W, int K, int N, bf16* WT, int k0, int n0, int drow, LAS float* scr, int lane) {
#pragma unroll 8
    for (int i = 0; i < 32; ++i) { const int kk = 2 * i + (lane >> 5); scr[kk * 33 + (lane & 31)] = W[(size_t)(k0 + kk) * N + n0 + (lane & 31)]; }
    LDS_WAIT(); asm volatile("" ::: "memory");
    const int c = lane & 7;
#pragma unroll
    for (int j = 0; j < 4; ++j) { const int n = (lane >> 3) + 8 * j; const LAS float* s = scr + (8 * c) * 33 + n;
        v4u o; o.x = cvt_pk_bf16(s[0 * 33], s[1 * 33]); o.y = cvt_pk_bf16(s[2 * 33], s[3 * 33]); o.z = cvt_pk_bf16(s[4 * 33], s[5 * 33]); o.w = cvt_pk_bf16(s[6 * 33], s[7 * 33]);
        *(GAS v4u*)(WT + (size_t)(drow + n) * K + k0 + 8 * c) = o; }
    LDS_WAIT(); asm volatile("" ::: "memory");
}
__device__ __forceinline__ void rms_row_to_bf16(const float* xrow, const float* g, bf16* orow, int lane) {
    const GAS f32x4* xr = (const GAS f32x4*)xrow + lane;
    f32x4 v[16]; float s = 0.f;
#pragma unroll
    for (int j = 0; j < 16; ++j) { v[j] = xr[64 * j]; s += (v[j].x * v[j].x + v[j].y * v[j].y) + (v[j].z * v[j].z + v[j].w * v[j].w); }
    const float rs = 1.0f / sqrtf(wave_sum(s) * (1.0f / DM) + EPS);
    const GAS f32x4* gr = (const GAS f32x4*)g + lane;
    GAS v2u* o8 = (GAS v2u*)orow + lane;
#pragma unroll
    for (int j = 0; j < 16; ++j) { const f32x4 gv = gr[64 * j]; v2u o; o.x = cvt_pk_bf16(v[j].x * rs * gv.x, v[j].y * rs * gv.y); o.y = cvt_pk_bf16(v[j].z * rs * gv.z, v[j].w * rs * gv.w); o8[64 * j] = o; }
}
__device__ __forceinline__ void p0_prologue(Frame& F) {
    LAS float* scr = (LAS float*)(F.lds + RING_OFF + F.wave * 16384);
    const int gw = F.vcu * NWAVES + F.wave, NGW = F.G * NWAVES;
    constexpr int I_IN = (DM / 64) * (DIN / 32), I_OUT = (DM / 64) * (DM / 32), I_UP = (DM / 64) * (2 * DFF / 32), I_DN = (DFF / 64) * (DM / 32), I_G = NBLK * 3 * 6;
    constexpr int NITEMS = I_IN + I_OUT + I_UP + I_DN + 2 * I_G;
    for (int it = gw; it < NITEMS; it += NGW) {
        int r = it;
        if (r < I_IN) { const int nb = DIN / 32, kb = r / nb, n0 = 32 * (r % nb); p0_transpose_item(F.w_in(), DM, DIN, F.Win_t(), 64 * kb, n0, n0, scr, F.lane); continue; } r -= I_IN;
        if (r < I_OUT) { const int nb = DM / 32, kb = r / nb, n0 = 32 * (r % nb); p0_transpose_item(F.w_out(), DM, DM, F.Wout_t(), 64 * kb, n0, n0, scr, F.lane); continue; } r -= I_OUT;
        if (r < I_UP) { const int nb = 2 * DFF / 32, kb = r / nb, n0 = 32 * (r % nb);
            const int f = n0 < DFF ? n0 : n0 - DFF; const int drow = 256 * (f >> 7) + (n0 < DFF ? 0 : 128) + (f & 127);
            p0_transpose_item(F.w_up(), DM, 2 * DFF, F.Wup_t(), 64 * kb, n0, drow, scr, F.lane); continue; } r -= I_UP;
        if (r < I_DN) { const int nb = DM / 32, kb = r / nb, n0 = 32 * (r % nb); p0_transpose_item(F.w_down(), DFF, DM, F.Wdown_t(), 64 * kb, n0, n0, scr, F.lane); continue; } r -= I_DN;
        { const int which = r / I_G; r -= which * I_G; const int blk = r / 18, q = r % 18, kb = q / 6, n0 = 32 * (q % 6);
          p0_transpose_item((which ? F.w_x() : F.w_a()) + (size_t)blk * BD * BD, BD, BD, (which ? F.Wx_t() : F.Wa_t()) + (size_t)blk * BD * BD, 64 * kb, n0, n0, scr, F.lane); }
    }
    for (int m = gw; m < M; m += NGW) rms_row_to_bf16(m < MP ? F.x_p() + (size_t)m * DM : F.x_s() + (size_t)(m - MP) * DM, F.g_mix(), F.BUFA() + (size_t)m * DM, F.lane);
}

struct Epi1 {
    static constexpr bool PERM = true, AFTER_DRAIN = false;
    bf16 *U, *G, *Qn, *Kn, *Vb; float* out; const float *qg, *kg; LAS float* P;
    __device__ __forceinline__ void operator()(const f32x4 (&acc)[2][2][4][2], const pg8::Unit& u, int wr, int wc, int fr, int fq) const {
        const int pn = u.pn, row0 = u.pm * 256 + wr * 64 + fr, cw8 = wc * 32 + 8 * fq;
        if (pn < 24) {
            bf16* base = pn < 12 ? U : G; const int col0 = (pn < 12 ? pn : pn - 12) * 256 + cw8;
#pragma unroll
            for (int ai = 0; ai < 2; ++ai)
#pragma unroll
                for (int m = 0; m < 4; ++m) { const int row = row0 + ai * 128 + m * 16; bf16* rowp = base + (size_t)row * DLRU + col0;
#pragma unroll
                    for (int bj = 0; bj < 2; ++bj) { const f32x4 v0 = acc[ai][bj][m][0], v1 = acc[ai][bj][m][1];
                        v4u w; w.x = cvt_pk_bf16(v0[0], v0[1]); w.y = cvt_pk_bf16(v0[2], v0[3]); w.z = cvt_pk_bf16(v1[0], v1[1]); w.w = cvt_pk_bf16(v1[2], v1[3]);
                        *(v4u*)(rowp + bj * 128) = w; }
                    if (pn < 12) {
                        float* cdst = nullptr;
                        if (row < MP) { if (row >= MP - 3) cdst = out + O_CP + (size_t)(row - (MP - 3)) * DLRU; }
                        else { const int t = (row - MP) & 31, b = (row - MP) >> 5; if (t >= 29) cdst = out + O_CS + (size_t)(b * 3 + (t - 29)) * DLRU; }
                        if (cdst) {
#pragma unroll
                            for (int bj = 0; bj < 2; ++bj) { *(f32x4*)(cdst + col0 + bj * 128) = acc[ai][bj][m][0]; *(f32x4*)(cdst + col0 + bj * 128 + 4) = acc[ai][bj][m][1]; } }
                    } }
        } else if (pn < 32) {
            const bool isk = pn >= 28; const float* gp = isk ? kg : qg;
#pragma unroll
            for (int ai = 0; ai < 2; ++ai)
#pragma unroll
                for (int m = 0; m < 4; ++m)
#pragma unroll
                    for (int bj = 0; bj < 2; ++bj) { const f32x4 v0 = acc[ai][bj][m][0], v1 = acc[ai][bj][m][1];
                        float s = (v0[0] * v0[0] + v0[1] * v0[1]) + (v0[2] * v0[2] + v0[3] * v0[3]) + (v1[0] * v1[0] + v1[1] * v1[1]) + (v1[2] * v1[2] + v1[3] * v1[3]);
                        s += __shfl_xor(s, 16); s += __shfl_xor(s, 32);
                        if (fq == 0) P[((ai * 128 + wr * 64 + m * 16 + fr) * 2 + bj) * 4 + wc] = s; }
            WG_BAR();
            const f32x4 g0 = *(const f32x4*)(gp + cw8), g1 = *(const f32x4*)(gp + cw8 + 4);
            bf16* base = isk ? Kn : Qn; const int col0 = (pn - (isk ? 28 : 24)) * 256 + cw8;
#pragma unroll
            for (int ai = 0; ai < 2; ++ai)
#pragma unroll
                for (int m = 0; m < 4; ++m) { const int row = row0 + ai * 128 + m * 16; bf16* rowp = base + (size_t)row * DSB + col0;
                    float* kdst = isk ? (row < MP ? out + O_KP + (size_t)row * DSB : out + O_KS + (size_t)(row - MP) * DSB) + col0 : nullptr;
#pragma unroll
                    for (int bj = 0; bj < 2; ++bj) { const f32x4 p = *(const LAS f32x4*)(P + ((ai * 128 + wr * 64 + m * 16 + fr) * 2 + bj) * 4);
                        const float sc = 1.0f / sqrtf(((p[0] + p[1]) + (p[2] + p[3])) * (1.0f / HD) + EPS);
                        const f32x4 v0 = acc[ai][bj][m][0] * sc * g0, v1 = acc[ai][bj][m][1] * sc * g1;
                        v4u w; w.x = cvt_pk_bf16(v0[0], v0[1]); w.y = cvt_pk_bf16(v0[2], v0[3]); w.z = cvt_pk_bf16(v1[0], v1[1]); w.w = cvt_pk_bf16(v1[2], v1[3]);
                        *(v4u*)(rowp + bj * 128) = w;
                        if (isk) { *(f32x4*)(kdst + bj * 128) = v0; *(f32x4*)(kdst + bj * 128 + 4) = v1; } } }
        } else {
            const int col0 = (pn - 32) * 256 + cw8;
#pragma unroll
            for (int ai = 0; ai < 2; ++ai)
#pragma unroll
                for (int m = 0; m < 4; ++m) { const int row = row0 + ai * 128 + m * 16; bf16* rowp = Vb + (size_t)row * DSB + col0;
                    float* vdst = (row < MP ? out + O_VP + (size_t)row * DSB : out + O_VS + (size_t)(row - MP) * DSB) + col0;
#pragma unroll
                    for (int bj = 0; bj < 2; ++bj) { const f32x4 v0 = acc[ai][bj][m][0], v1 = acc[ai][bj][m][1];
                        v4u w; w.x = cvt_pk_bf16(v0[0], v0[1]); w.y = cvt_pk_bf16(v0[2], v0[3]); w.z = cvt_pk_bf16(v1[0], v1[1]); w.w = cvt_pk_bf16(v1[2], v1[3]);
                        *(v4u*)(rowp + bj * 128) = w; *(f32x4*)(vdst + bj * 128) = v0; *(f32x4*)(vdst + bj * 128 + 4) = v1; } }
        }
    }
};
struct EpiRes {
    static constexpr bool PERM = false, AFTER_DRAIN = false;
    const float *xp, *xs; float* out; int inplace;
    __device__ __forceinline__ void operator()(const f32x4 (&acc)[2][2][4][2], const pg8::Unit& u, int wr, int wc, int fr, int fq) const {
        const int row0 = u.pm * 256 + wr * 64 + fr, col0 = u.pn * 256 + wc * 32 + 4 * fq;
#pragma unroll
        for (int ai = 0; ai < 2; ++ai)
#pragma unroll
            for (int m = 0; m < 4; ++m) { const int row = row0 + ai * 128 + m * 16; float* op = out + O_Y + (size_t)row * DM + col0;
                const float* bp = inplace ? op : ((row < MP ? xp + (size_t)row * DM : xs + (size_t)(row - MP) * DM) + col0);
#pragma unroll
                for (int bj = 0; bj < 2; ++bj)
#pragma unroll
                    for (int n = 0; n < 2; ++n) { const f32x4 b = *(const f32x4*)(bp + bj * 128 + n * 16); *(f32x4*)(op + bj * 128 + n * 16) = b + acc[ai][bj][m][n]; } }
    }
};
struct EpiBf {
    static constexpr bool PERM = true, AFTER_DRAIN = false;
    bf16* O; int ldc;
    __device__ __forceinline__ void operator()(const f32x4 (&acc)[2][2][4][2], const pg8::Unit& u, int wr, int wc, int fr, int fq) const {
        const int row0 = u.pm * 256 + wr * 64 + fr, col0 = u.pn * 256 + wc * 32 + 8 * fq;
#pragma unroll
        for (int ai = 0; ai < 2; ++ai)
#pragma unroll
            for (int m = 0; m < 4; ++m) { bf16* rowp = O + (size_t)(row0 + ai * 128 + m * 16) * ldc + col0;
#pragma unroll
                for (int bj = 0; bj < 2; ++bj) { const f32x4 v0 = acc[ai][bj][m][0], v1 = acc[ai][bj][m][1];
                    v4u w; w.x = cvt_pk_bf16(v0[0], v0[1]); w.y = cvt_pk_bf16(v0[2], v0[3]); w.z = cvt_pk_bf16(v1[0], v1[1]); w.w = cvt_pk_bf16(v1[2], v1[3]);
                    *(v4u*)(rowp + bj * 128) = w; } }
    }
};

constexpr int UC_LD = 388;
constexpr int UC_BYTES = 64 * UC_LD * 4, LSS_OFF = UC_BYTES;
static_assert(LSS_OFF + 8 * 64 * 4 <= RING_BYTES, "lru lds");
template <int PASS> __device__ __forceinline__ void lru_unit(Frame& F, int chunk, int bp) {
    const int tid = F.tid, lane = F.lane, w = F.wave, fr = lane & 15, fq = lane >> 4;
    LAS float* UC = (LAS float*)(F.lds + RING_OFF);
    LAS float* LSS = (LAS float*)(F.lds + RING_OFF + LSS_OFF);
    const bool smp = chunk >= 256;
    const int row0 = smp ? MP + 64 * (chunk - 256) : 64 * chunk;
    const int chb = 384 * bp;
    const int bl = w >> 2, cg = w & 3, blk = 2 * bp + bl, cwl = 192 * bl + 48 * cg;
    f32x4 carry[3];
    if constexpr (PASS == 1) {
        if (smp) { const int b0 = 2 * (chunk - 256);
#pragma unroll
            for (int ct = 0; ct < 3; ++ct) carry[ct] = *(const f32x4*)(F.st_h() + (size_t)b0 * DLRU + chb + cwl + 16 * ct + 4 * fq);
        } else {
            f32x4 PA[3], PB[3];
#pragma unroll
            for (int ct = 0; ct < 3; ++ct) { PA[ct] = (f32x4){1.f, 1.f, 1.f, 1.f}; PB[ct] = (f32x4){0.f, 0.f, 0.f, 0.f}; }
            const int S = (chunk + 15) >> 4, c_lo = fr * S;
            for (int i = 0; i < S; ++i) { const int cc = c_lo + i;
                if (cc < chunk) {
#pragma unroll
                    for (int ct = 0; ct < 3; ++ct) { const int chg = chb + cwl + 16 * ct + 4 * fq;
                        const f32x4 la = *(const f32x4*)(F.AggA() + (size_t)cc * DLRU + chg), lb = *(const f32x4*)(F.AggB() + (size_t)cc * DLRU + chg);
                        PB[ct] = la * PB[ct] + lb; PA[ct] = la * PA[ct]; }
                } }
#pragma unroll
            for (int ct = 0; ct < 3; ++ct)
#pragma unroll
                for (int r = 0; r < 4; ++r) { float a = PA[ct][r], b = PB[ct][r]; row_scan_ab(a, b); carry[ct][r] = __shfl(b, (lane & 48) | 15); }
        }
    }
    WG_BAR();
    if (tid < 384) {
        const int cgp = tid % 48, tg = tid / 48, ch = chb + 8 * cgp, tok0 = 8 * tg;
        float wv[4][8], bv[8], xw[3][8];
#pragma unroll
        for (int k = 0; k < 4; ++k) { const f32x4 a = *(const f32x4*)(F.cw() + k * DLRU + ch), b = *(const f32x4*)(F.cw() + k * DLRU + ch + 4);
            wv[k][0] = a[0]; wv[k][1] = a[1]; wv[k][2] = a[2]; wv[k][3] = a[3]; wv[k][4] = b[0]; wv[k][5] = b[1]; wv[k][6] = b[2]; wv[k][7] = b[3]; }
        { const f32x4 a = *(const f32x4*)(F.cb() + ch), b = *(const f32x4*)(F.cb() + ch + 4); bv[0] = a[0]; bv[1] = a[1]; bv[2] = a[2]; bv[3] = a[3]; bv[4] = b[0]; bv[5] = b[1]; bv[6] = b[2]; bv[7] = b[3]; }
        const int r0 = row0 + tok0;
        const bool from_state = smp && ((tok0 & 31) == 0), zero_prev = (!smp) && (r0 == 0);
#pragma unroll
        for (int d = 0; d < 3; ++d) {
            if (zero_prev) {
#pragma unroll
                for (int e = 0; e < 8; ++e) xw[d][e] = 0.f;
            } else if (from_state) { const int b = (r0 - MP) >> 5; const float* sp = F.st_conv() + (size_t)(b * 3 + d) * DLRU + ch; const f32x4 a = *(const f32x4*)sp, c = *(const f32x4*)(sp + 4);
                xw[d][0] = a[0]; xw[d][1] = a[1]; xw[d][2] = a[2]; xw[d][3] = a[3]; xw[d][4] = c[0]; xw[d][5] = c[1]; xw[d][6] = c[2]; xw[d][7] = c[3];
            } else { const v4u q = *(const v4u*)(F.U() + (size_t)(r0 - 3 + d) * DLRU + ch);
                xw[d][0] = bflo(q.x); xw[d][1] = bfhi(q.x); xw[d][2] = bflo(q.y); xw[d][3] = bfhi(q.y); xw[d][4] = bflo(q.z); xw[d][5] = bfhi(q.z); xw[d][6] = bflo(q.w); xw[d][7] = bfhi(q.w); }
        }
#pragma unroll
        for (int t = 0; t < 8; ++t) {
            const v4u q = *(const v4u*)(F.U() + (size_t)(r0 + t) * DLRU + ch);
            float xc[8]; xc[0] = bflo(q.x); xc[1] = bfhi(q.x); xc[2] = bflo(q.y); xc[3] = bfhi(q.y); xc[4] = bflo(q.z); xc[5] = bfhi(q.z); xc[6] = bflo(q.w); xc[7] = bfhi(q.w);
            float o[8];
#pragma unroll
            for (int e = 0; e < 8; ++e) o[e] = bv[e] + ((wv[0][e] * xw[0][e] + wv[1][e] * xw[1][e]) + (wv[2][e] * xw[2][e] + wv[3][e] * xc[e]));
            LAS f32x4* dst = (LAS f32x4*)(UC + (tok0 + t) * UC_LD + 8 * cgp);
            dst[0] = (f32x4){o[0], o[1], o[2], o[3]}; dst[1] = (f32x4){o[4], o[5], o[6], o[7]};
#pragma unroll
            for (int e = 0; e < 8; ++e) { xw[0][e] = xw[1][e]; xw[1][e] = xw[2][e]; xw[2][e] = xc[e]; }
        }
    }
    WG_BAR();
    f32x4 accA[4][3], accX[4][3];
#pragma unroll
    for (int tt = 0; tt < 4; ++tt)
#pragma unroll
        for (int ct = 0; ct < 3; ++ct) { accA[tt][ct] = (f32x4){0.f, 0.f, 0.f, 0.f}; accX[tt][ct] = (f32x4){0.f, 0.f, 0.f, 0.f}; }
    const bf16* wa_base = F.Wa_t() + (size_t)blk * BD * BD + (size_t)(48 * cg + fr) * BD + 8 * fq;
    const bf16* wx_base = F.Wx_t() + (size_t)blk * BD * BD + (size_t)(48 * cg + fr) * BD + 8 * fq;
#pragma unroll 1
    for (int ks = 0; ks < 6; ++ks) {
        bf16x8 uf[4];
#pragma unroll
        for (int tt = 0; tt < 4; ++tt) { const LAS f32x4* s = (const LAS f32x4*)(UC + (16 * tt + fr) * UC_LD + 192 * bl + 32 * ks + 8 * fq); const f32x4 a = s[0], b = s[1];
            v4u p; p.x = cvt_pk_bf16(a[0], a[1]); p.y = cvt_pk_bf16(a[2], a[3]); p.z = cvt_pk_bf16(b[0], b[1]); p.w = cvt_pk_bf16(b[2], b[3]); uf[tt] = __builtin_bit_cast(bf16x8, p); }
#pragma unroll
        for (int ct = 0; ct < 3; ++ct) {
            const bf16x8 fa = __builtin_bit_cast(bf16x8, *(const v4u*)(wa_base + (size_t)(16 * ct) * BD + 32 * ks));
            const bf16x8 fx = __builtin_bit_cast(bf16x8, *(const v4u*)(wx_base + (size_t)(16 * ct) * BD + 32 * ks));
#pragma unroll
            for (int tt = 0; tt < 4; ++tt) { accA[tt][ct] = __builtin_amdgcn_mfma_f32_16x16x32_bf16(fa, uf[tt], accA[tt][ct], 0, 0, 0);
                                             accX[tt][ct] = __builtin_amdgcn_mfma_f32_16x16x32_bf16(fx, uf[tt], accX[tt][ct], 0, 0, 0); }
        }
    }
#pragma unroll
    for (int ct = 0; ct < 3; ++ct) {
        const int chg = chb + cwl + 16 * ct + 4 * fq;
        const f32x4 ba = *(const f32x4*)(F.b_a() + chg), bx = *(const f32x4*)(F.b_x() + chg), lm = *(const f32x4*)(F.lam() + chg);
        f32x4 c8;
#pragma unroll
        for (int r = 0; r < 4; ++r) { const float l = lm[r]; c8[r] = 8.0f * 1.4426950408889634f * (fminf(l, 0.f) - log1pf(expf(-fabsf(l)))); }
#pragma unroll
        for (int tt = 0; tt < 4; ++tt) {
            const f32x4 uc = *(const LAS f32x4*)(UC + (16 * tt + fr) * UC_LD + cwl + 16 * ct + 4 * fq);
#pragma unroll
            for (int r = 0; r < 4; ++r) {
                const float rg = sigmoidf_(accA[tt][ct][r] + ba[r]), ig = sigmoidf_(accX[tt][ct][r] + bx[r]);
                const float la2 = c8[r] * rg;
                const float a = fexp2(la2);
                const float x = 2.0f * 0.6931471805599453f * la2;
                const float om = (x > -0.25f) ? -x * (1.0f + x * (0.5f + x * (0.16666667f + x * (0.041666668f + x * (0.008333334f + x * 0.0013888889f))))) : 1.0f - a * a;
                accA[tt][ct][r] = a; accX[tt][ct][r] = sqrtf(om) * ig * uc[r];
            }
        }
    }
#pragma unroll
    for (int tt = 0; tt < 4; ++tt)
#pragma unroll
        for (int ct = 0; ct < 3; ++ct)
#pragma unroll
            for (int r = 0; r < 4; ++r) { float a = accA[tt][ct][r], b = accX[tt][ct][r]; row_scan_ab(a, b); accA[tt][ct][r] = a; accX[tt][ct][r] = b; }
    if constexpr (PASS == 0) {
        if (fr == 15) {
#pragma unroll
            for (int ct = 0; ct < 3; ++ct) { f32x4 A = accA[0][ct], B = accX[0][ct];
#pragma unroll
                for (int tt = 1; tt < 4; ++tt) { B = accA[tt][ct] * B + accX[tt][ct]; A = A * accA[tt][ct]; }
                const int chg = chb + cwl + 16 * ct + 4 * fq;
                *(f32x4*)(F.AggA() + (size_t)chunk * DLRU + chg) = A; *(f32x4*)(F.AggB() + (size_t)chunk * DLRU + chg) = B; }
        }
    } else {
        const float* gl = F.g_lru();
        float ssq[4] = {0.f, 0.f, 0.f, 0.f};
#pragma unroll
        for (int tt = 0; tt < 4; ++tt) {
            if (smp && tt == 2) { const int b1 = 2 * (chunk - 256) + 1;
#pragma unroll
                for (int ct = 0; ct < 3; ++ct) carry[ct] = *(const f32x4*)(F.st_h() + (size_t)b1 * DLRU + chb + cwl + 16 * ct + 4 * fq); }
            const int row = row0 + 16 * tt + fr;
#pragma unroll
            for (int ct = 0; ct < 3; ++ct) {
                const int chg = chb + cwl + 16 * ct + 4 * fq;
                const f32x4 h = accX[tt][ct] + accA[tt][ct] * carry[ct];
                const v2u gq = *(const v2u*)(F.Gt() + (size_t)row * DLRU + chg);
                const f32x4 gv = *(const f32x4*)(gl + chg);
                f32x4 y; y[0] = h[0] * gelu_tanh(bflo(gq.x)); y[1] = h[1] * gelu_tanh(bfhi(gq.x)); y[2] = h[2] * gelu_tanh(bflo(gq.y)); y[3] = h[3] * gelu_tanh(bfhi(gq.y));
                ssq[tt] += (y[0] * y[0] + y[1] * y[1]) + (y[2] * y[2] + y[3] * y[3]);
                y = y * gv;
                v2u o; o.x = cvt_pk_bf16(y[0], y[1]); o.y = cvt_pk_bf16(y[2], y[3]);
                *(v2u*)(F.Y() + (size_t)row * DM + chg) = o;
                const bool lastp = (!smp) && (row == MP - 1), lasts = smp && (((row - MP) & 31) == 31);
                if (lastp) *(f32x4*)(F.out() + O_HP + chg) = h;
                if (lasts) *(f32x4*)(F.out() + O_HS + (size_t)((row - MP) >> 5) * DLRU + chg) = h;
#pragma unroll
                for (int r = 0; r < 4; ++r) carry[ct][r] = __shfl(h[r], (lane & 48) | 15);
            }
            float s = ssq[tt]; s += __shfl_xor(s, 16); s += __shfl_xor(s, 32);
            if (fq == 0) LSS[w * 64 + 16 * tt + fr] = s;
        }
        WG_BAR();
        if (tid < 64) { float s = 0.f;
#pragma unroll
            for (int k = 0; k < 8; ++k) s += LSS[k * 64 + tid];
            F.SsqL()[(size_t)(row0 + tid) * 8 + bp] = s; }
    }
}

constexpr int KS_LD = 272, KS_OFF = 0, VT_OFF = 128 * KS_LD, WM_OFF = 2 * 128 * KS_LD;
constexpr float ATT_SC = 0.12751743082459868f;
constexpr float ATT_STOP = -160.0f;
__device__ __forceinline__ int vt_pos(int k) { return (k & ~31) | (((k >> 2) & 3) << 3) | (((k >> 4) & 1) << 2) | (k & 3); }
__device__ __forceinline__ void attn_unit(Frame& F, int ui) {
    const int tid = F.tid, lane = F.lane, w = F.wave, fr = lane & 15, fq = lane >> 4;
    LAS unsigned char* KS = F.lds + RING_OFF + KS_OFF; LAS unsigned char* VT = F.lds + RING_OFF + VT_OFF; LAS float* WM = (LAS float*)(F.lds + RING_OFF + WM_OFF);
    const bool smp = ui >= 1024; const int h = ui & 7;
    const int qt = ui >> 3, b = (ui - 1024) >> 3;
    const int qrow0 = smp ? MP + 32 * b : 128 * qt;
    const int nkb = smp ? 1 + PAST / 128 : qt + 1;
    const bool active = smp ? (w < 2) : true;
    const int qi = 16 * w + fr;
    bf16x8 qf[4];
    if (active) {
#pragma unroll
        for (int ds = 0; ds < 4; ++ds) qf[ds] = __builtin_bit_cast(bf16x8, *(const v4u*)(F.Qn() + (size_t)(qrow0 + qi) * DSB + h * HD + 32 * ds + 8 * fq));
    } else {
#pragma unroll
        for (int ds = 0; ds < 4; ++ds) qf[ds] = (bf16x8){0, 0, 0, 0, 0, 0, 0, 0};
    }
    f32x4 o[8];
#pragma unroll
    for (int dt = 0; dt < 8; ++dt) o[dt] = (f32x4){0.f, 0.f, 0.f, 0.f};
    float carry = 0.f;
    for (int j = 0; j < nkb; ++j) {
        WG_BAR();
        if (!smp || j == 0) {
            const int krow0 = smp ? qrow0 : 128 * (qt - j); const int nvalid = smp ? 32 : 128;
#pragma unroll
            for (int c = 0; c < 4; ++c) { const int id = tid + 512 * c;
                { const int key = id >> 4, dc = id & 15; v4u q = (v4u){0u, 0u, 0u, 0u}; if (key < nvalid) q = *(const v4u*)(F.Kn() + (size_t)(krow0 + key) * DSB + h * HD + 8 * dc);
                  *(LAS v4u*)(KS + key * KS_LD + 16 * dc) = q; }
                { const int key = id & 127, dc = id >> 7; v4u q = (v4u){0u, 0u, 0u, 0u}; if (key < nvalid) q = *(const v4u*)(F.Vb() + (size_t)(krow0 + key) * DSB + h * HD + 8 * dc);
                  LAS unsigned short* vp = (LAS unsigned short*)(VT + (8 * dc) * KS_LD + 2 * vt_pos(key));
                  vp[0 * (KS_LD / 2)] = (unsigned short)(q.x & 0xffffu); vp[1 * (KS_LD / 2)] = (unsigned short)(q.x >> 16); vp[2 * (KS_LD / 2)] = (unsigned short)(q.y & 0xffffu); vp[3 * (KS_LD / 2)] = (unsigned short)(q.y >> 16);
                  vp[4 * (KS_LD / 2)] = (unsigned short)(q.z & 0xffffu); vp[5 * (KS_LD / 2)] = (unsigned short)(q.z >> 16); vp[6 * (KS_LD / 2)] = (unsigned short)(q.w & 0xffffu); vp[7 * (KS_LD / 2)] = (unsigned short)(q.w >> 16); }
            }
        } else {
            const int pos0 = PAST - 128 * j;
            const float* ck = F.cache_k() + ((size_t)b * PAST + pos0) * DSB + h * HD; const float* cv = F.cache_v() + ((size_t)b * PAST + pos0) * DSB + h * HD;
#pragma unroll
            for (int c = 0; c < 4; ++c) { const int id = tid + 512 * c;
                { const int key = id >> 4, dc = id & 15; const float* p = ck + (size_t)key * DSB + 8 * dc; const f32x4 a = *(const f32x4*)p, bb = *(const f32x4*)(p + 4);
                  v4u q; q.x = cvt_pk_bf16(a[0], a[1]); q.y = cvt_pk_bf16(a[2], a[3]); q.z = cvt_pk_bf16(bb[0], bb[1]); q.w = cvt_pk_bf16(bb[2], bb[3]);
                  *(LAS v4u*)(KS + key * KS_LD + 16 * dc) = q; }
                { const int key = id & 127, dc = id >> 7; const float* p = cv + (size_t)key * DSB + 8 * dc; const f32x4 a = *(const f32x4*)p, bb = *(const f32x4*)(p + 4);
                  v4u q; q.x = cvt_pk_bf16(a[0], a[1]); q.y = cvt_pk_bf16(a[2], a[3]); q.z = cvt_pk_bf16(bb[0], bb[1]); q.w = cvt_pk_bf16(bb[2], bb[3]);
                  LAS unsigned short* vp = (LAS unsigned short*)(VT + (8 * dc) * KS_LD + 2 * vt_pos(key));
                  vp[0 * (KS_LD / 2)] = (unsigned short)(q.x & 0xffffu); vp[1 * (KS_LD / 2)] = (unsigned short)(q.x >> 16); vp[2 * (KS_LD / 2)] = (unsigned short)(q.y & 0xffffu); vp[3 * (KS_LD / 2)] = (unsigned short)(q.y >> 16);
                  vp[4 * (KS_LD / 2)] = (unsigned short)(q.z & 0xffffu); vp[5 * (KS_LD / 2)] = (unsigned short)(q.z >> 16); vp[6 * (KS_LD / 2)] = (unsigned short)(q.w & 0xffffu); vp[7 * (KS_LD / 2)] = (unsigned short)(q.w >> 16); }
            }
        }
        WG_BAR();
        float wmax = -3.0e38f;
        if (active) {
            f32x4 s[8];
#pragma unroll
            for (int kt = 0; kt < 8; ++kt) { s[kt] = (f32x4){0.f, 0.f, 0.f, 0.f};
#pragma unroll
                for (int ds = 0; ds < 4; ++ds) { const bf16x8 kf = *(const LAS bf16x8*)(KS + (16 * kt + fr) * KS_LD + 2 * (32 * ds + 8 * fq)); s[kt] = __builtin_amdgcn_mfma_f32_16x16x32_bf16(kf, qf[ds], s[kt], 0, 0, 0); } }
            const bool diag = (j == 0);
            float lb[8][4], xs[8][3], Fq[8], TT[8];
#pragma unroll
            for (int kt = 0; kt < 8; ++kt) {
#pragma unroll
                for (int r = 0; r < 4; ++r) { const float z2 = s[kt][r] * ATT_SC; s[kt][r] = z2;
                    const float sp = fmaxf(z2, 0.f) + flog2(1.0f + fexp2(-fabsf(z2)));
                    const bool valid = (!diag) || ((16 * kt + 4 * fq + r) < qi);
                    lb[kt][r] = valid ? -sp : 0.f; }
                xs[kt][2] = lb[kt][3]; xs[kt][1] = lb[kt][3] + lb[kt][2]; xs[kt][0] = xs[kt][1] + lb[kt][1];
                const float T = xs[kt][0] + lb[kt][0];
                const float t1 = __shfl_xor(T, 16), t2 = __shfl_xor(T, 32), t3 = __shfl_xor(T, 48);
                Fq[kt] = (((fq ^ 1) > fq) ? t1 : 0.f) + (((fq ^ 2) > fq) ? t2 : 0.f) + (((fq ^ 3) > fq) ? t3 : 0.f);
                TT[kt] = (T + t1) + (t2 + t3);
            }
            float run = carry; bf16x8 pf[4];
            unsigned pw[8][2];
#pragma unroll
            for (int kt = 7; kt >= 0; --kt) {
                const float base = run + Fq[kt];
                float wv[4];
#pragma unroll
                for (int r = 0; r < 4; ++r) { const float st = base + (r < 3 ? xs[kt][r] : 0.f);
                    const bool valid = (!diag) || ((16 * kt + 4 * fq + r) < qi);
                    wv[r] = valid ? fexp2(s[kt][r] + lb[kt][r] + st) : 0.f; }
                pw[kt][0] = cvt_pk_bf16(wv[0], wv[1]); pw[kt][1] = cvt_pk_bf16(wv[2], wv[3]);
                run += TT[kt];
            }
            carry = run;
#pragma unroll
            for (int sI = 0; sI < 4; ++sI) { v4u p; p.x = pw[2 * sI][0]; p.y = pw[2 * sI][1]; p.z = pw[2 * sI + 1][0]; p.w = pw[2 * sI + 1][1]; pf[sI] = __builtin_bit_cast(bf16x8, p); }
#pragma unroll
            for (int dt = 0; dt < 8; ++dt)
#pragma unroll
                for (int sI = 0; sI < 4; ++sI) { const bf16x8 vf = *(const LAS bf16x8*)(VT + (16 * dt + fr) * KS_LD + 2 * (32 * sI + 8 * fq)); o[dt] = __builtin_amdgcn_mfma_f32_16x16x32_bf16(vf, pf[sI], o[dt], 0, 0, 0); }
            wmax = carry;
#pragma unroll
            for (int off = 1; off < 16; off <<= 1) wmax = fmaxf(wmax, __shfl_xor(wmax, off));
        }
        if (lane == 0) WM[w] = wmax;
        WG_BAR();
        float mx = WM[0];
#pragma unroll
        for (int k = 1; k < 8; ++k) mx = fmaxf(mx, WM[k]);
        if (mx < ATT_STOP) break;
    }
    if (active) {
        const int row = qrow0 + qi;
        float ss = 0.f;
#pragma unroll
        for (int dt = 0; dt < 8; ++dt) ss += (o[dt][0] * o[dt][0] + o[dt][1] * o[dt][1]) + (o[dt][2] * o[dt][2] + o[dt][3] * o[dt][3]);
        ss += __shfl_xor(ss, 16); ss += __shfl_xor(ss, 32);
        if (fq == 0) F.SsqS()[(size_t)row * 8 + h] = ss;
#pragma unroll
        for (int dt = 0; dt < 8; ++dt) { const int d = 16 * dt + 4 * fq; const f32x4 gv = *(const f32x4*)(F.g_sb() + h * HD + d); const f32x4 y = o[dt] * gv;
            v2u q; q.x = cvt_pk_bf16(y[0], y[1]); q.y = cvt_pk_bf16(y[2], y[3]); *(v2u*)(F.Y() + (size_t)row * DM + DLRU + h * HD + d) = q; }
    }
}

__device__ __forceinline__ void mixnorm_rows(Frame& F) {
    const int gw = F.vcu * NWAVES + F.wave, NGW = F.G * NWAVES, lane = F.lane;
    for (int m = gw; m < M; m += NGW) {
        const f32x4 a0 = *(const f32x4*)(F.SsqL() + (size_t)m * 8), a1 = *(const f32x4*)(F.SsqL() + (size_t)m * 8 + 4), b0 = *(const f32x4*)(F.SsqS() + (size_t)m * 8), b1 = *(const f32x4*)(F.SsqS() + (size_t)m * 8 + 4);
        const float sl = 1.0f / sqrtf((((a0[0] + a0[1]) + (a0[2] + a0[3])) + ((a1[0] + a1[1]) + (a1[2] + a1[3]))) * (1.0f / DLRU) + EPS);
        const float ssb = 1.0f / sqrtf((((b0[0] + b0[1]) + (b0[2] + b0[3])) + ((b1[0] + b1[1]) + (b1[2] + b1[3]))) * (1.0f / DSB) + EPS);
        GAS v4u* yr = (GAS v4u*)(F.Y() + (size_t)m * DM);
#pragma unroll
        for (int j = 0; j < 8; ++j) { const int ci = lane + 64 * j; const float sc = (ci < DLRU / 8) ? sl : ssb; v4u q = yr[ci];
            q.x = cvt_pk_bf16(bflo(q.x) * sc, bfhi(q.x) * sc); q.y = cvt_pk_bf16(bflo(q.y) * sc, bfhi(q.y) * sc); q.z = cvt_pk_bf16(bflo(q.z) * sc, bfhi(q.z) * sc); q.w = cvt_pk_bf16(bflo(q.w) * sc, bfhi(q.w) * sc);
            yr[ci] = q; }
    }
}
__device__ __forceinline__ void act_pass(Frame& F, int hf) {
    const int gt = F.vcu * (NWAVES * 64) + F.tid, NGT = F.G * NWAVES * 64;
    constexpr int NFG = DFF / 2 / 8, NRB = M / 32;
    for (int it = gt; it < NFG * NRB; it += NGT) {
        const int fg = it % NFG, rb = it / NFG, pnl = fg >> 4, wi = (fg & 15) * 8, vcol = 256 * pnl + wi, f = (DFF / 2) * hf + 128 * pnl + wi, r0 = 32 * rb;
        float w0[8], w1[8], w2[8], cbv[8], p2[8], p1[8];
        { const f32x4 a = *(const f32x4*)(F.fcw() + f), b = *(const f32x4*)(F.fcw() + f + 4); w0[0] = a[0]; w0[1] = a[1]; w0[2] = a[2]; w0[3] = a[3]; w0[4] = b[0]; w0[5] = b[1]; w0[6] = b[2]; w0[7] = b[3]; }
        { const f32x4 a = *(const f32x4*)(F.fcw() + DFF + f), b = *(const f32x4*)(F.fcw() + DFF + f + 4); w1[0] = a[0]; w1[1] = a[1]; w1[2] = a[2]; w1[3] = a[3]; w1[4] = b[0]; w1[5] = b[1]; w1[6] = b[2]; w1[7] = b[3]; }
        { const f32x4 a = *(const f32x4*)(F.fcw() + 2 * DFF + f), b = *(const f32x4*)(F.fcw() + 2 * DFF + f + 4); w2[0] = a[0]; w2[1] = a[1]; w2[2] = a[2]; w2[3] = a[3]; w2[4] = b[0]; w2[5] = b[1]; w2[6] = b[2]; w2[7] = b[3]; }
        { const f32x4 a = *(const f32x4*)(F.fcb() + f), b = *(const f32x4*)(F.fcb() + f + 4); cbv[0] = a[0]; cbv[1] = a[1]; cbv[2] = a[2]; cbv[3] = a[3]; cbv[4] = b[0]; cbv[5] = b[1]; cbv[6] = b[2]; cbv[7] = b[3]; }
        if (r0 >= MP) { const int b = (r0 - MP) >> 5; const float* s0 = F.st_ffn() + (size_t)(b * 2) * DFF + f; const float* s1 = s0 + DFF;
            const f32x4 a = *(const f32x4*)s0, c = *(const f32x4*)(s0 + 4), d = *(const f32x4*)s1, e = *(const f32x4*)(s1 + 4);
            p2[0] = a[0]; p2[1] = a[1]; p2[2] = a[2]; p2[3] = a[3]; p2[4] = c[0]; p2[5] = c[1]; p2[6] = c[2]; p2[7] = c[3];
            p1[0] = d[0]; p1[1] = d[1]; p1[2] = d[2]; p1[3] = d[3]; p1[4] = e[0]; p1[5] = e[1]; p1[6] = e[2]; p1[7] = e[3];
        } else if (r0 == 0) {
#pragma unroll
            for (int e = 0; e < 8; ++e) { p2[e] = 0.f; p1[e] = 0.f; }
        } else { const v4u a = *(const v4u*)(F.VALPRE() + (size_t)(r0 - 2) * DFF + vcol + 128), b = *(const v4u*)(F.VALPRE() + (size_t)(r0 - 1) * DFF + vcol + 128);
            p2[0] = bflo(a.x); p2[1] = bfhi(a.x); p2[2] = bflo(a.y); p2[3] = bfhi(a.y); p2[4] = bflo(a.z); p2[5] = bfhi(a.z); p2[6] = bflo(a.w); p2[7] = bfhi(a.w);
            p1[0] = bflo(b.x); p1[1] = bfhi(b.x); p1[2] = bflo(b.y); p1[3] = bfhi(b.y); p1[4] = bflo(b.z); p1[5] = bfhi(b.z); p1[6] = bflo(b.w); p1[7] = bfhi(b.w); }
#pragma unroll 4
        for (int t = 0; t < 32; ++t) { const int row = r0 + t;
            const v4u pq = *(const v4u*)(F.VALPRE() + (size_t)row * DFF + vcol + 128), vq = *(const v4u*)(F.VALPRE() + (size_t)row * DFF + vcol);
            float pc[8], vv[8], o[8];
            pc[0] = bflo(pq.x); pc[1] = bfhi(pq.x); pc[2] = bflo(pq.y); pc[3] = bfhi(pq.y); pc[4] = bflo(pq.z); pc[5] = bfhi(pq.z); pc[6] = bflo(pq.w); pc[7] = bfhi(pq.w);
            vv[0] = bflo(vq.x); vv[1] = bfhi(vq.x); vv[2] = bflo(vq.y); vv[3] = bfhi(vq.y); vv[4] = bflo(vq.z); vv[5] = bfhi(vq.z); vv[6] = bflo(vq.w); vv[7] = bfhi(vq.w);
#pragma unroll
            for (int e = 0; e < 8; ++e) { const float c = cbv[e] + (w0[e] * p2[e] + w1[e] * p1[e]) + w2[e] * pc[e]; o[e] = gelu_tanh(c) * vv[e]; p2[e] = p1[e]; p1[e] = pc[e]; }
            v4u q; q.x = cvt_pk_bf16(o[0], o[1]); q.y = cvt_pk_bf16(o[2], o[3]); q.z = cvt_pk_bf16(o[4], o[5]); q.w = cvt_pk_bf16(o[6], o[7]);
            *(v4u*)(F.ACT() + (size_t)row * DFF + f) = q;
            float* fdst = nullptr;
            if (row < MP) { if (row >= MP - 2) fdst = F.out() + O_FP + (size_t)(row - (MP - 2)) * DFF + f; }
            else { const int tt = (row - MP) & 31; if (tt >= 30) fdst = F.out() + O_FS + (size_t)(((row - MP) >> 5) * 2 + (tt - 30)) * DFF + f; }
            if (fdst) { *(f32x4*)fdst = (f32x4){pc[0], pc[1], pc[2], pc[3]}; *(f32x4*)(fdst + 4) = (f32x4){pc[4], pc[5], pc[6], pc[7]}; }
        }
    }
}

constexpr int NPH = 12;
__global__ void __launch_bounds__(NWAVES * 64, 2) hymba_fwd(Args args) {
    extern __shared__ __attribute__((aligned(16))) unsigned char lds[];
    Frame F;
    F.lds = (LAS unsigned char*)lds;
    F.MISC = (volatile LAS unsigned*)(F.lds + MISC_OFF);
    F.tid = threadIdx.x; F.lane = F.tid & 63; F.wave = __builtin_amdgcn_readfirstlane(F.tid >> 6);
    F.G = gridDim.x; { const int bx = blockIdx.x; F.vcu = (F.G % 8 == 0) ? (bx % 8) * (F.G / 8) + bx / 8 : bx; }
    F.a = &args;
    F.ctl = (gu32*)(args.ws + WS_CTL);
    for (int u = F.tid; u < (LDS_BYTES - LDSCTL_OFF) / 4; u += NWAVES * 64) ((LAS unsigned*)(F.lds + LDSCTL_OFF))[u] = 0u;
    __syncthreads();
    XcdBarrier bar; bar.bar = (unsigned*)(F.ctl + CW_BAR); bar.x = 0; bar.st = nullptr;
    if (!MK_PER_PHASE) bar = xcd_barrier_post((unsigned*)(F.ctl + CW_BAR), F.MISC + 8);
#define GRID_BAR(seam) do { if (MK_PER_PHASE) { if (F.tid == 0) __hip_atomic_store(F.ctl + CW_TMO, 0xBADBA0u | (unsigned)(seam), RLX_AGENT); } else { xcd_barrier(bar); } } while (0)
    const int lo = args.ph_lo, hi = args.ph_hi;
#ifndef PH_MASK
#define PH_MASK 0x7FFF
#endif
#define IN(k) (((PH_MASK >> (k)) & 1) && lo <= (k) && (k) < hi)
#define BOTH(k) (IN(k) && IN((k) + 1))
    LAS float* EPI = (LAS float*)(F.lds + EPI_OFF);

    if (IN(0)) { p0_prologue(F); if (BOTH(0)) GRID_BAR(0); }
    if (IN(1)) {
        pg8::Gemm g{F.BUFA(), F.Win_t(), M, DIN, DM}; pg8::StaticOrder S; S.init(M, DIN, F.G, (int)blockIdx.x);
        Epi1 E{F.U(), F.Gt(), F.Qn(), F.Kn(), F.Vb(), F.out(), F.qg(), F.kg(), EPI};
        pg8::gemm_phase<Epi1, pg8::StaticOrder, true, true>(F.lds + RING_OFF, g, S, E);
        if (BOTH(1)) GRID_BAR(1);
    }
    if (IN(2)) {
        if ((PH_MASK >> 12) & 1) for (int u = F.vcu; u < 2048; u += F.G) lru_unit<0>(F, u >> 3, u & 7);
        if ((PH_MASK >> 13) & 1) for (int u = F.vcu; u < 64; u += F.G) lru_unit<1>(F, 256 + (u >> 3), u & 7);
        if ((PH_MASK >> 14) & 1) for (int u = (F.vcu + 64) % F.G; u < 1152; u += F.G) attn_unit(F, u);
        if (BOTH(2)) GRID_BAR(2);
    }
    if (IN(3)) {
        for (int u = F.vcu; u < 2048; u += F.G) lru_unit<1>(F, u >> 3, u & 7);
        if (BOTH(3)) GRID_BAR(3);
    }
    if (IN(4)) { mixnorm_rows(F); if (BOTH(4)) GRID_BAR(4); }
    if (IN(5)) {
        pg8::Gemm g{F.Y(), F.Wout_t(), M, DM, DM}; pg8::StaticOrder S; S.init(M, DM, F.G, (int)blockIdx.x);
        EpiRes E{F.x_p(), F.x_s(), F.out(), 0};
        pg8::gemm_phase<EpiRes, pg8::StaticOrder, true, true>(F.lds + RING_OFF, g, S, E);
        if (BOTH(5)) GRID_BAR(5);
    }
    if (IN(6)) {
        const int gw = F.vcu * NWAVES + F.wave, NGW = F.G * NWAVES;
        for (int m = gw; m < M; m += NGW) rms_row_to_bf16(F.out() + O_Y + (size_t)m * DM, F.g_ffn(), F.BUFA() + (size_t)m * DM, F.lane);
        if (BOTH(6)) GRID_BAR(6);
    }
    if (IN(7)) {
        pg8::Gemm g{F.BUFA(), F.Wup_t(), M, DFF, DM}; pg8::StaticOrder S; S.init(M, DFF, F.G, (int)blockIdx.x);
        EpiBf E{F.VALPRE(), DFF};
        pg8::gemm_phase<EpiBf, pg8::StaticOrder, true, true>(F.lds + RING_OFF, g, S, E);
        if (BOTH(7)) GRID_BAR(7);
    }
    if (IN(8)) { act_pass(F, 0); if (BOTH(8)) GRID_BAR(8); }
    if (IN(9)) {
        pg8::Gemm g{F.BUFA(), F.Wup_t() + (size_t)DFF * DM, M, DFF, DM}; pg8::StaticOrder S; S.init(M, DFF, F.G, (int)blockIdx.x);
        EpiBf E{F.VALPRE(), DFF};
        pg8::gemm_phase<EpiBf, pg8::StaticOrder, true, true>(F.lds + RING_OFF, g, S, E);
        if (BOTH(9)) GRID_BAR(9);
    }
    if (IN(10)) { act_pass(F, 1); if (BOTH(10)) GRID_BAR(10); }
    if (IN(11)) {
        pg8::Gemm g{F.ACT(), F.Wdown_t(), M, DM, DFF}; pg8::StaticOrder S; S.init(M, DM, F.G, (int)blockIdx.x);
        EpiRes E{F.x_p(), F.x_s(), F.out(), 1};
        pg8::gemm_phase<EpiRes, pg8::StaticOrder, true, true>(F.lds + RING_OFF, g, S, E);
    }
#undef IN
#undef BOTH
}

extern "C" void kernel_launch(void* const* d_in, const int* in_sizes, int n_in, void* d_out, int out_size, void* d_ws, size_t ws_size, hipStream_t stream) {
    static int grid = 0;
    if (grid == 0) {
        if (n_in != 26 || out_size != (int)O_END || ws_size < WS_END) { fprintf(stderr, "kernel_launch: unexpected shapes (n_in %d, out %d, ws %zu); nothing launched\n", n_in, out_size, ws_size); grid = -1; return; }
        int dev = 0, cus = 0, per_cu = 0;
        if (hipGetDevice(&dev) != hipSuccess || hipDeviceGetAttribute(&cus, hipDeviceAttributeMultiprocessorCount, dev) != hipSuccess) { grid = -1; return; }
        if (hipFuncSetAttribute((const void*)hymba_fwd, hipFuncAttributeMaxDynamicSharedMemorySize, LDS_BYTES) != hipSuccess) { fprintf(stderr, "kernel_launch: hipFuncSetAttribute failed\n"); grid = -1; return; }
        if (hipOccupancyMaxActiveBlocksPerMultiprocessor(&per_cu, (const void*)hymba_fwd, NWAVES * 64, LDS_BYTES) != hipSuccess || per_cu < 1) { fprintf(stderr, "kernel_launch: occupancy query reports %d blocks per CU\n", per_cu); }
        (void)hipGetLastError();
        grid = cus;
        if (MK_GRID) grid = MK_GRID;
    }
    if (grid < 0) return;
    if (hipMemsetAsync((char*)d_ws + WS_CTL, 0, CTL_ZERO_BYTES, stream) != hipSuccess) return;
    Args a{};
    for (int i = 0; i < 26; ++i) a.in[i] = (const float*)d_in[i];
    a.out = (float*)d_out; a.ws = (unsigned char*)d_ws;
    const int nl = MK_PER_PHASE ? NPH : 1;
    for (int li = 0; li < nl; ++li) {
        a.ph_lo = MK_PER_PHASE ? li : 0; a.ph_hi = MK_PER_PHASE ? li + 1 : NPH; a.li = li;
        hipLaunchKernelGGL(hymba_fwd, dim3(grid), dim3(NWAVES * 64), LDS_BYTES, stream, a);
        const hipError_t le = hipPeekAtLastError();
        if (le != hipSuccess) { fprintf(stderr, "kernel_launch: launch %d failed: %s\n", li, hipGetErrorName(le)); break; }
    }
}
```

```cpp
#include <hip/hip_runtime.h>
#include <cstdio>
#include <cstdint>
#define MK_PER_PHASE 0
namespace pg8 {
#define PG8_LAS __attribute__((address_space(3)))
typedef unsigned short bf16_t;
typedef short bf16x8 __attribute__((ext_vector_type(8)));
typedef float f32x4 __attribute__((ext_vector_type(4)));
typedef unsigned u32x4 __attribute__((ext_vector_type(4)));
constexpr int BM = 256, BK = 64, HALF = 128, HTB = HALF * BK * 2  , STAGE_BYTES = 8 * HTB, NXCD = 8, WGM = 8;

__host__ __device__ __forceinline__ int lds_byte(int r, int c) { const int st = (r >> 4) * 2 + (c >> 5), rr = r & 15, cc = c & 31, ob = rr * 64 + cc * 2; return st * 1024 + (ob ^ (((ob >> 9) & 1) << 5)); }
__host__ __device__ __forceinline__ void stage_rc(int b, int& R, int& C) { const int st = b / 1024, sb = b % 1024, swz = sb ^ (((sb >> 9) & 1) << 5); R = (st >> 1) * 16 + swz / 64; C = (st & 1) * 32 + (swz % 64) / 2; }
__host__ __device__ __forceinline__ int perm32(int rho) { const int n = rho >> 4, i = rho & 15; return 8 * (i >> 2) + 4 * n + (i & 3); }

struct Unit { int pm, pn, k0, nt, ks; };
struct Gemm { const bf16_t* A; const bf16_t* Bt; int M, N, K; };

struct StaticOrder {
    int nM, nN, nwg, G, c, ntK, nsplit;
    __host__ __device__ void init(int M, int N, int G_, int c_, int ntK_, int nsplit_ = 0) { nM = M / BM; nN = N / BM; nwg = nM * nN; G = G_; c = c_; ntK = ntK_; nsplit = nsplit_; }
    __host__ __device__ __forceinline__ bool next(int i, Unit& u) const {
        const long L = (long)i * G + c;
        int pm, pn, k0 = 0, nt = ntK, ks = -1; bool ok = true;
        if (L >= nwg) {
            const int s = (int)(L - nwg); ok = (nsplit != 0) && (s < 2 * nN * nsplit);
            const int nsp = nsplit > 0 ? nsplit : 1, tile = s / nsp; ks = s - tile * nsp; pm = nM + tile / nN; pn = tile % nN; nt = ntK / nsp; k0 = ks * nt;
        } else {
            int wgid = (int)L; { const int q = nwg / NXCD, r = nwg % NXCD, xcd = wgid % NXCD, off = wgid / NXCD; wgid = (xcd < r ? xcd * (q + 1) : r * (q + 1) + (xcd - r) * q) + off; }
            const int nig = WGM * nN, gid = wgid / nig, fm = gid * WGM, gsz = (nM - fm) < WGM ? (nM - fm) : WGM;
            pm = fm + ((wgid % nig) % gsz); pn = (wgid % nig) / gsz;
        }
        u.pm = pm; u.pn = pn; u.k0 = k0; u.nt = nt; u.ks = ks; return ok;
    }
    __device__ __forceinline__ void a_ready(const Unit&) const {}
    __device__ __forceinline__ void done(const Unit&) const {}
};

__device__ __forceinline__ unsigned cvt_pk_bf16(float lo, float hi) { unsigned r; asm volatile("v_cvt_pk_bf16_f32 %0, %1, %2" : "=v"(r) : "v"(lo), "v"(hi)); return r; }
typedef float f32x2 __attribute__((ext_vector_type(2)));
template <class Epi, class Sched, bool ALIGN_EPI = false, bool SP2 = false>
__device__ __forceinline__ void gemm_phase(PG8_LAS unsigned char* lds, const Gemm g, const Sched& S, const Epi& E) {
    const int tid = threadIdx.x, wid = __builtin_amdgcn_readfirstlane(tid >> 6), lane = tid & 63, wr = wid >> 2, wc = wid & 3, fr = lane & 15, fq = lane >> 4;
    const int K = g.K;
    unsigned voffA[2], voffB[2];
#pragma unroll
    for (int i = 0; i < 2; ++i) { int R, C; stage_rc(tid * 16 + i * 8192, R, C); const int Rb = Epi::PERM ? ((R & ~31) + perm32(R & 31)) : R;
        voffA[i] = (unsigned)(R * K + C) * 2u; voffB[i] = (unsigned)(Rb * K + C) * 2u; }
    const size_t kstep = (size_t)(BK * 2);
    const size_t hstep = (size_t)HALF * K * 2;
    const size_t tstep = 2 * hstep;
    const unsigned ldsw = (unsigned)wid * 1024u;
    const int aoff = lds_byte(wr * 64 + fr, fq * 8), boff = lds_byte(wc * 32 + fr, fq * 8);
#define PG8_SA(b, h) (((b) * 2 + (h)) * HTB)
#define PG8_SB(b, h) ((4 + (b) * 2 + (h)) * HTB)
#define PG8_STAGE(bufoff, gbase, voff) do { _Pragma("unroll") for (int _i = 0; _i < 2; ++_i) \
        __builtin_amdgcn_global_load_lds((const unsigned*)((const char*)(gbase) + (voff)[_i]), (PG8_LAS unsigned*)(lds + (bufoff) + ldsw + _i * 8192), 16, 0, 0); } while (0)
#define PG8_LDA(dst, b, h) do { _Pragma("unroll") for (int m = 0; m < 4; ++m) _Pragma("unroll") for (int k = 0; k < 2; ++k) dst[m][k] = *(const PG8_LAS bf16x8*)(lds + PG8_SA(b, h) + aoff + m * 2048 + k * 1024); } while (0)
#define PG8_LDB(dst, b, h) do { _Pragma("unroll") for (int n = 0; n < 2; ++n) _Pragma("unroll") for (int k = 0; k < 2; ++k) dst[n][k] = *(const PG8_LAS bf16x8*)(lds + PG8_SB(b, h) + boff + n * 2048 + k * 1024); } while (0)
#define PG8_MMA(ai, bj, At, Bt) do { __builtin_amdgcn_s_setprio(1); _Pragma("unroll") for (int m = 0; m < 4; ++m) _Pragma("unroll") for (int n = 0; n < 2; ++n) _Pragma("unroll") for (int k = 0; k < 2; ++k) \
        acc[ai][bj][m][n] = __builtin_amdgcn_mfma_f32_16x16x32_bf16(Bt[n][k], At[m][k], acc[ai][bj][m][n], 0, 0, 0); __builtin_amdgcn_s_setprio(0); } while (0)
#define PG8_WAIT_V(n) asm volatile("s_waitcnt vmcnt(" #n ")" ::: "memory")
#define PG8_WAIT_L(n) asm volatile("s_waitcnt lgkmcnt(" #n ")" ::: "memory")
#define PG8_BAR __builtin_amdgcn_s_barrier()
#define PG8_SCHED __builtin_amdgcn_sched_barrier(0)
    Unit cur, nxt; int ui = 0;
    if (!S.next(0, cur)) return;
    f32x4 acc[2][2][4][2];
#pragma unroll
    for (int a = 0; a < 2; ++a)
#pragma unroll
        for (int b = 0; b < 2; ++b)
#pragma unroll
            for (int m = 0; m < 4; ++m)
#pragma unroll
                for (int n = 0; n < 2; ++n) acc[a][b][m][n] = (f32x4){0.f, 0.f, 0.f, 0.f};
    bf16x8 At[4][2], B0[2][2], B1[2][2];
    const char* cA = (const char*)g.A + (size_t)cur.pm * tstep + (size_t)cur.k0 * kstep; const char* cB = (const char*)g.Bt + (size_t)cur.pn * tstep + (size_t)cur.k0 * kstep;
    S.a_ready(cur);
    if constexpr (SP2) {
        PG8_STAGE(PG8_SB(0, 0), cB, voffB); PG8_STAGE(PG8_SB(0, 1), cB + hstep, voffB); PG8_STAGE(PG8_SA(0, 0), cA, voffA); PG8_STAGE(PG8_SA(0, 1), cA + hstep, voffA);
        if (wr == 1) PG8_BAR;
        PG8_WAIT_V(2); PG8_BAR;
        PG8_STAGE(PG8_SB(1, 0), cB + kstep, voffB); PG8_STAGE(PG8_SA(1, 0), cA + kstep, voffA); PG8_STAGE(PG8_SB(1, 1), cB + hstep + kstep, voffB);
        PG8_WAIT_V(6); PG8_BAR;
    } else {
        PG8_STAGE(PG8_SB(0, 0), cB, voffB); PG8_STAGE(PG8_SA(0, 0), cA, voffA); PG8_STAGE(PG8_SB(0, 1), cB + hstep, voffB); PG8_STAGE(PG8_SA(0, 1), cA + hstep, voffA);
        if (wr == 1) PG8_BAR;
        PG8_WAIT_V(4); PG8_BAR;
        PG8_STAGE(PG8_SB(1, 0), cB + kstep, voffB); PG8_STAGE(PG8_SA(1, 0), cA + kstep, voffA); PG8_STAGE(PG8_SB(1, 1), cB + hstep + kstep, voffB);
        PG8_WAIT_V(6); PG8_BAR;
    }
    for (;;) {
        const bool has_next = S.next(ui + 1, nxt);
        const char* nA = has_next ? (const char*)g.A + (size_t)nxt.pm * tstep + (size_t)nxt.k0 * kstep : cA; const char* nB = has_next ? (const char*)g.Bt + (size_t)nxt.pn * tstep + (size_t)nxt.k0 * kstep : cB;
        const int nt = cur.nt;
        for (int t = 0; t < nt; t += 2) {
            const bool last = (t == nt - 2);
            const char* a1 = cA + (size_t)(t + 1) * kstep;
            const char* a2 = last ? nA : cA + (size_t)(t + 2) * kstep; const char* b2 = last ? nB : cB + (size_t)(t + 2) * kstep;
            const char* a3 = a2 + kstep; const char* b3 = b2 + kstep;
            if (last && has_next) S.a_ready(nxt);
            if constexpr (SP2) {
            PG8_LDB(B0, 0, 0); PG8_LDB(B1, 0, 1); PG8_SCHED; PG8_LDA(At, 0, 0); PG8_STAGE(PG8_SA(1, 1), a1 + hstep, voffA);
            PG8_WAIT_V(8); PG8_WAIT_L(0); PG8_BAR; PG8_MMA(0, 0, At, B0); PG8_MMA(0, 1, At, B1); PG8_BAR; PG8_SCHED;
            PG8_LDA(At, 0, 1); PG8_STAGE(PG8_SB(0, 0), b2, voffB); PG8_STAGE(PG8_SB(0, 1), b2 + hstep, voffB); PG8_STAGE(PG8_SA(0, 0), a2, voffA);
            PG8_WAIT_V(8); PG8_WAIT_L(0); PG8_BAR; PG8_MMA(1, 0, At, B0); PG8_MMA(1, 1, At, B1); PG8_BAR; PG8_SCHED;
            PG8_LDB(B0, 1, 0); PG8_LDB(B1, 1, 1); PG8_SCHED; PG8_LDA(At, 1, 0); PG8_STAGE(PG8_SA(0, 1), a2 + hstep, voffA);
            PG8_WAIT_V(8); PG8_WAIT_L(0); PG8_BAR; PG8_MMA(0, 0, At, B0); PG8_MMA(0, 1, At, B1); PG8_BAR; PG8_SCHED;
            PG8_LDA(At, 1, 1); PG8_STAGE(PG8_SB(1, 0), b3, voffB); PG8_STAGE(PG8_SB(1, 1), b3 + hstep, voffB); PG8_STAGE(PG8_SA(1, 0), a3, voffA);
            PG8_WAIT_V(8); PG8_WAIT_L(0); PG8_BAR; PG8_MMA(1, 0, At, B0); PG8_MMA(1, 1, At, B1); PG8_BAR; PG8_SCHED;
            } else {
            PG8_LDB(B0, 0, 0); PG8_SCHED; PG8_LDA(At, 0, 0); PG8_STAGE(PG8_SA(1, 1), a1 + hstep, voffA);
            PG8_WAIT_L(8); PG8_BAR; PG8_WAIT_L(0); PG8_MMA(0, 0, At, B0); PG8_BAR; PG8_SCHED;
            PG8_LDB(B1, 0, 1); PG8_STAGE(PG8_SB(0, 0), b2, voffB);
            PG8_BAR; PG8_WAIT_L(0); PG8_MMA(0, 1, At, B1); PG8_BAR;
            PG8_LDA(At, 0, 1); PG8_STAGE(PG8_SA(0, 0), a2, voffA);
            PG8_BAR; PG8_WAIT_L(0); PG8_MMA(1, 0, At, B0); PG8_BAR; PG8_SCHED;
            PG8_STAGE(PG8_SB(0, 1), b2 + hstep, voffB);
            PG8_WAIT_V(6); PG8_BAR; PG8_MMA(1, 1, At, B1); PG8_BAR;
            PG8_LDB(B0, 1, 0); PG8_SCHED; PG8_LDA(At, 1, 0); PG8_STAGE(PG8_SA(0, 1), a2 + hstep, voffA);
            PG8_WAIT_L(8); PG8_BAR; PG8_WAIT_L(0); PG8_MMA(0, 0, At, B0); PG8_BAR; PG8_SCHED;
            PG8_LDB(B1, 1, 1); PG8_STAGE(PG8_SB(1, 0), b3, voffB);
            PG8_BAR; PG8_WAIT_L(0); PG8_MMA(0, 1, At, B1); PG8_BAR;
            PG8_LDA(At, 1, 1); PG8_STAGE(PG8_SA(1, 0), a3, voffA);
            PG8_BAR; PG8_WAIT_L(0); PG8_MMA(1, 0, At, B0); PG8_BAR; PG8_SCHED;
            PG8_STAGE(PG8_SB(1, 1), b3 + hstep, voffB);
            PG8_WAIT_V(6); PG8_BAR; PG8_MMA(1, 1, At, B1); PG8_BAR;
            }
        }
        if constexpr (ALIGN_EPI) { if (wr == 0) PG8_BAR; }
        if constexpr (!Epi::AFTER_DRAIN) { E(acc, cur, wr, wc, fr, fq); S.done(cur); }
        if (!has_next) break;
#pragma unroll
        for (int a = 0; a < 2; ++a)
#pragma unroll
            for (int b = 0; b < 2; ++b)
#pragma unroll
                for (int m = 0; m < 4; ++m)
#pragma unroll
                    for (int n = 0; n < 2; ++n) acc[a][b][m][n] = (f32x4){0.f, 0.f, 0.f, 0.f};
        cur = nxt; cA = nA; cB = nB; ++ui;
        if constexpr (ALIGN_EPI) { if (wr == 1) PG8_BAR; }
    }
    PG8_WAIT_V(0);
    if constexpr (!ALIGN_EPI) { if (wr == 0) PG8_BAR; }
    PG8_BAR;
    if constexpr (Epi::AFTER_DRAIN) { E.fused(acc, cur, wr, wc, fr, fq, lds, wid, lane); S.done(cur); }
#undef PG8_SA
#undef PG8_SB
#undef PG8_STAGE
#undef PG8_LDA
#undef PG8_LDB
#undef PG8_MMA
#undef PG8_WAIT_V
#undef PG8_WAIT_L
#undef PG8_BAR
#undef PG8_SCHED
}
}

constexpr int DM = 4096, SEQ = 16384, DBATCH = 16, DSEQ = 32, PAST = 4096, HD = 128, NH = 8, DSB = 1024, DLRU = 3072, NBLK = 16, BD = 192, DIN = 9216, DFF = 12288;
constexpr int MP = SEQ, MS = DBATCH * DSEQ, M = MP + MS;
constexpr float EPS = 1e-6f;
constexpr int NWAVES = 8;
#ifndef MK_PER_PHASE
#define MK_PER_PHASE 0
#endif
#ifndef MK_GRID
#define MK_GRID 0
#endif

constexpr size_t O_Y = 0, O_KP = (size_t)M * DM, O_VP = O_KP + (size_t)MP * DSB, O_HP = O_VP + (size_t)MP * DSB, O_CP = O_HP + DLRU, O_FP = O_CP + 3 * DLRU,
                 O_KS = O_FP + 2 * DFF, O_VS = O_KS + (size_t)MS * DSB, O_HS = O_VS + (size_t)MS * DSB, O_CS = O_HS + (size_t)DBATCH * DLRU, O_FS = O_CS + (size_t)DBATCH * 3 * DLRU,
                 O_END = O_FS + (size_t)DBATCH * 2 * DFF;
static_assert(O_END == 104435712, "d_out size");

constexpr size_t MiB = 1u << 20;
constexpr size_t WS_CTL = 0, CTL_ZERO_BYTES = 1 * MiB;
constexpr size_t WS_WA = 1 * MiB, WS_WX = WS_WA + (size_t)NBLK * BD * BD * 2;
constexpr size_t WS_AGGA = 4 * MiB, WS_AGGB = 7 * MiB;
constexpr size_t WS_C8 = 10 * MiB, WS_SSQS = 11 * MiB, WS_CARRY = 12 * MiB;
constexpr size_t WS_HALO = 832 * MiB, WS_DEFC = 840 * MiB, WS_DEFV = 848 * MiB;
constexpr size_t WS_Z = 970 * MiB;
constexpr size_t WS_WDOWN = 16 * MiB, WS_WUP = 112 * MiB, WS_BUFA = 304 * MiB, WS_ACT = 436 * MiB, WS_VALPRE = 832 * MiB, WS_PART = 1228 * MiB, WS_END = 1292 * MiB;
constexpr size_t WS_WIN = 436 * MiB, WS_WOUT = 508 * MiB, WS_U = 540 * MiB, WS_G = 639 * MiB, WS_QN = 738 * MiB, WS_KN = 771 * MiB, WS_VB = 804 * MiB, WS_Y = 837 * MiB;
static_assert(WS_WX + (size_t)NBLK * BD * BD * 2 <= WS_AGGA && WS_SSQS + (size_t)M * 8 * 4 <= WS_CARRY && WS_CARRY + (size_t)256 * DLRU * 4 <= WS_WDOWN, "ws map (small)");
static_assert(WS_Z >= WS_Y + (size_t)M * DM * 2 && WS_Z + (size_t)MP * DLRU * 2 <= WS_PART, "ws map (Z)");
static_assert(WS_WDOWN + (size_t)DM * DFF * 2 <= WS_WUP && WS_WUP + (size_t)2 * DFF * DM * 2 <= WS_BUFA && WS_BUFA + (size_t)M * DM * 2 <= WS_ACT, "ws map (weights)");
static_assert(WS_ACT + (size_t)M * DFF * 2 <= WS_VALPRE && WS_VALPRE + (size_t)M * DFF * 2 <= WS_PART && WS_PART + (size_t)8 * MS * DM * 4 <= WS_END, "ws map (ffn)");
static_assert(WS_WIN + (size_t)DIN * DM * 2 <= WS_WOUT && WS_WOUT + (size_t)DM * DM * 2 <= WS_U && WS_U + (size_t)M * DLRU * 2 <= WS_G && WS_G + (size_t)M * DLRU * 2 <= WS_QN, "ws map (early 1)");
static_assert(WS_QN + (size_t)M * DSB * 2 <= WS_KN && WS_KN + (size_t)M * DSB * 2 <= WS_VB && WS_VB + (size_t)M * DSB * 2 <= WS_Y && WS_Y + (size_t)M * DM * 2 <= WS_PART, "ws map (early 2)");
constexpr int CW_TMO = 0, CW_CODE = 1, CW_BAR = 4096;

constexpr int RING_OFF = 0, RING_BYTES = 131072;
constexpr int EPI_OFF = RING_BYTES, EPI_BYTES = 8192;
constexpr int LDSCTL_OFF = EPI_OFF + EPI_BYTES, MISC_OFF = LDSCTL_OFF + 320;
constexpr int LDS_BYTES = 147456;
static_assert(MISC_OFF + 128 <= LDS_BYTES, "LDS map");

#define GAS __attribute__((address_space(1)))
#define LAS __attribute__((address_space(3)))
typedef unsigned short bf16;
typedef unsigned v4u __attribute__((ext_vector_type(4)));
typedef unsigned v2u __attribute__((ext_vector_type(2)));
typedef float f32x4 __attribute__((ext_vector_type(4)));
typedef short bf16x8 __attribute__((ext_vector_type(8)));
typedef GAS unsigned gu32;
#define RLX_AGENT __ATOMIC_RELAXED, __HIP_MEMORY_SCOPE_AGENT
#define LDS_WAIT() asm volatile("s_waitcnt lgkmcnt(0)" ::: "memory")
#define VM_WAIT() asm volatile("s_waitcnt vmcnt(0)" ::: "memory")
#define WG_BAR() do { asm volatile("s_waitcnt lgkmcnt(0)" ::: "memory"); __builtin_amdgcn_s_barrier(); asm volatile("" ::: "memory"); } while (0)
using pg8::cvt_pk_bf16;
__device__ __forceinline__ float bflo(unsigned w) { return __builtin_bit_cast(float, w << 16); }
__device__ __forceinline__ float bfhi(unsigned w) { return __builtin_bit_cast(float, w & 0xffff0000u); }
__device__ __forceinline__ float fexp2(float x) { return __builtin_amdgcn_exp2f(x); }
__device__ __forceinline__ float flog2(float x) { return __builtin_amdgcn_logf(x); }
__device__ __forceinline__ float frcp(float x) { return __builtin_amdgcn_rcpf(x); }
__device__ __forceinline__ float sigmoidf_(float x) { return frcp(1.0f + fexp2(-1.4426950408889634f * x)); }
__device__ __forceinline__ float gelu_tanh(float x) { const float u = x * (1.0f + 0.044715f * x * x); return x * frcp(1.0f + fexp2(-2.302208198f * u)); }
__device__ __forceinline__ float wave_sum(float v) {
#pragma unroll
    for (int o = 1; o < 64; o <<= 1) v += __shfl_xor(v, o);
    return v;
}
template <int S> __device__ __forceinline__ float dpp_ror(float v) {
    return __builtin_bit_cast(float, __builtin_amdgcn_update_dpp(0, __builtin_bit_cast(int, v), 0x120 + S, 0xF, 0xF, false));
}
template <int S> __device__ __forceinline__ float dpp_shr(float oldv, float v) {
    return __builtin_bit_cast(float, __builtin_amdgcn_update_dpp(__builtin_bit_cast(int, oldv), __builtin_bit_cast(int, v), 0x110 + S, 0xF, 0xF, false));
}
__device__ __forceinline__ void row_scan_ab(float& a, float& b) {
    { const float ap = dpp_shr<1>(1.0f, a), bp = dpp_shr<1>(0.0f, b); b = a * bp + b; a = a * ap; }
    { const float ap = dpp_shr<2>(1.0f, a), bp = dpp_shr<2>(0.0f, b); b = a * bp + b; a = a * ap; }
    { const float ap = dpp_shr<4>(1.0f, a), bp = dpp_shr<4>(0.0f, b); b = a * bp + b; a = a * ap; }
    { const float ap = dpp_shr<8>(1.0f, a), bp = dpp_shr<8>(0.0f, b); b = a * bp + b; a = a * ap; }
}

#define XB_TMO      128
#define XB_XCNT(j)  (256  + 64 * (j))
#define XB_XSUB(j)  (1280 + 64 * (j))
#define XB_XGEN(j)  (2304 + 64 * (j))
#define XB_TOP      3328
#define XB_TOPGEN   3392
#define XCD_BAR_WORDS 3456
#define XB_SPIN_CAP (1u << 18)

__device__ __forceinline__ unsigned xb_ld(unsigned* p)              { return __hip_atomic_load(p, __ATOMIC_RELAXED, __HIP_MEMORY_SCOPE_AGENT); }
__device__ __forceinline__ unsigned xb_add(unsigned* p, unsigned v) { return __hip_atomic_fetch_add(p, v, __ATOMIC_RELAXED, __HIP_MEMORY_SCOPE_AGENT); }
__device__ __forceinline__ unsigned xb_xcc_id() { return (unsigned)__builtin_amdgcn_s_getreg((3 << 11) | 20) & 0xFu; }
#define XB_SPIN(cond, bar) do { unsigned _sp = 0; while (cond) { __builtin_amdgcn_s_sleep(1); \
    if ((++_sp & 255u) == 0u) { if (xb_ld(&(bar)[XB_TMO])) break; if (_sp > XB_SPIN_CAP) { atomicAdd(&(bar)[XB_TMO], 1u); break; } } } } while (0)

struct XcdBarrier {
    unsigned* bar; unsigned x;
    volatile LAS unsigned* st;
};

__device__ __forceinline__ XcdBarrier xcd_barrier_post(unsigned* bar, volatile LAS unsigned* st) {
    XcdBarrier b; b.bar = bar; b.x = xb_xcc_id(); b.st = st;
    if (threadIdx.x == 0) (void)xb_add(&bar[XB_XCNT(b.x)], 1u);
    return b;
}
__device__ __forceinline__ void xcd_barrier_complete(unsigned* bar, unsigned x, unsigned& nloc, unsigned& nx) {
    const unsigned G = gridDim.x * gridDim.y * gridDim.z;
    unsigned sum, cnt, mine, sp = 0u;
    for (;;) {
        sum = 0u; cnt = 0u; mine = 0u;
#pragma unroll
        for (unsigned j = 0; j < 16; ++j) { const unsigned c = xb_ld(&bar[XB_XCNT(j)]); sum += c; cnt += (c > 0u) ? 1u : 0u; mine = (j == x) ? c : mine; }
        if (sum == G) break;
        __builtin_amdgcn_s_sleep(1);
        if ((++sp & 255u) == 0u) { if (xb_ld(&bar[XB_TMO])) break; if (sp > XB_SPIN_CAP) { atomicAdd(&bar[XB_TMO], 1u); break; } }
    }
    nloc = mine > 0u ? mine : 1u; nx = cnt > 0u ? cnt : 1u;
}

__device__ __forceinline__ void xcd_barrier(const XcdBarrier& b) {
    asm volatile("s_waitcnt vmcnt(0)" ::: "memory");
    __syncthreads();
    if (threadIdx.x == 0) {
        unsigned* bar = b.bar;
        __builtin_amdgcn_s_waitcnt(0);
        unsigned nloc = b.st[0], nx = b.st[1];
        if (nloc == 0u) { xcd_barrier_complete(bar, b.x, nloc, nx); b.st[0] = nloc; b.st[1] = nx; }
        const unsigned old = xb_add(&bar[XB_XSUB(b.x)], 1u);
        const unsigned gen = old / nloc;
        if (old + 1u == (gen + 1u) * nloc) {
            __builtin_amdgcn_fence(__ATOMIC_RELEASE, "agent");
            asm volatile("s_waitcnt vmcnt(0)" ::: "memory");
            const unsigned og = xb_add(&bar[XB_TOP], 1u);
            const unsigned tg = og / nx;
            if (og + 1u == (tg + 1u) * nx) xb_add(&bar[XB_TOPGEN], 1u);
            else XB_SPIN(xb_ld(&bar[XB_TOPGEN]) == tg, bar);
            __builtin_amdgcn_fence(__ATOMIC_ACQUIRE, "agent");
            xb_add(&bar[XB_XGEN(b.x)], 1u);
            asm volatile("s_waitcnt vmcnt(0)" ::: "memory");
        } else {
            XB_SPIN(xb_ld(&bar[XB_XGEN(b.x)]) == gen, bar);
            __builtin_amdgcn_fence(__ATOMIC_ACQUIRE, "agent");
            asm volatile("s_waitcnt vmcnt(0)" ::: "memory");
        }
    }
    __syncthreads();
}

struct Args { const float* in[26]; float* out; unsigned char* ws; int ph_lo, ph_hi, li, pad; };
struct Frame {
    LAS unsigned char* lds;
    volatile LAS unsigned* MISC;
    gu32* ctl;
    int tid, lane, wave, vcu, G;
    const Args* a;
    __device__ __forceinline__ const float* x_p() const { return a->in[0]; }
    __device__ __forceinline__ const float* x_s() const { return a->in[1]; }
    __device__ __forceinline__ const float* cache_k() const { return a->in[2]; }
    __device__ __forceinline__ const float* cache_v() const { return a->in[3]; }
    __device__ __forceinline__ const float* st_h() const { return a->in[4]; }
    __device__ __forceinline__ const float* st_conv() const { return a->in[5]; }
    __device__ __forceinline__ const float* st_ffn() const { return a->in[6]; }
    __device__ __forceinline__ const float* g_mix() const { return a->in[7]; }
    __device__ __forceinline__ const float* w_in() const { return a->in[8]; }
    __device__ __forceinline__ const float* cw() const { return a->in[9]; }
    __device__ __forceinline__ const float* cb() const { return a->in[10]; }
    __device__ __forceinline__ const float* w_a() const { return a->in[11]; }
    __device__ __forceinline__ const float* b_a() const { return a->in[12]; }
    __device__ __forceinline__ const float* w_x() const { return a->in[13]; }
    __device__ __forceinline__ const float* b_x() const { return a->in[14]; }
    __device__ __forceinline__ const float* lam() const { return a->in[15]; }
    __device__ __forceinline__ const float* qg() const { return a->in[16]; }
    __device__ __forceinline__ const float* kg() const { return a->in[17]; }
    __device__ __forceinline__ const float* g_lru() const { return a->in[18]; }
    __device__ __forceinline__ const float* g_sb() const { return a->in[19]; }
    __device__ __forceinline__ const float* w_out() const { return a->in[20]; }
    __device__ __forceinline__ const float* g_ffn() const { return a->in[21]; }
    __device__ __forceinline__ const float* w_up() const { return a->in[22]; }
    __device__ __forceinline__ const float* fcw() const { return a->in[23]; }
    __device__ __forceinline__ const float* fcb() const { return a->in[24]; }
    __device__ __forceinline__ const float* w_down() const { return a->in[25]; }
    __device__ __forceinline__ float* out() const { return a->out; }
    __device__ __forceinline__ bf16* Wa_t() const { return (bf16*)(a->ws + WS_WA); }
    __device__ __forceinline__ bf16* Wx_t() const { return (bf16*)(a->ws + WS_WX); }
    __device__ __forceinline__ bf16* Win_t() const { return (bf16*)(a->ws + WS_WIN); }
    __device__ __forceinline__ bf16* Wout_t() const { return (bf16*)(a->ws + WS_WOUT); }
    __device__ __forceinline__ bf16* Wup_t() const { return (bf16*)(a->ws + WS_WUP); }
    __device__ __forceinline__ bf16* Wdown_t() const { return (bf16*)(a->ws + WS_WDOWN); }
    __device__ __forceinline__ bf16* BUFA() const { return (bf16*)(a->ws + WS_BUFA); }
    __device__ __forceinline__ bf16* ACT() const { return (bf16*)(a->ws + WS_ACT); }
    __device__ __forceinline__ bf16* VALPRE() const { return (bf16*)(a->ws + WS_VALPRE); }
    __device__ __forceinline__ bf16* U() const { return (bf16*)(a->ws + WS_U); }
    __device__ __forceinline__ bf16* Gt() const { return (bf16*)(a->ws + WS_G); }
    __device__ __forceinline__ bf16* Qn() const { return (bf16*)(a->ws + WS_QN); }
    __device__ __forceinline__ bf16* Kn() const { return (bf16*)(a->ws + WS_KN); }
    __device__ __forceinline__ bf16* Vb() const { return (bf16*)(a->ws + WS_VB); }
    __device__ __forceinline__ bf16* Y() const { return (bf16*)(a->ws + WS_Y); }
    __device__ __forceinline__ float* AggA() const { return (float*)(a->ws + WS_AGGA); }
    __device__ __forceinline__ float* AggB() const { return (float*)(a->ws + WS_AGGB); }
    __device__ __forceinline__ float* C8() const { return (float*)(a->ws + WS_C8); }
    __device__ __forceinline__ float* Carry() const { return (float*)(a->ws + WS_CARRY); }
    __device__ __forceinline__ bf16* Z() const { return (bf16*)(a->ws + WS_Z); }
    __device__ __forceinline__ float* Part() const { return (float*)(a->ws + WS_PART); }
    __device__ __forceinline__ float* Halo() const { return (float*)(a->ws + WS_HALO); }
    __device__ __forceinline__ float* DefC() const { return (float*)(a->ws + WS_DEFC); }
    __device__ __forceinline__ float* DefV() const { return (float*)(a->ws + WS_DEFV); }
    __device__ __forceinline__ float* SsqS() const { return (float*)(a->ws + WS_SSQS); }
};

__device__ __forceinline__ void p0_transpose_item(const float* W, int K, int N, bf16* WT, int k0, int n0, int drow, LAS float* scr, int lane) {
#pragma unroll 8
    for (int i = 0; i < 32; ++i) { const int kk = 2 * i + (lane >> 5); scr[kk * 33 + (lane & 31)] = W[(size_t)(k0 + kk) * N + n0 + (lane & 31)]; }
    LDS_WAIT(); asm volatile("" ::: "memory");
    const int c = lane & 7;
#pragma unroll
    for (int j = 0; j < 4; ++j) { const int n = (lane >> 3) + 8 * j; const LAS float* s = scr + (8 * c) * 33 + n;
        v4u o; o.x = cvt_pk_bf16(s[0 * 33], s[1 * 33]); o.y = cvt_pk_bf16(s[2 * 33], s[3 * 33]); o.z = cvt_pk_bf16(s[4 * 33], s[5 * 33]); o.w = cvt_pk_bf16(s[6 * 33], s[7 * 33]);
        *(GAS v4u*)(WT + (size_t)(drow + n) * K + k0 + 8 * c) = o; }
    LDS_WAIT(); asm volatile("" ::: "memory");
}
__device__ __forceinline__ void rms_row_to_bf16(const float* xrow, const float* g, bf16* orow, int lane) {
    const GAS f32x4* xr = (const GAS f32x4*)xrow + lane;
    f32x4 v[16]; float s = 0.f;
#pragma unroll
    for (int j = 0; j < 16; ++j) { v[j] = xr[64 * j]; s += (v[j].x * v[j].x + v[j].y * v[j].y) + (v[j].z * v[j].z + v[j].w * v[j].w); }
    const float rs = 1.0f / sqrtf(wave_sum(s) * (1.0f / DM) + EPS);
    const GAS f32x4* gr = (const GAS f32x4*)g + lane;
    GAS v2u* o8 = (GAS v2u*)orow + lane;
#pragma unroll
    for (int j = 0; j < 16; ++j) { const f32x4 gv = gr[64 * j]; v2u o; o.x = cvt_pk_bf16(v[j].x * rs * gv.x, v[j].y * rs * gv.y); o.y = cvt_pk_bf16(v[j].z * rs * gv.z, v[j].w * rs * gv.w); o8[64 * j] = o; }
}
__device__ __forceinline__ void sample_row_reduce(const float* base, const float* part, int rs, float* dst, const float* g, bf16* orow, int lane) {
    f32x4 v[16]; float s = 0.f;
#pragma unroll
    for (int j = 0; j < 16; ++j) v[j] = ((const GAS f32x4*)base)[lane + 64 * j];
#pragma unroll 2
    for (int ks = 0; ks < 8; ++ks) { const GAS f32x4* pr = (const GAS f32x4*)(part + ((size_t)ks * MS + rs) * DM) + lane;
#pragma unroll
        for (int j = 0; j < 16; ++j) v[j] = v[j] + pr[64 * j]; }
#pragma unroll
    for (int j = 0; j < 16; ++j) { ((GAS f32x4*)dst)[lane + 64 * j] = v[j]; s += (v[j].x * v[j].x + v[j].y * v[j].y) + (v[j].z * v[j].z + v[j].w * v[j].w); }
    if (orow) {
        const float rsn = 1.0f / sqrtf(wave_sum(s) * (1.0f / DM) + EPS);
        const GAS f32x4* gr = (const GAS f32x4*)g + lane; GAS v2u* o8 = (GAS v2u*)orow + lane;
#pragma unroll
        for (int j = 0; j < 16; ++j) { const f32x4 gv = gr[64 * j]; v2u o; o.x = cvt_pk_bf16(v[j].x * rsn * gv.x, v[j].y * rsn * gv.y); o.y = cvt_pk_bf16(v[j].z * rsn * gv.z, v[j].w * rsn * gv.w); o8[64 * j] = o; }
    }
}
__device__ __forceinline__ void p0_prologue(Frame& F) {
    LAS float* scr = (LAS float*)(F.lds + RING_OFF + F.wave * 16384);
    const int gw = F.vcu * NWAVES + F.wave, NGW = F.G * NWAVES;
    constexpr int I_IN = (DM / 64) * (DIN / 32), I_OUT = (DM / 64) * (DM / 32), I_UP = (DM / 64) * (2 * DFF / 32), I_DN = (DFF / 64) * (DM / 32), I_G = NBLK * 3 * 6;
    constexpr int NITEMS = I_IN + I_OUT + I_UP + I_DN + 2 * I_G;
    for (int it = gw; it < NITEMS; it += NGW) {
        int r = it;
        if (r < I_IN) { const int nb = DIN / 32, kb = r / nb, n0 = 32 * (r % nb); p0_transpose_item(F.w_in(), DM, DIN, F.Win_t(), 64 * kb, n0, n0, scr, F.lane); continue; } r -= I_IN;
        if (r < I_OUT) { const int nb = DM / 32, kb = r / nb, n0 = 32 * (r % nb); p0_transpose_item(F.w_out(), DM, DM, F.Wout_t(), 64 * kb, n0, n0, scr, F.lane); continue; } r -= I_OUT;
        if (r < I_UP) { const int nb = 2 * DFF / 32, kb = r / nb, n0 = 32 * (r % nb);
            const int f = n0 < DFF ? n0 : n0 - DFF; const int drow = 256 * (f >> 7) + (n0 < DFF ? 0 : 128) + (f & 127);
            p0_transpose_item(F.w_up(), DM, 2 * DFF, F.Wup_t(), 64 * kb, n0, drow, scr, F.lane); continue; } r -= I_UP;
        if (r < I_DN) { const int nb = DM / 32, kb = r / nb, n0 = 32 * (r % nb); p0_transpose_item(F.w_down(), DFF, DM, F.Wdown_t(), 64 * kb, n0, n0, scr, F.lane); continue; } r -= I_DN;
        { const int which = r / I_G; r -= which * I_G; const int blk = r / 18, q = r % 18, kb = q / 6, n0 = 32 * (q % 6);
          p0_transpose_item((which ? F.w_x() : F.w_a()) + (size_t)blk * BD * BD, BD, BD, (which ? F.Wx_t() : F.Wa_t()) + (size_t)blk * BD * BD, 64 * kb, n0, n0, scr, F.lane); }
    }
    if (gw < DLRU / 64) { const int ch = gw * 64 + F.lane; const float l = F.lam()[ch]; F.C8()[ch] = 8.0f * 1.4426950408889634f * (fminf(l, 0.f) - log1pf(expf(-fabsf(l)))); }
    for (int m = gw; m < M; m += NGW) rms_row_to_bf16(m < MP ? F.x_p() + (size_t)m * DM : F.x_s() + (size_t)(m - MP) * DM, F.g_mix(), F.BUFA() + (size_t)m * DM, F.lane);
}

struct Epi1 {
    static constexpr bool PERM = true, AFTER_DRAIN = false;
    bf16 *U, *G, *Qn, *Kn, *Vb; float* out; const float *qg, *kg; LAS float* P;
    __device__ __forceinline__ void operator()(const f32x4 (&acc)[2][2][4][2], const pg8::Unit& u, int wr, int wc, int fr, int fq) const {
        const int pn = u.pn, row0 = u.pm * 256 + wr * 64 + fr, cw8 = wc * 32 + 8 * fq;
        if (pn < 24) {
            bf16* base = pn < 12 ? U : G; const int col0 = (pn < 12 ? pn : pn - 12) * 256 + cw8;
#pragma unroll
            for (int ai = 0; ai < 2; ++ai)
#pragma unroll
                for (int m = 0; m < 4; ++m) { const int row = row0 + ai * 128 + m * 16; bf16* rowp = base + (size_t)row * DLRU + col0;
#pragma unroll
                    for (int bj = 0; bj < 2; ++bj) { const f32x4 v0 = acc[ai][bj][m][0], v1 = acc[ai][bj][m][1];
                        v4u w; w.x = cvt_pk_bf16(v0[0], v0[1]); w.y = cvt_pk_bf16(v0[2], v0[3]); w.z = cvt_pk_bf16(v1[0], v1[1]); w.w = cvt_pk_bf16(v1[2], v1[3]);
                        *(v4u*)(rowp + bj * 128) = w; }
                    if (pn < 12) {
                        float* cdst = nullptr;
                        if (row < MP) { if (row >= MP - 3) cdst = out + O_CP + (size_t)(row - (MP - 3)) * DLRU; }
                        else { const int t = (row - MP) & 31, b = (row - MP) >> 5; if (t >= 29) cdst = out + O_CS + (size_t)(b * 3 + (t - 29)) * DLRU; }
                        if (cdst) {
#pragma unroll
                            for (int bj = 0; bj < 2; ++bj) { *(f32x4*)(cdst + col0 + bj * 128) = acc[ai][bj][m][0]; *(f32x4*)(cdst + col0 + bj * 128 + 4) = acc[ai][bj][m][1]; } }
                    } }
        } else if (pn < 32) {
            const bool isk = pn >= 28; const float* gp = isk ? kg : qg;
#pragma unroll
            for (int ai = 0; ai < 2; ++ai)
#pragma unroll
                for (int m = 0; m < 4; ++m)
#pragma unroll
                    for (int bj = 0; bj < 2; ++bj) { const f32x4 v0 = acc[ai][bj][m][0], v1 = acc[ai][bj][m][1];
                        float s = (v0[0] * v0[0] + v0[1] * v0[1]) + (v0[2] * v0[2] + v0[3] * v0[3]) + (v1[0] * v1[0] + v1[1] * v1[1]) + (v1[2] * v1[2] + v1[3] * v1[3]);
                        s += __shfl_xor(s, 16); s += __shfl_xor(s, 32);
                        if (fq == 0) P[((ai * 128 + wr * 64 + m * 16 + fr) * 2 + bj) * 4 + wc] = s; }
            WG_BAR();
            const f32x4 g0 = *(const f32x4*)(gp + cw8), g1 = *(const f32x4*)(gp + cw8 + 4);
            bf16* base = isk ? Kn : Qn; const int col0 = (pn - (isk ? 28 : 24)) * 256 + cw8;
#pragma unroll
            for (int ai = 0; ai < 2; ++ai)
#pragma unroll
                for (int m = 0; m < 4; ++m) { const int row = row0 + ai * 128 + m * 16; bf16* rowp = base + (size_t)row * DSB + col0;
                    float* kdst = isk ? (row < MP ? out + O_KP + (size_t)row * DSB : out + O_KS + (size_t)(row - MP) * DSB) + col0 : nullptr;
#pragma unroll
                    for (int bj = 0; bj < 2; ++bj) { const f32x4 p = *(const LAS f32x4*)(P + ((ai * 128 + wr * 64 + m * 16 + fr) * 2 + bj) * 4);
                        const float sc = 1.0f / sqrtf(((p[0] + p[1]) + (p[2] + p[3])) * (1.0f / HD) + EPS);
                        const f32x4 v0 = acc[ai][bj][m][0] * sc * g0, v1 = acc[ai][bj][m][1] * sc * g1;
                        v4u w; w.x = cvt_pk_bf16(v0[0], v0[1]); w.y = cvt_pk_bf16(v0[2], v0[3]); w.z = cvt_pk_bf16(v1[0], v1[1]); w.w = cvt_pk_bf16(v1[2], v1[3]);
                        *(v4u*)(rowp + bj * 128) = w;
                        if (isk) { *(f32x4*)(kdst + bj * 128) = v0; *(f32x4*)(kdst + bj * 128 + 4) = v1; } } }
        } else {
            const int col0 = (pn - 32) * 256 + cw8;
#pragma unroll
            for (int ai = 0; ai < 2; ++ai)
#pragma unroll
                for (int m = 0; m < 4; ++m) { const int row = row0 + ai * 128 + m * 16; bf16* rowp = Vb + (size_t)row * DSB + col0;
                    float* vdst = (row < MP ? out + O_VP + (size_t)row * DSB : out + O_VS + (size_t)(row - MP) * DSB) + col0;
#pragma unroll
                    for (int bj = 0; bj < 2; ++bj) { const f32x4 v0 = acc[ai][bj][m][0], v1 = acc[ai][bj][m][1];
                        v4u w; w.x = cvt_pk_bf16(v0[0], v0[1]); w.y = cvt_pk_bf16(v0[2], v0[3]); w.z = cvt_pk_bf16(v1[0], v1[1]); w.w = cvt_pk_bf16(v1[2], v1[3]);
                        *(v4u*)(rowp + bj * 128) = w; *(f32x4*)(vdst + bj * 128) = v0; *(f32x4*)(vdst + bj * 128 + 4) = v1; } }
        }
    }
};
struct EpiRes {
    static constexpr bool PERM = false, AFTER_DRAIN = false;
    const float *xp, *xs; float* out; float* part; int inplace;
    __device__ __forceinline__ void operator()(const f32x4 (&acc)[2][2][4][2], const pg8::Unit& u, int wr, int wc, int fr, int fq) const {
        const int row0 = u.pm * 256 + wr * 64 + fr, col0 = u.pn * 256 + wc * 32 + 4 * fq;
        if (u.ks >= 0) {
#pragma unroll
            for (int ai = 0; ai < 2; ++ai)
#pragma unroll
                for (int m = 0; m < 4; ++m) { const int row = row0 + ai * 128 + m * 16; float* op = part + ((size_t)u.ks * MS + (row - MP)) * DM + col0;
#pragma unroll
                    for (int bj = 0; bj < 2; ++bj)
#pragma unroll
                        for (int n = 0; n < 2; ++n) *(f32x4*)(op + bj * 128 + n * 16) = acc[ai][bj][m][n]; }
            return;
        }
#pragma unroll
        for (int ai = 0; ai < 2; ++ai)
#pragma unroll
            for (int m = 0; m < 4; ++m) { const int row = row0 + ai * 128 + m * 16; float* op = out + O_Y + (size_t)row * DM + col0;
                const float* bp = inplace ? op : ((row < MP ? xp + (size_t)row * DM : xs + (size_t)(row - MP) * DM) + col0);
#pragma unroll
                for (int bj = 0; bj < 2; ++bj)
#pragma unroll
                    for (int n = 0; n < 2; ++n) { const f32x4 b = *(const f32x4*)(bp + bj * 128 + n * 16); *(f32x4*)(op + bj * 128 + n * 16) = b + acc[ai][bj][m][n]; } }
    }
};
struct EpiUp {
    static constexpr bool PERM = true, AFTER_DRAIN = false;
    bf16* ACT; const float *fcw, *fcb, *st_ffn; float* out; float *halo, *defc, *defv; LAS float* HX;
    __device__ __forceinline__ void operator()(const f32x4 (&acc)[2][2][4][2], const pg8::Unit& u, int wr, int wc, int fr, int fq) const {
        const int pm = u.pm, cl = wc * 32 + 8 * fq, f0 = u.pn * 128 + cl;
        const bool smp = pm >= MP / 256;
        const f32x4 w0a = *(const f32x4*)(fcw + f0), w0b = *(const f32x4*)(fcw + f0 + 4), w1a = *(const f32x4*)(fcw + DFF + f0), w1b = *(const f32x4*)(fcw + DFF + f0 + 4);
        const f32x4 w2a = *(const f32x4*)(fcw + 2 * DFF + f0), w2b = *(const f32x4*)(fcw + 2 * DFF + f0 + 4), cba = *(const f32x4*)(fcb + f0), cbb = *(const f32x4*)(fcb + f0 + 4);
        if (!smp && fr >= 14) {
#pragma unroll
            for (int ai = 0; ai < 2; ++ai) { LAS f32x4* hp = (LAS f32x4*)(HX + (((ai * 2 + wr) * 2 + (fr - 14)) * 128 + cl)); hp[0] = acc[ai][1][3][0]; hp[1] = acc[ai][1][3][1]; }
            if (wr == 1) { float* hd = (pm == MP / 256 - 1) ? out + O_FP + (size_t)(fr - 14) * DFF + f0 : halo + ((size_t)pm * 2 + (fr - 14)) * DFF + f0;
                *(f32x4*)hd = acc[1][1][3][0]; *(f32x4*)(hd + 4) = acc[1][1][3][1]; }
        }
        WG_BAR();
        f32x4 R1pa, R1pb, R2pa, R2pb;
#pragma unroll
        for (int ai = 0; ai < 2; ++ai) {
#pragma unroll
            for (int m = 0; m < 4; ++m) {
                const int row = pm * 256 + ai * 128 + wr * 64 + m * 16 + fr;
                const f32x4 Pa = acc[ai][1][m][0], Pb = acc[ai][1][m][1], Va = acc[ai][0][m][0], Vb = acc[ai][0][m][1];
                f32x4 R1a, R1b, R2a, R2b;
#pragma unroll
                for (int j = 0; j < 4; ++j) { R1a[j] = dpp_ror<1>(Pa[j]); R1b[j] = dpp_ror<1>(Pb[j]); R2a[j] = dpp_ror<2>(Pa[j]); R2b[j] = dpp_ror<2>(Pb[j]); }
                if (m == 0 || (smp && m == 2)) {
                    f32x4 B1a, B1b, B2a, B2b;
                    if (smp) { const int b = (row - MP) >> 5; const float* s0 = st_ffn + (size_t)(b * 2) * DFF + f0; const float* s1 = s0 + DFF;
                        B2a = *(const f32x4*)s0; B2b = *(const f32x4*)(s0 + 4); B1a = *(const f32x4*)s1; B1b = *(const f32x4*)(s1 + 4);
                    } else if (ai == 0 && wr == 0) { B1a = B1b = B2a = B2b = (f32x4){0.f, 0.f, 0.f, 0.f};
                    } else { const int pg = ai * 2 + wr - 1; const LAS f32x4* h2 = (const LAS f32x4*)(HX + ((pg * 2 + 0) * 128 + cl)); const LAS f32x4* h1 = (const LAS f32x4*)(HX + ((pg * 2 + 1) * 128 + cl));
                        B2a = h2[0]; B2b = h2[1]; B1a = h1[0]; B1b = h1[1]; }
                    R1pa = B1a; R1pb = B1b; R2pa = (fr == 0) ? B2a : B1a; R2pb = (fr == 0) ? B2b : B1b;
                }
                const f32x4 p1a = (fr >= 1) ? R1a : R1pa, p1b = (fr >= 1) ? R1b : R1pb, p2a = (fr >= 2) ? R2a : R2pa, p2b = (fr >= 2) ? R2b : R2pb;
                const f32x4 ca = cba + (w0a * p2a + w1a * p1a) + w2a * Pa, cbv = cbb + (w0b * p2b + w1b * p1b) + w2b * Pb;
                f32x4 oa, ob;
#pragma unroll
                for (int j = 0; j < 4; ++j) { oa[j] = gelu_tanh(ca[j]) * Va[j]; ob[j] = gelu_tanh(cbv[j]) * Vb[j]; }
                v4u q; q.x = cvt_pk_bf16(oa[0], oa[1]); q.y = cvt_pk_bf16(oa[2], oa[3]); q.z = cvt_pk_bf16(ob[0], ob[1]); q.w = cvt_pk_bf16(ob[2], ob[3]);
                *(v4u*)(ACT + (size_t)row * DFF + f0) = q;
                if (m == 0 && ai == 0) { if (!smp && pm >= 1 && wr == 0 && fr < 2) { float* dc = defc + ((size_t)pm * 2 + fr) * DFF + f0; float* dv = defv + ((size_t)pm * 2 + fr) * DFF + f0;
                        *(f32x4*)dc = ca; *(f32x4*)(dc + 4) = cbv; *(f32x4*)dv = Va; *(f32x4*)(dv + 4) = Vb; } }
                if ((m & 1) && smp && fr >= 14) { float* fd = out + O_FS + (size_t)(((row - MP) >> 5) * 2 + (fr - 14)) * DFF + f0; *(f32x4*)fd = Pa; *(f32x4*)(fd + 4) = Pb; }
                R1pa = R1a; R1pb = R1b; R2pa = R2a; R2pb = R2b;
            }
        }
    }
};
struct EpiBf {
    static constexpr bool PERM = true, AFTER_DRAIN = false;
    bf16* O; int ldc;
    __device__ __forceinline__ void operator()(const f32x4 (&acc)[2][2][4][2], const pg8::Unit& u, int wr, int wc, int fr, int fq) const {
        const int row0 = u.pm * 256 + wr * 64 + fr, col0 = u.pn * 256 + wc * 32 + 8 * fq;
#pragma unroll
        for (int ai = 0; ai < 2; ++ai)
#pragma unroll
            for (int m = 0; m < 4; ++m) { bf16* rowp = O + (size_t)(row0 + ai * 128 + m * 16) * ldc + col0;
#pragma unroll
                for (int bj = 0; bj < 2; ++bj) { const f32x4 v0 = acc[ai][bj][m][0], v1 = acc[ai][bj][m][1];
                    v4u w; w.x = cvt_pk_bf16(v0[0], v0[1]); w.y = cvt_pk_bf16(v0[2], v0[3]); w.z = cvt_pk_bf16(v1[0], v1[1]); w.w = cvt_pk_bf16(v1[2], v1[3]);
                    *(v4u*)(rowp + bj * 128) = w; } }
    }
};

constexpr int UC_LD = 388;
constexpr int UC_BYTES = 64 * UC_LD * 4;
static_assert(UC_BYTES <= RING_BYTES, "lru lds");
__device__ __forceinline__ void lru_unit(Frame& F, int chunk, int bp) {
    const int tid = F.tid, lane = F.lane, w = F.wave, fr = lane & 15, fq = lane >> 4;
    LAS float* UC = (LAS float*)(F.lds + RING_OFF);
    const bool smp = chunk >= 256;
    const int row0 = smp ? MP + 64 * (chunk - 256) : 64 * chunk;
    const int chb = 384 * bp;
    const int bl = w >> 2, cg = w & 3, blk = 2 * bp + bl, cwl = 192 * bl + 48 * cg;
    WG_BAR();
    if (tid < 384) {
        const int cgp = tid % 48, tg = tid / 48, ch = chb + 8 * cgp, tok0 = 8 * tg;
        float wv[4][8], bv[8], xw[3][8];
#pragma unroll
        for (int k = 0; k < 4; ++k) { const f32x4 a = *(const f32x4*)(F.cw() + k * DLRU + ch), b = *(const f32x4*)(F.cw() + k * DLRU + ch + 4);
            wv[k][0] = a[0]; wv[k][1] = a[1]; wv[k][2] = a[2]; wv[k][3] = a[3]; wv[k][4] = b[0]; wv[k][5] = b[1]; wv[k][6] = b[2]; wv[k][7] = b[3]; }
        { const f32x4 a = *(const f32x4*)(F.cb() + ch), b = *(const f32x4*)(F.cb() + ch + 4); bv[0] = a[0]; bv[1] = a[1]; bv[2] = a[2]; bv[3] = a[3]; bv[4] = b[0]; bv[5] = b[1]; bv[6] = b[2]; bv[7] = b[3]; }
        const int r0 = row0 + tok0;
        const bool from_state = smp && ((tok0 & 31) == 0), zero_prev = (!smp) && (r0 == 0);
#pragma unroll
        for (int d = 0; d < 3; ++d) {
            if (zero_prev) {
#pragma unroll
                for (int e = 0; e < 8; ++e) xw[d][e] = 0.f;
            } else if (from_state) { const int b = (r0 - MP) >> 5; const float* sp = F.st_conv() + (size_t)(b * 3 + d) * DLRU + ch; const f32x4 a = *(const f32x4*)sp, c = *(const f32x4*)(sp + 4);
                xw[d][0] = a[0]; xw[d][1] = a[1]; xw[d][2] = a[2]; xw[d][3] = a[3]; xw[d][4] = c[0]; xw[d][5] = c[1]; xw[d][6] = c[2]; xw[d][7] = c[3];
            } else { const v4u q = *(const v4u*)(F.U() + (size_t)(r0 - 3 + d) * DLRU + ch);
                xw[d][0] = bflo(q.x); xw[d][1] = bfhi(q.x); xw[d][2] = bflo(q.y); xw[d][3] = bfhi(q.y); xw[d][4] = bflo(q.z); xw[d][5] = bfhi(q.z); xw[d][6] = bflo(q.w); xw[d][7] = bfhi(q.w); }
        }
#pragma unroll
        for (int t = 0; t < 8; ++t) {
            const v4u q = *(const v4u*)(F.U() + (size_t)(r0 + t) * DLRU + ch);
            float xc[8]; xc[0] = bflo(q.x); xc[1] = bfhi(q.x); xc[2] = bflo(q.y); xc[3] = bfhi(q.y); xc[4] = bflo(q.z); xc[5] = bfhi(q.z); xc[6] = bflo(q.w); xc[7] = bfhi(q.w);
            float o[8];
#pragma unroll
            for (int e = 0; e < 8; ++e) o[e] = bv[e] + ((wv[0][e] * xw[0][e] + wv[1][e] * xw[1][e]) + (wv[2][e] * xw[2][e] + wv[3][e] * xc[e]));
            LAS f32x4* dst = (LAS f32x4*)(UC + (tok0 + t) * UC_LD + 8 * cgp);
            dst[0] = (f32x4){o[0], o[1], o[2], o[3]}; dst[1] = (f32x4){o[4], o[5], o[6], o[7]};
#pragma unroll
            for (int e = 0; e < 8; ++e) { xw[0][e] = xw[1][e]; xw[1][e] = xw[2][e]; xw[2][e] = xc[e]; }
        }
    }
    WG_BAR();
    f32x4 accA[4][3], accX[4][3];
#pragma unroll
    for (int tt = 0; tt < 4; ++tt)
#pragma unroll
        for (int ct = 0; ct < 3; ++ct) { accA[tt][ct] = (f32x4){0.f, 0.f, 0.f, 0.f}; accX[tt][ct] = (f32x4){0.f, 0.f, 0.f, 0.f}; }
    const bf16* wa_base = F.Wa_t() + (size_t)blk * BD * BD + (size_t)(48 * cg + fr) * BD + 8 * fq;
    const bf16* wx_base = F.Wx_t() + (size_t)blk * BD * BD + (size_t)(48 * cg + fr) * BD + 8 * fq;
#pragma unroll 1
    for (int kb = 0; kb < 3; ++kb) {
        bf16x8 fa[2][3], fx[2][3];
#pragma unroll
        for (int kk = 0; kk < 2; ++kk)
#pragma unroll
            for (int ct = 0; ct < 3; ++ct) {
                fa[kk][ct] = __builtin_bit_cast(bf16x8, *(const v4u*)(wa_base + (size_t)(16 * ct) * BD + 32 * (2 * kb + kk)));
                fx[kk][ct] = __builtin_bit_cast(bf16x8, *(const v4u*)(wx_base + (size_t)(16 * ct) * BD + 32 * (2 * kb + kk))); }
#pragma unroll
        for (int kk = 0; kk < 2; ++kk) {
            const int ks = 2 * kb + kk;
            bf16x8 uf[4];
#pragma unroll
            for (int tt = 0; tt < 4; ++tt) { const LAS f32x4* s = (const LAS f32x4*)(UC + (16 * tt + fr) * UC_LD + 192 * bl + 32 * ks + 8 * fq); const f32x4 a = s[0], b = s[1];
                v4u p; p.x = cvt_pk_bf16(a[0], a[1]); p.y = cvt_pk_bf16(a[2], a[3]); p.z = cvt_pk_bf16(b[0], b[1]); p.w = cvt_pk_bf16(b[2], b[3]); uf[tt] = __builtin_bit_cast(bf16x8, p); }
#pragma unroll
            for (int ct = 0; ct < 3; ++ct)
#pragma unroll
                for (int tt = 0; tt < 4; ++tt) { accA[tt][ct] = __builtin_amdgcn_mfma_f32_16x16x32_bf16(fa[kk][ct], uf[tt], accA[tt][ct], 0, 0, 0);
                                                 accX[tt][ct] = __builtin_amdgcn_mfma_f32_16x16x32_bf16(fx[kk][ct], uf[tt], accX[tt][ct], 0, 0, 0); }
        }
    }
    f32x4 carry[3], acar[3];
#pragma unroll
    for (int ct = 0; ct < 3; ++ct) { acar[ct] = (f32x4){1.f, 1.f, 1.f, 1.f};
        carry[ct] = smp ? *(const f32x4*)(F.st_h() + (size_t)(2 * (chunk - 256)) * DLRU + chb + cwl + 16 * ct + 4 * fq) : (f32x4){0.f, 0.f, 0.f, 0.f}; }
#pragma unroll
    for (int tt = 0; tt < 4; ++tt) {
        if (smp && tt == 2) {
#pragma unroll
            for (int ct = 0; ct < 3; ++ct) { acar[ct] = (f32x4){1.f, 1.f, 1.f, 1.f}; carry[ct] = *(const f32x4*)(F.st_h() + (size_t)(2 * (chunk - 256) + 1) * DLRU + chb + cwl + 16 * ct + 4 * fq); } }
        const int row = row0 + 16 * tt + fr;
#pragma unroll
        for (int ct = 0; ct < 3; ++ct) {
            const int chg = chb + cwl + 16 * ct + 4 * fq;
            const f32x4 ba = *(const f32x4*)(F.b_a() + chg), bx = *(const f32x4*)(F.b_x() + chg), c8 = *(const f32x4*)(F.C8() + chg);
            const f32x4 uc = *(const LAS f32x4*)(UC + (16 * tt + fr) * UC_LD + cwl + 16 * ct + 4 * fq);
            const v2u gq = *(const v2u*)(F.Gt() + (size_t)row * DLRU + chg);
            f32x4 av, bv;
#pragma unroll
            for (int r = 0; r < 4; ++r) {
                const float rg = sigmoidf_(accA[tt][ct][r] + ba[r]), ig = sigmoidf_(accX[tt][ct][r] + bx[r]);
                const float la2 = c8[r] * rg;
                float a = fexp2(la2);
                const float x = 2.0f * 0.6931471805599453f * la2;
                const float om = (x > -0.25f) ? -x * (1.0f + x * (0.5f + x * (0.16666667f + x * (0.041666668f + x * (0.008333334f + x * 0.0013888889f))))) : 1.0f - a * a;
                float b = __builtin_amdgcn_sqrtf(om) * ig * uc[r];
                row_scan_ab(a, b);
                av[r] = a; bv[r] = b;
            }
            const f32x4 h = bv + av * carry[ct];
            const f32x4 hA = av * acar[ct];
            f32x4 ge; ge[0] = gelu_tanh(bflo(gq.x)); ge[1] = gelu_tanh(bfhi(gq.x)); ge[2] = gelu_tanh(bflo(gq.y)); ge[3] = gelu_tanh(bfhi(gq.y));
            const f32x4 y = h * ge;
            v2u o; o.x = cvt_pk_bf16(y[0], y[1]); o.y = cvt_pk_bf16(y[2], y[3]);
            *(v2u*)(F.Y() + (size_t)row * DM + chg) = o;
            if (!smp) { const f32x4 z = hA * ge; v2u oz; oz.x = cvt_pk_bf16(z[0], z[1]); oz.y = cvt_pk_bf16(z[2], z[3]); *(v2u*)(F.Z() + (size_t)row * DLRU + chg) = oz;
                if (tt == 3 && fr == 15) { *(f32x4*)(F.AggA() + (size_t)chunk * DLRU + chg) = hA; *(f32x4*)(F.AggB() + (size_t)chunk * DLRU + chg) = h; } }
            else if (((row - MP) & 31) == 31) *(f32x4*)(F.out() + O_HS + (size_t)((row - MP) >> 5) * DLRU + chg) = h;
#pragma unroll
            for (int r = 0; r < 4; ++r) { carry[ct][r] = __shfl(h[r], (lane & 48) | 15); acar[ct][r] = __shfl(hA[r], (lane & 48) | 15); }
        }
        __builtin_amdgcn_sched_barrier(0);
    }
}
__device__ __forceinline__ void lru_prefix(Frame& F) {
    const int gw = F.vcu * NWAVES + F.wave, NGW = F.G * NWAVES, fr = F.lane & 15, fq = F.lane >> 4;
    for (int item = gw; item < DLRU / 16; item += NGW) {
        const int chg = 16 * item + 4 * fq;
        f32x4 la[16], lb[16];
#pragma unroll
        for (int i = 0; i < 16; ++i) { la[i] = *(const f32x4*)(F.AggA() + (size_t)(16 * fr + i) * DLRU + chg); lb[i] = *(const f32x4*)(F.AggB() + (size_t)(16 * fr + i) * DLRU + chg); }
        f32x4 PA = la[0], PB = lb[0];
#pragma unroll
        for (int i = 1; i < 16; ++i) { PB = la[i] * PB + lb[i]; PA = la[i] * PA; }
        f32x4 h;
#pragma unroll
        for (int r = 0; r < 4; ++r) { float a = PA[r], b = PB[r]; row_scan_ab(a, b); h[r] = dpp_shr<1>(0.0f, b); }
#pragma unroll
        for (int i = 0; i < 16; ++i) { *(f32x4*)(F.Carry() + (size_t)(16 * fr + i) * DLRU + chg) = h; h = la[i] * h + lb[i]; }
        if (fr == 15) *(f32x4*)(F.out() + O_HP + chg) = h;
    }
}

constexpr int KS_LD = 272, KS_OFF = 0, VT_OFF = 128 * KS_LD, WM_OFF = 2 * 128 * KS_LD;
constexpr float ATT_SC = 0.12751743082459868f;
constexpr float ATT_STOP = -160.0f;
__device__ __forceinline__ int vt_pos(int k) { return (k & ~31) | (((k >> 2) & 3) << 3) | (((k >> 4) & 1) << 2) | (k & 3); }
__device__ __forceinline__ void attn_unit(Frame& F, int ui) {
    const int tid = F.tid, lane = F.lane, w = F.wave, fr = lane & 15, fq = lane >> 4;
    LAS unsigned char* KS = F.lds + RING_OFF + KS_OFF; LAS unsigned char* VT = F.lds + RING_OFF + VT_OFF; LAS float* WM = (LAS float*)(F.lds + RING_OFF + WM_OFF);
    const bool smp = ui >= 1024; const int h = ui & 7;
    const int qt = ui >> 3, b = (ui - 1024) >> 3;
    const int qrow0 = smp ? MP + 32 * b : 128 * qt;
    const int nkb = smp ? 1 + PAST / 128 : qt + 1;
    const bool active = smp ? (w < 2) : true;
    const int qi = 16 * w + fr;
    bf16x8 qf[4];
    if (active) {
#pragma unroll
        for (int ds = 0; ds < 4; ++ds) qf[ds] = __builtin_bit_cast(bf16x8, *(const v4u*)(F.Qn() + (size_t)(qrow0 + qi) * DSB + h * HD + 32 * ds + 8 * fq));
    } else {
#pragma unroll
        for (int ds = 0; ds < 4; ++ds) qf[ds] = (bf16x8){0, 0, 0, 0, 0, 0, 0, 0};
    }
    f32x4 o[8];
#pragma unroll
    for (int dt = 0; dt < 8; ++dt) o[dt] = (f32x4){0.f, 0.f, 0.f, 0.f};
    float carry = 0.f;
    for (int j = 0; j < nkb; ++j) {
        WG_BAR();
        if (!smp || j == 0) {
            const int krow0 = smp ? qrow0 : 128 * (qt - j); const int nvalid = smp ? 32 : 128;
#pragma unroll
            for (int c = 0; c < 4; ++c) { const int id = tid + 512 * c;
                { const int key = id >> 4, dc = id & 15; v4u q = (v4u){0u, 0u, 0u, 0u}; if (key < nvalid) q = *(const v4u*)(F.Kn() + (size_t)(krow0 + key) * DSB + h * HD + 8 * dc);
                  *(LAS v4u*)(KS + key * KS_LD + 16 * dc) = q; }
                { const int key = id & 127, dc = id >> 7; v4u q = (v4u){0u, 0u, 0u, 0u}; if (key < nvalid) q = *(const v4u*)(F.Vb() + (size_t)(krow0 + key) * DSB + h * HD + 8 * dc);
                  LAS unsigned short* vp = (LAS unsigned short*)(VT + (8 * dc) * KS_LD + 2 * vt_pos(key));
                  vp[0 * (KS_LD / 2)] = (unsigned short)(q.x & 0xffffu); vp[1 * (KS_LD / 2)] = (unsigned short)(q.x >> 16); vp[2 * (KS_LD / 2)] = (unsigned short)(q.y & 0xffffu); vp[3 * (KS_LD / 2)] = (unsigned short)(q.y >> 16);
                  vp[4 * (KS_LD / 2)] = (unsigned short)(q.z & 0xffffu); vp[5 * (KS_LD / 2)] = (unsigned short)(q.z >> 16); vp[6 * (KS_LD / 2)] = (unsigned short)(q.w & 0xffffu); vp[7 * (KS_LD / 2)] = (unsigned short)(q.w >> 16); }
            }
        } else {
            const int pos0 = PAST - 128 * j;
            const float* ck = F.cache_k() + ((size_t)b * PAST + pos0) * DSB + h * HD; const float* cv = F.cache_v() + ((size_t)b * PAST + pos0) * DSB + h * HD;
#pragma unroll
            for (int c = 0; c < 4; ++c) { const int id = tid + 512 * c;
                { const int key = id >> 4, dc = id & 15; const float* p = ck + (size_t)key * DSB + 8 * dc; const f32x4 a = *(const f32x4*)p, bb = *(const f32x4*)(p + 4);
                  v4u q; q.x = cvt_pk_bf16(a[0], a[1]); q.y = cvt_pk_bf16(a[2], a[3]); q.z = cvt_pk_bf16(bb[0], bb[1]); q.w = cvt_pk_bf16(bb[2], bb[3]);
                  *(LAS v4u*)(KS + key * KS_LD + 16 * dc) = q; }
                { const int key = id & 127, dc = id >> 7; const float* p = cv + (size_t)key * DSB + 8 * dc; const f32x4 a = *(const f32x4*)p, bb = *(const f32x4*)(p + 4);
                  v4u q; q.x = cvt_pk_bf16(a[0], a[1]); q.y = cvt_pk_bf16(a[2], a[3]); q.z = cvt_pk_bf16(bb[0], bb[1]); q.w = cvt_pk_bf16(bb[2], bb[3]);
                  LAS unsigned short* vp = (LAS unsigned short*)(VT + (8 * dc) * KS_LD + 2 * vt_pos(key));
                  vp[0 * (KS_LD / 2)] = (unsigned short)(q.x & 0xffffu); vp[1 * (KS_LD / 2)] = (unsigned short)(q.x >> 16); vp[2 * (KS_LD / 2)] = (unsigned short)(q.y & 0xffffu); vp[3 * (KS_LD / 2)] = (unsigned short)(q.y >> 16);
                  vp[4 * (KS_LD / 2)] = (unsigned short)(q.z & 0xffffu); vp[5 * (KS_LD / 2)] = (unsigned short)(q.z >> 16); vp[6 * (KS_LD / 2)] = (unsigned short)(q.w & 0xffffu); vp[7 * (KS_LD / 2)] = (unsigned short)(q.w >> 16); }
            }
        }
        WG_BAR();
        float wmax = -3.0e38f;
        if (active) {
            f32x4 s[8];
#pragma unroll
            for (int kt = 0; kt < 8; ++kt) { s[kt] = (f32x4){0.f, 0.f, 0.f, 0.f};
#pragma unroll
                for (int ds = 0; ds < 4; ++ds) { const bf16x8 kf = *(const LAS bf16x8*)(KS + (16 * kt + fr) * KS_LD + 2 * (32 * ds + 8 * fq)); s[kt] = __builtin_amdgcn_mfma_f32_16x16x32_bf16(kf, qf[ds], s[kt], 0, 0, 0); } }
            const bool diag = (j == 0);
            float lb[8][4], xs[8][3], Fq[8], TT[8];
#pragma unroll
            for (int kt = 0; kt < 8; ++kt) {
#pragma unroll
                for (int r = 0; r < 4; ++r) { const float z2 = s[kt][r] * ATT_SC; s[kt][r] = z2;
                    const float sp = fmaxf(z2, 0.f) + flog2(1.0f + fexp2(-fabsf(z2)));
                    const bool valid = (!diag) || ((16 * kt + 4 * fq + r) < qi);
                    lb[kt][r] = valid ? -sp : 0.f; }
                xs[kt][2] = lb[kt][3]; xs[kt][1] = lb[kt][3] + lb[kt][2]; xs[kt][0] = xs[kt][1] + lb[kt][1];
                const float T = xs[kt][0] + lb[kt][0];
                const float t1 = __shfl_xor(T, 16), t2 = __shfl_xor(T, 32), t3 = __shfl_xor(T, 48);
                Fq[kt] = (((fq ^ 1) > fq) ? t1 : 0.f) + (((fq ^ 2) > fq) ? t2 : 0.f) + (((fq ^ 3) > fq) ? t3 : 0.f);
                TT[kt] = (T + t1) + (t2 + t3);
            }
            float run = carry; bf16x8 pf[4];
            unsigned pw[8][2];
#pragma unroll
            for (int kt = 7; kt >= 0; --kt) {
                const float base = run + Fq[kt];
                float wv[4];
#pragma unroll
                for (int r = 0; r < 4; ++r) { const float st = base + (r < 3 ? xs[kt][r] : 0.f);
                    const bool valid = (!diag) || ((16 * kt + 4 * fq + r) < qi);
                    wv[r] = valid ? fexp2(s[kt][r] + lb[kt][r] + st) : 0.f; }
                pw[kt][0] = cvt_pk_bf16(wv[0], wv[1]); pw[kt][1] = cvt_pk_bf16(wv[2], wv[3]);
                run += TT[kt];
            }
            carry = run;
#pragma unroll
            for (int sI = 0; sI < 4; ++sI) { v4u p; p.x = pw[2 * sI][0]; p.y = pw[2 * sI][1]; p.z = pw[2 * sI + 1][0]; p.w = pw[2 * sI + 1][1]; pf[sI] = __builtin_bit_cast(bf16x8, p); }
#pragma unroll
            for (int dt = 0; dt < 8; ++dt)
#pragma unroll
                for (int sI = 0; sI < 4; ++sI) { const bf16x8 vf = *(const LAS bf16x8*)(VT + (16 * dt + fr) * KS_LD + 2 * (32 * sI + 8 * fq)); o[dt] = __builtin_amdgcn_mfma_f32_16x16x32_bf16(vf, pf[sI], o[dt], 0, 0, 0); }
            wmax = carry;
#pragma unroll
            for (int off = 1; off < 16; off <<= 1) wmax = fmaxf(wmax, __shfl_xor(wmax, off));
        }
        if (lane == 0) WM[w] = wmax;
        WG_BAR();
        float mx = WM[0];
#pragma unroll
        for (int k = 1; k < 8; ++k) mx = fmaxf(mx, WM[k]);
        if (mx < ATT_STOP) break;
    }
    if (active) {
        const int row = qrow0 + qi;
        float ss = 0.f;
#pragma unroll
        for (int dt = 0; dt < 8; ++dt) ss += (o[dt][0] * o[dt][0] + o[dt][1] * o[dt][1]) + (o[dt][2] * o[dt][2] + o[dt][3] * o[dt][3]);
        ss += __shfl_xor(ss, 16); ss += __shfl_xor(ss, 32);
        if (fq == 0) F.SsqS()[(size_t)row * 8 + h] = ss;
#pragma unroll
        for (int dt = 0; dt < 8; ++dt) { const int d = 16 * dt + 4 * fq; const f32x4 gv = *(const f32x4*)(F.g_sb() + h * HD + d); const f32x4 y = o[dt] * gv;
            v2u q; q.x = cvt_pk_bf16(y[0], y[1]); q.y = cvt_pk_bf16(y[2], y[3]); *(v2u*)(F.Y() + (size_t)row * DM + DLRU + h * HD + d) = q; }
    }
}

__device__ __forceinline__ void mix_rows(Frame& F) {
    const int gw = F.vcu * NWAVES + F.wave, NGW = F.G * NWAVES, lane = F.lane;
    for (int m = gw; m < M; m += NGW) {
        GAS v4u* yr = (GAS v4u*)(F.Y() + (size_t)m * DM);
        float y[6][8]; float ss = 0.f;
#pragma unroll
        for (int j = 0; j < 6; ++j) { const int ci = lane + 64 * j; const v4u q = yr[ci];
            y[j][0] = bflo(q.x); y[j][1] = bfhi(q.x); y[j][2] = bflo(q.y); y[j][3] = bfhi(q.y); y[j][4] = bflo(q.z); y[j][5] = bfhi(q.z); y[j][6] = bflo(q.w); y[j][7] = bfhi(q.w);
            if (m < MP) { const v4u z = *((const GAS v4u*)(F.Z() + (size_t)m * DLRU) + ci); const float* cp = F.Carry() + (size_t)(m >> 6) * DLRU + 8 * ci; const f32x4 c0 = *(const f32x4*)cp, c1 = *(const f32x4*)(cp + 4);
                y[j][0] += bflo(z.x) * c0[0]; y[j][1] += bfhi(z.x) * c0[1]; y[j][2] += bflo(z.y) * c0[2]; y[j][3] += bfhi(z.y) * c0[3]; y[j][4] += bflo(z.z) * c1[0]; y[j][5] += bfhi(z.z) * c1[1]; y[j][6] += bflo(z.w) * c1[2]; y[j][7] += bfhi(z.w) * c1[3]; }
#pragma unroll
            for (int e = 0; e < 8; ++e) ss += y[j][e] * y[j][e]; }
        const f32x4 b0 = *(const f32x4*)(F.SsqS() + (size_t)m * 8), b1 = *(const f32x4*)(F.SsqS() + (size_t)m * 8 + 4);
        const float ssb = 1.0f / sqrtf((((b0[0] + b0[1]) + (b0[2] + b0[3])) + ((b1[0] + b1[1]) + (b1[2] + b1[3]))) * (1.0f / DSB) + EPS);
        const float sl = 1.0f / sqrtf(wave_sum(ss) * (1.0f / DLRU) + EPS);
#pragma unroll
        for (int j = 0; j < 6; ++j) { const int ci = lane + 64 * j; v4u q; const f32x4 g0 = *(const f32x4*)(F.g_lru() + 8 * ci) * sl, g1 = *(const f32x4*)(F.g_lru() + 8 * ci + 4) * sl;
            q.x = cvt_pk_bf16(y[j][0] * g0[0], y[j][1] * g0[1]); q.y = cvt_pk_bf16(y[j][2] * g0[2], y[j][3] * g0[3]); q.z = cvt_pk_bf16(y[j][4] * g1[0], y[j][5] * g1[1]); q.w = cvt_pk_bf16(y[j][6] * g1[2], y[j][7] * g1[3]); yr[ci] = q; }
#pragma unroll
        for (int j = 6; j < 8; ++j) { const int ci = lane + 64 * j; v4u q = yr[ci];
            q.x = cvt_pk_bf16(bflo(q.x) * ssb, bfhi(q.x) * ssb); q.y = cvt_pk_bf16(bflo(q.y) * ssb, bfhi(q.y) * ssb); q.z = cvt_pk_bf16(bflo(q.z) * ssb, bfhi(q.z) * ssb); q.w = cvt_pk_bf16(bflo(q.w) * ssb, bfhi(q.w) * ssb); yr[ci] = q; }
    }
}
__device__ __forceinline__ void act_pass(Frame& F, int hf) {
    const int gt = F.vcu * (NWAVES * 64) + F.tid, NGT = F.G * NWAVES * 64;
    constexpr int NFG = DFF / 2 / 8, NRB = M / 32;
    for (int it = gt; it < NFG * NRB; it += NGT) {
        const int fg = it % NFG, rb = it / NFG, pnl = fg >> 4, wi = (fg & 15) * 8, vcol = 256 * pnl + wi, f = (DFF / 2) * hf + 128 * pnl + wi, r0 = 32 * rb;
        float w0[8], w1[8], w2[8], cbv[8], p2[8], p1[8];
        { const f32x4 a = *(const f32x4*)(F.fcw() + f), b = *(const f32x4*)(F.fcw() + f + 4); w0[0] = a[0]; w0[1] = a[1]; w0[2] = a[2]; w0[3] = a[3]; w0[4] = b[0]; w0[5] = b[1]; w0[6] = b[2]; w0[7] = b[3]; }
        { const f32x4 a = *(const f32x4*)(F.fcw() + DFF + f), b = *(const f32x4*)(F.fcw() + DFF + f + 4); w1[0] = a[0]; w1[1] = a[1]; w1[2] = a[2]; w1[3] = a[3]; w1[4] = b[0]; w1[5] = b[1]; w1[6] = b[2]; w1[7] = b[3]; }
        { const f32x4 a = *(const f32x4*)(F.fcw() + 2 * DFF + f), b = *(const f32x4*)(F.fcw() + 2 * DFF + f + 4); w2[0] = a[0]; w2[1] = a[1]; w2[2] = a[2]; w2[3] = a[3]; w2[4] = b[0]; w2[5] = b[1]; w2[6] = b[2]; w2[7] = b[3]; }
        { const f32x4 a = *(const f32x4*)(F.fcb() + f), b = *(const f32x4*)(F.fcb() + f + 4); cbv[0] = a[0]; cbv[1] = a[1]; cbv[2] = a[2]; cbv[3] = a[3]; cbv[4] = b[0]; cbv[5] = b[1]; cbv[6] = b[2]; cbv[7] = b[3]; }
        if (r0 >= MP) { const int b = (r0 - MP) >> 5; const float* s0 = F.st_ffn() + (size_t)(b * 2) * DFF + f; const float* s1 = s0 + DFF;
            const f32x4 a = *(const f32x4*)s0, c = *(const f32x4*)(s0 + 4), d = *(const f32x4*)s1, e = *(const f32x4*)(s1 + 4);
            p2[0] = a[0]; p2[1] = a[1]; p2[2] = a[2]; p2[3] = a[3]; p2[4] = c[0]; p2[5] = c[1]; p2[6] = c[2]; p2[7] = c[3];
            p1[0] = d[0]; p1[1] = d[1]; p1[2] = d[2]; p1[3] = d[3]; p1[4] = e[0]; p1[5] = e[1]; p1[6] = e[2]; p1[7] = e[3];
        } else if (r0 == 0) {
#pragma unroll
            for (int e = 0; e < 8; ++e) { p2[e] = 0.f; p1[e] = 0.f; }
        } else { const v4u a = *(const v4u*)(F.VALPRE() + (size_t)(r0 - 2) * DFF + vcol + 128), b = *(const v4u*)(F.VALPRE() + (size_t)(r0 - 1) * DFF + vcol + 128);
            p2[0] = bflo(a.x); p2[1] = bfhi(a.x); p2[2] = bflo(a.y); p2[3] = bfhi(a.y); p2[4] = bflo(a.z); p2[5] = bfhi(a.z); p2[6] = bflo(a.w); p2[7] = bfhi(a.w);
            p1[0] = bflo(b.x); p1[1] = bfhi(b.x); p1[2] = bflo(b.y); p1[3] = bfhi(b.y); p1[4] = bflo(b.z); p1[5] = bfhi(b.z); p1[6] = bflo(b.w); p1[7] = bfhi(b.w); }
#pragma unroll 4
        for (int t = 0; t < 32; ++t) { const int row = r0 + t;
            const v4u pq = *(const v4u*)(F.VALPRE() + (size_t)row * DFF + vcol + 128), vq = *(const v4u*)(F.VALPRE() + (size_t)row * DFF + vcol);
            float pc[8], vv[8], o[8];
            pc[0] = bflo(pq.x); pc[1] = bfhi(pq.x); pc[2] = bflo(pq.y); pc[3] = bfhi(pq.y); pc[4] = bflo(pq.z); pc[5] = bfhi(pq.z); pc[6] = bflo(pq.w); pc[7] = bfhi(pq.w);
            vv[0] = bflo(vq.x); vv[1] = bfhi(vq.x); vv[2] = bflo(vq.y); vv[3] = bfhi(vq.y); vv[4] = bflo(vq.z); vv[5] = bfhi(vq.z); vv[6] = bflo(vq.w); vv[7] = bfhi(vq.w);
#pragma unroll
            for (int e = 0; e < 8; ++e) { const float c = cbv[e] + (w0[e] * p2[e] + w1[e] * p1[e]) + w2[e] * pc[e]; o[e] = gelu_tanh(c) * vv[e]; p2[e] = p1[e]; p1[e] = pc[e]; }
            v4u q; q.x = cvt_pk_bf16(o[0], o[1]); q.y = cvt_pk_bf16(o[2], o[3]); q.z = cvt_pk_bf16(o[4], o[5]); q.w = cvt_pk_bf16(o[6], o[7]);
            *(v4u*)(F.ACT() + (size_t)row * DFF + f) = q;
            float* fdst = nullptr;
            if (row < MP) { if (row >= MP - 2) fdst = F.out() + O_FP + (size_t)(row - (MP - 2)) * DFF + f; }
            else { const int tt = (row - MP) & 31; if (tt >= 30) fdst = F.out() + O_FS + (size_t)(((row - MP) >> 5) * 2 + (tt - 30)) * DFF + f; }
            if (fdst) { *(f32x4*)fdst = (f32x4){pc[0], pc[1], pc[2], pc[3]}; *(f32x4*)(fdst + 4) = (f32x4){pc[4], pc[5], pc[6], pc[7]}; }
        }
    }
}

__device__ __forceinline__ void ffn_fixup(Frame& F) {
    const int gt = F.vcu * (NWAVES * 64) + F.tid, NGT = F.G * NWAVES * 64;
    constexpr int NF4 = DFF / 4;
    for (int it = gt; it < (MP / 256 - 1) * 2 * NF4; it += NGT) {
        const int f = 4 * (it % NF4), q = it / NF4, rr = q & 1, pm = 1 + (q >> 1);
        f32x4 c = *(const f32x4*)(F.DefC() + ((size_t)pm * 2 + rr) * DFF + f); const f32x4 v = *(const f32x4*)(F.DefV() + ((size_t)pm * 2 + rr) * DFF + f);
        const f32x4 H1 = *(const f32x4*)(F.Halo() + ((size_t)(pm - 1) * 2 + 1) * DFF + f), H0 = *(const f32x4*)(F.Halo() + ((size_t)(pm - 1) * 2 + 0) * DFF + f);
        const f32x4 w0 = *(const f32x4*)(F.fcw() + f), w1 = *(const f32x4*)(F.fcw() + DFF + f);
        c = rr == 0 ? c + (w1 * H1 + w0 * H0) : c + w0 * H1;
        v2u o; o.x = cvt_pk_bf16(gelu_tanh(c[0]) * v[0], gelu_tanh(c[1]) * v[1]); o.y = cvt_pk_bf16(gelu_tanh(c[2]) * v[2], gelu_tanh(c[3]) * v[3]);
        *(v2u*)(F.ACT() + (size_t)(256 * pm + rr) * DFF + f) = o;
    }
}

constexpr int NPH = 11;
__global__ void __launch_bounds__(NWAVES * 64, 2) hymba_fwd(Args args) {
    extern __shared__ __attribute__((aligned(16))) unsigned char lds[];
    Frame F;
    F.lds = (LAS unsigned char*)lds;
    F.MISC = (volatile LAS unsigned*)(F.lds + MISC_OFF);
    F.tid = threadIdx.x; F.lane = F.tid & 63; F.wave = __builtin_amdgcn_readfirstlane(F.tid >> 6);
    F.G = gridDim.x; { const int bx = blockIdx.x; F.vcu = (F.G % 8 == 0) ? (bx % 8) * (F.G / 8) + bx / 8 : bx; }
    F.a = &args;
    F.ctl = (gu32*)(args.ws + WS_CTL);
    for (int u = F.tid; u < (LDS_BYTES - LDSCTL_OFF) / 4; u += NWAVES * 64) ((LAS unsigned*)(F.lds + LDSCTL_OFF))[u] = 0u;
    __syncthreads();
    XcdBarrier bar; bar.bar = (unsigned*)(F.ctl + CW_BAR); bar.x = 0; bar.st = nullptr;
    if (!MK_PER_PHASE) bar = xcd_barrier_post((unsigned*)(F.ctl + CW_BAR), F.MISC + 8);
#define GRID_BAR(seam) do { if (MK_PER_PHASE) { if (F.tid == 0) __hip_atomic_store(F.ctl + CW_TMO, 0xBADBA0u | (unsigned)(seam), RLX_AGENT); } else { xcd_barrier(bar); } } while (0)
    const int lo = args.ph_lo, hi = args.ph_hi;
#ifndef PH_MASK
#define PH_MASK 0xFFFF
#endif
#define IN(k) (((PH_MASK >> (k)) & 1) && lo <= (k) && (k) < hi)
#define BOTH(k) (IN(k) && IN((k) + 1))
#ifndef REP_MASK
#define REP_MASK 0
#endif
#define REP2(k) if constexpr (((REP_MASK >> (k)) & 1) != 0)
    LAS float* EPI = (LAS float*)(F.lds + EPI_OFF);

    if (IN(0)) { p0_prologue(F); REP2(0) p0_prologue(F); if (BOTH(0)) GRID_BAR(0); }
    if (IN(1)) {
        pg8::Gemm g{F.BUFA(), F.Win_t(), M, DIN, DM}; pg8::StaticOrder S; S.init(M, DIN, F.G, (int)blockIdx.x, DM / 64);
        Epi1 E{F.U(), F.Gt(), F.Qn(), F.Kn(), F.Vb(), F.out(), F.qg(), F.kg(), EPI};
        pg8::gemm_phase<Epi1, pg8::StaticOrder, true, true>(F.lds + RING_OFF, g, S, E);
        REP2(1) pg8::gemm_phase<Epi1, pg8::StaticOrder, true, true>(F.lds + RING_OFF, g, S, E);
        if (BOTH(1)) GRID_BAR(1);
    }
    if (IN(2)) {
        for (int u = F.vcu; u < 2112; u += F.G) lru_unit(F, u >> 3, u & 7);
        for (int u = (F.vcu + 64) % F.G; u < 1152; u += F.G) attn_unit(F, u);
        REP2(2) {
        for (int u = F.vcu; u < 2112; u += F.G) lru_unit(F, u >> 3, u & 7);
        for (int u = (F.vcu + 64) % F.G; u < 1152; u += F.G) attn_unit(F, u);
        }
        if (BOTH(2)) GRID_BAR(2);
    }
    if (IN(3)) { lru_prefix(F); if (BOTH(3)) GRID_BAR(3); }
    if (IN(4)) { mix_rows(F); if (BOTH(4)) GRID_BAR(4); }
    if (IN(5)) {
        pg8::Gemm g{F.Y(), F.Wout_t(), M, DM, DM}; pg8::StaticOrder S; S.init(MP, DM, F.G, (int)blockIdx.x, DM / 64, 8);
        EpiRes E{F.x_p(), F.x_s(), F.out(), F.Part(), 0};
        pg8::gemm_phase<EpiRes, pg8::StaticOrder, true, true>(F.lds + RING_OFF, g, S, E);
        if (BOTH(5)) GRID_BAR(5);
    }
    if (IN(6)) {
        const int gw = F.vcu * NWAVES + F.wave, NGW = F.G * NWAVES;
        for (int m = gw; m < MP; m += NGW) rms_row_to_bf16(F.out() + O_Y + (size_t)m * DM, F.g_ffn(), F.BUFA() + (size_t)m * DM, F.lane);
        for (int r = gw; r < MS; r += NGW) sample_row_reduce(F.x_s() + (size_t)r * DM, F.Part(), r, F.out() + O_Y + (size_t)(MP + r) * DM, F.g_ffn(), F.BUFA() + (size_t)(MP + r) * DM, F.lane);
        if (BOTH(6)) GRID_BAR(6);
    }
    if (IN(7)) {
        pg8::Gemm g{F.BUFA(), F.Wup_t(), M, 2 * DFF, DM}; pg8::StaticOrder S; S.init(M, 2 * DFF, F.G, (int)blockIdx.x, DM / 64);
        EpiUp E{F.ACT(), F.fcw(), F.fcb(), F.st_ffn(), F.out(), F.Halo(), F.DefC(), F.DefV(), EPI};
        pg8::gemm_phase<EpiUp, pg8::StaticOrder, true, true>(F.lds + RING_OFF, g, S, E);
        if (BOTH(7)) GRID_BAR(7);
    }
    if (IN(8)) { ffn_fixup(F); if (BOTH(8)) GRID_BAR(8); }
    if (IN(9)) {
        pg8::Gemm g{F.ACT(), F.Wdown_t(), M, DM, DFF}; pg8::StaticOrder S; S.init(MP, DM, F.G, (int)blockIdx.x, DFF / 64, 8);
        EpiRes E{F.x_p(), F.x_s(), F.out(), F.Part(), 1};
        pg8::gemm_phase<EpiRes, pg8::StaticOrder, true, true>(F.lds + RING_OFF, g, S, E);
        if (BOTH(9)) GRID_BAR(9);
    }
    if (IN(10)) {
        const int gw = F.vcu * NWAVES + F.wave, NGW = F.G * NWAVES;
        for (int r = gw; r < MS; r += NGW) { float* yr = F.out() + O_Y + (size_t)(MP + r) * DM; sample_row_reduce(yr, F.Part(), r, yr, nullptr, nullptr, F.lane); }
    }
#undef IN
#undef BOTH
}

extern "C" void kernel_launch(void* const* d_in, const int* in_sizes, int n_in, void* d_out, int out_size, void* d_ws, size_t ws_size, hipStream_t stream) {
    static int grid = 0;
    if (grid == 0) {
        if (n_in != 26 || out_size != (int)O_END || ws_size < WS_END) { fprintf(stderr, "kernel_launch: unexpected shapes (n_in %d, out %d, ws %zu); nothing launched\n", n_in, out_size, ws_size); grid = -1; return; }
        int dev = 0, cus = 0, per_cu = 0;
        if (hipGetDevice(&dev) != hipSuccess || hipDeviceGetAttribute(&cus, hipDeviceAttributeMultiprocessorCount, dev) != hipSuccess) { grid = -1; return; }
        if (hipFuncSetAttribute((const void*)hymba_fwd, hipFuncAttributeMaxDynamicSharedMemorySize, LDS_BYTES) != hipSuccess) { fprintf(stderr, "kernel_launch: hipFuncSetAttribute failed\n"); grid = -1; return; }
        if (hipOccupancyMaxActiveBlocksPerMultiprocessor(&per_cu, (const void*)hymba_fwd, NWAVES * 64, LDS_BYTES) != hipSuccess || per_cu < 1) { fprintf(stderr, "kernel_launch: occupancy query reports %d blocks per CU\n", per_cu); }
        (void)hipGetLastError();
        grid = cus;
        if (MK_GRID) grid = MK_GRID;
    }
    if (grid < 0) return;
    if (hipMemsetAsync((char*)d_ws + WS_CTL, 0, CTL_ZERO_BYTES, stream) != hipSuccess) return;
    Args a{};
    for (int i = 0; i < 26; ++i) a.in[i] = (const float*)d_in[i];
    a.out = (float*)d_out; a.ws = (unsigned char*)d_ws;
    const int nl = MK_PER_PHASE ? NPH : 1;
    for (int li = 0; li < nl; ++li) {
        a.ph_lo = MK_PER_PHASE ? li : 0; a.ph_hi = MK_PER_PHASE ? li + 1 : NPH; a.li = li;
        hipLaunchKernelGGL(hymba_fwd, dim3(grid), dim3(NWAVES * 64), LDS_BYTES, stream, a);
        const hipError_t le = hipPeekAtLastError();
        if (le != hipSuccess) { fprintf(stderr, "kernel_launch: launch %d failed: %s\n", li, hipGetErrorName(le)); break; }
    }
}
```

```cpp
#include <hip/hip_runtime.h>
#include <cstdio>
#include <cstdint>
#define MK_PER_PHASE 0
namespace pg8 {
#define PG8_LAS __attribute__((address_space(3)))
typedef unsigned short bf16_t;
typedef short bf16x8 __attribute__((ext_vector_type(8)));
typedef float f32x4 __attribute__((ext_vector_type(4)));
typedef unsigned u32x4 __attribute__((ext_vector_type(4)));
constexpr int BM = 256, BK = 64, HALF = 128, HTB = HALF * BK * 2  , STAGE_BYTES = 8 * HTB, NXCD = 8, WGM = 8;

__host__ __device__ __forceinline__ int lds_byte(int r, int c) { const int st = (r >> 4) * 2 + (c >> 5), rr = r & 15, cc = c & 31, ob = rr * 64 + cc * 2; return st * 1024 + (ob ^ (((ob >> 9) & 1) << 5)); }
__host__ __device__ __forceinline__ void stage_rc(int b, int& R, int& C) { const int st = b / 1024, sb = b % 1024, swz = sb ^ (((sb >> 9) & 1) << 5); R = (st >> 1) * 16 + swz / 64; C = (st & 1) * 32 + (swz % 64) / 2; }
__host__ __device__ __forceinline__ int perm32(int rho) { const int n = rho >> 4, i = rho & 15; return 8 * (i >> 2) + 4 * n + (i & 3); }

struct Unit { int pm, pn, k0, nt, ks; };
struct Gemm { const bf16_t* A; const bf16_t* Bt; int M, N, K; };

struct StaticOrder {
    int nM, nN, nwg, G, c, ntK, nsplit;
    __host__ __device__ void init(int M, int N, int G_, int c_, int ntK_, int nsplit_ = 0) { nM = M / BM; nN = N / BM; nwg = nM * nN; G = G_; c = c_; ntK = ntK_; nsplit = nsplit_; }
    __host__ __device__ __forceinline__ bool next(int i, Unit& u) const {
        int ii = i;
        if (nsplit > 0 && (nwg % G) == 0 && 2 * nN * nsplit == G && (c & 7) < 4) { const int nmain = nwg / G; ii = (i == 0) ? nmain : (i <= nmain ? i - 1 : i); }
        const long L = (long)ii * G + c;
        int pm, pn, k0 = 0, nt = ntK, ks = -1; bool ok = true;
        if (L >= nwg) {
            const int s = (int)(L - nwg); ok = (nsplit != 0) && (s < 2 * nN * nsplit);
            const int nsp = nsplit > 0 ? nsplit : 1, tile = s / nsp; ks = s - tile * nsp; pm = nM + tile / nN; pn = tile % nN; nt = ntK / nsp; k0 = ks * nt;
        } else {
            int wgid = (int)L; { const int q = nwg / NXCD, r = nwg % NXCD, xcd = wgid % NXCD, off = wgid / NXCD; wgid = (xcd < r ? xcd * (q + 1) : r * (q + 1) + (xcd - r) * q) + off; }
            const int nig = WGM * nN, gid = wgid / nig, fm = gid * WGM, gsz = (nM - fm) < WGM ? (nM - fm) : WGM;
            pm = fm + ((wgid % nig) % gsz); pn = (wgid % nig) / gsz;
        }
        u.pm = pm; u.pn = pn; u.k0 = k0; u.nt = nt; u.ks = ks; return ok;
    }
    __device__ __forceinline__ void a_ready(const Unit&) const {}
    __device__ __forceinline__ void done(const Unit&) const {}
};

typedef float f32x2c __attribute__((ext_vector_type(2)));
typedef __bf16 bf16x2c __attribute__((ext_vector_type(2)));
__device__ __forceinline__ unsigned cvt_pk_bf16(float lo, float hi) { const f32x2c v = {lo, hi}; return __builtin_bit_cast(unsigned, __builtin_convertvector(v, bf16x2c)); }
typedef float f32x2 __attribute__((ext_vector_type(2)));
template <class Epi, class Sched, bool ALIGN_EPI = false, bool SP2 = false>
__device__ __forceinline__ void gemm_phase(PG8_LAS unsigned char* lds, const Gemm g, const Sched& S, const Epi& E) {
    const int tid = threadIdx.x, wid = __builtin_amdgcn_readfirstlane(tid >> 6), lane = tid & 63, wr = wid >> 2, wc = wid & 3, fr = lane & 15, fq = lane >> 4;
    const int K = g.K;
    unsigned voffA[2], voffB[2];
#pragma unroll
    for (int i = 0; i < 2; ++i) { int R, C; stage_rc(tid * 16 + i * 8192, R, C); const int Rb = Epi::PERM ? ((R & ~31) + perm32(R & 31)) : R;
        voffA[i] = (unsigned)(R * K + C) * 2u; voffB[i] = (unsigned)(Rb * K + C) * 2u; }
    const size_t kstep = (size_t)(BK * 2);
    const size_t hstep = (size_t)HALF * K * 2;
    const size_t tstep = 2 * hstep;
    const unsigned ldsw = (unsigned)wid * 1024u;
    const int aoff = lds_byte(wr * 64 + fr, fq * 8), boff = lds_byte(wc * 32 + fr, fq * 8);
#define PG8_SA(b, h) (((b) * 2 + (h)) * HTB)
#define PG8_SB(b, h) ((4 + (b) * 2 + (h)) * HTB)
#define PG8_STAGE(bufoff, gbase, voff) do { _Pragma("unroll") for (int _i = 0; _i < 2; ++_i) \
        __builtin_amdgcn_global_load_lds((const unsigned*)((const char*)(gbase) + (voff)[_i]), (PG8_LAS unsigned*)(lds + (bufoff) + ldsw + _i * 8192), 16, 0, 0); } while (0)
#define PG8_LDA(dst, b, h) do { _Pragma("unroll") for (int m = 0; m < 4; ++m) _Pragma("unroll") for (int k = 0; k < 2; ++k) dst[m][k] = *(const PG8_LAS bf16x8*)(lds + PG8_SA(b, h) + aoff + m * 2048 + k * 1024); } while (0)
#define PG8_LDB(dst, b, h) do { _Pragma("unroll") for (int n = 0; n < 2; ++n) _Pragma("unroll") for (int k = 0; k < 2; ++k) dst[n][k] = *(const PG8_LAS bf16x8*)(lds + PG8_SB(b, h) + boff + n * 2048 + k * 1024); } while (0)
#define PG8_MMA(ai, bj, At, Bt) do { __builtin_amdgcn_s_setprio(1); _Pragma("unroll") for (int m = 0; m < 4; ++m) _Pragma("unroll") for (int n = 0; n < 2; ++n) _Pragma("unroll") for (int k = 0; k < 2; ++k) \
        acc[ai][bj][m][n] = __builtin_amdgcn_mfma_f32_16x16x32_bf16(Bt[n][k], At[m][k], acc[ai][bj][m][n], 0, 0, 0); __builtin_amdgcn_s_setprio(0); } while (0)
#define PG8_WAIT_V(n) asm volatile("s_waitcnt vmcnt(" #n ")" ::: "memory")
#define PG8_WAIT_L(n) asm volatile("s_waitcnt lgkmcnt(" #n ")" ::: "memory")
#define PG8_BAR __builtin_amdgcn_s_barrier()
#define PG8_SCHED __builtin_amdgcn_sched_barrier(0)
    Unit cur, nxt; int ui = 0;
    if (!S.next(0, cur)) return;
    f32x4 acc[2][2][4][2];
#pragma unroll
    for (int a = 0; a < 2; ++a)
#pragma unroll
        for (int b = 0; b < 2; ++b)
#pragma unroll
            for (int m = 0; m < 4; ++m)
#pragma unroll
                for (int n = 0; n < 2; ++n) acc[a][b][m][n] = (f32x4){0.f, 0.f, 0.f, 0.f};
    bf16x8 At[4][2], B0[2][2], B1[2][2];
    const char* cA = (const char*)g.A + (size_t)cur.pm * tstep + (size_t)cur.k0 * kstep; const char* cB = (const char*)g.Bt + (size_t)cur.pn * tstep + (size_t)cur.k0 * kstep;
    S.a_ready(cur);
    if constexpr (SP2) {
        PG8_STAGE(PG8_SB(0, 0), cB, voffB); PG8_STAGE(PG8_SB(0, 1), cB + hstep, voffB); PG8_STAGE(PG8_SA(0, 0), cA, voffA); PG8_STAGE(PG8_SA(0, 1), cA + hstep, voffA);
        if (wr == 1) PG8_BAR;
        PG8_WAIT_V(2); PG8_BAR;
        PG8_STAGE(PG8_SB(1, 0), cB + kstep, voffB); PG8_STAGE(PG8_SA(1, 0), cA + kstep, voffA); PG8_STAGE(PG8_SB(1, 1), cB + hstep + kstep, voffB);
        PG8_WAIT_V(6); PG8_BAR;
    } else {
        PG8_STAGE(PG8_SB(0, 0), cB, voffB); PG8_STAGE(PG8_SA(0, 0), cA, voffA); PG8_STAGE(PG8_SB(0, 1), cB + hstep, voffB); PG8_STAGE(PG8_SA(0, 1), cA + hstep, voffA);
        if (wr == 1) PG8_BAR;
        PG8_WAIT_V(4); PG8_BAR;
        PG8_STAGE(PG8_SB(1, 0), cB + kstep, voffB); PG8_STAGE(PG8_SA(1, 0), cA + kstep, voffA); PG8_STAGE(PG8_SB(1, 1), cB + hstep + kstep, voffB);
        PG8_WAIT_V(6); PG8_BAR;
    }
    for (;;) {
        const bool has_next = S.next(ui + 1, nxt);
        const char* nA = has_next ? (const char*)g.A + (size_t)nxt.pm * tstep + (size_t)nxt.k0 * kstep : cA; const char* nB = has_next ? (const char*)g.Bt + (size_t)nxt.pn * tstep + (size_t)nxt.k0 * kstep : cB;
        const int nt = cur.nt;
        for (int t = 0; t < nt; t += 2) {
            const bool last = (t == nt - 2);
            const char* a1 = cA + (size_t)(t + 1) * kstep;
            const char* a2 = last ? nA : cA + (size_t)(t + 2) * kstep; const char* b2 = last ? nB : cB + (size_t)(t + 2) * kstep;
            const char* a3 = a2 + kstep; const char* b3 = b2 + kstep;
            if (last && has_next) S.a_ready(nxt);
            if constexpr (SP2) {
            PG8_LDB(B0, 0, 0); PG8_LDB(B1, 0, 1); PG8_SCHED; PG8_LDA(At, 0, 0); PG8_STAGE(PG8_SA(1, 1), a1 + hstep, voffA);
            PG8_WAIT_V(8); PG8_WAIT_L(0); PG8_BAR; PG8_MMA(0, 0, At, B0); PG8_MMA(0, 1, At, B1); PG8_BAR; PG8_SCHED;
            PG8_LDA(At, 0, 1); PG8_STAGE(PG8_SB(0, 0), b2, voffB); PG8_STAGE(PG8_SB(0, 1), b2 + hstep, voffB); PG8_STAGE(PG8_SA(0, 0), a2, voffA);
            PG8_WAIT_V(8); PG8_WAIT_L(0); PG8_BAR; PG8_MMA(1, 0, At, B0); PG8_MMA(1, 1, At, B1); PG8_BAR; PG8_SCHED;
            PG8_LDB(B0, 1, 0); PG8_LDB(B1, 1, 1); PG8_SCHED; PG8_LDA(At, 1, 0); PG8_STAGE(PG8_SA(0, 1), a2 + hstep, voffA);
            PG8_WAIT_V(8); PG8_WAIT_L(0); PG8_BAR; PG8_MMA(0, 0, At, B0); PG8_MMA(0, 1, At, B1); PG8_BAR; PG8_SCHED;
            PG8_LDA(At, 1, 1); PG8_STAGE(PG8_SB(1, 0), b3, voffB); PG8_STAGE(PG8_SB(1, 1), b3 + hstep, voffB); PG8_STAGE(PG8_SA(1, 0), a3, voffA);
            PG8_WAIT_V(8); PG8_WAIT_L(0); PG8_BAR; PG8_MMA(1, 0, At, B0); PG8_MMA(1, 1, At, B1); PG8_BAR; PG8_SCHED;
            } else {
            PG8_LDB(B0, 0, 0); PG8_SCHED; PG8_LDA(At, 0, 0); PG8_STAGE(PG8_SA(1, 1), a1 + hstep, voffA);
            PG8_WAIT_L(8); PG8_BAR; PG8_WAIT_L(0); PG8_MMA(0, 0, At, B0); PG8_BAR; PG8_SCHED;
            PG8_LDB(B1, 0, 1); PG8_STAGE(PG8_SB(0, 0), b2, voffB);
            PG8_BAR; PG8_WAIT_L(0); PG8_MMA(0, 1, At, B1); PG8_BAR;
            PG8_LDA(At, 0, 1); PG8_STAGE(PG8_SA(0, 0), a2, voffA);
            PG8_BAR; PG8_WAIT_L(0); PG8_MMA(1, 0, At, B0); PG8_BAR; PG8_SCHED;
            PG8_STAGE(PG8_SB(0, 1), b2 + hstep, voffB);
            PG8_WAIT_V(6); PG8_BAR; PG8_MMA(1, 1, At, B1); PG8_BAR;
            PG8_LDB(B0, 1, 0); PG8_SCHED; PG8_LDA(At, 1, 0); PG8_STAGE(PG8_SA(0, 1), a2 + hstep, voffA);
            PG8_WAIT_L(8); PG8_BAR; PG8_WAIT_L(0); PG8_MMA(0, 0, At, B0); PG8_BAR; PG8_SCHED;
            PG8_LDB(B1, 1, 1); PG8_STAGE(PG8_SB(1, 0), b3, voffB);
            PG8_BAR; PG8_WAIT_L(0); PG8_MMA(0, 1, At, B1); PG8_BAR;
            PG8_LDA(At, 1, 1); PG8_STAGE(PG8_SA(1, 0), a3, voffA);
            PG8_BAR; PG8_WAIT_L(0); PG8_MMA(1, 0, At, B0); PG8_BAR; PG8_SCHED;
            PG8_STAGE(PG8_SB(1, 1), b3 + hstep, voffB);
            PG8_WAIT_V(6); PG8_BAR; PG8_MMA(1, 1, At, B1); PG8_BAR;
            }
        }
        if constexpr (ALIGN_EPI) { if (wr == 0) PG8_BAR; }
        if constexpr (!Epi::AFTER_DRAIN) { E(acc, cur, wr, wc, fr, fq); S.done(cur); }
        if (!has_next) break;
#pragma unroll
        for (int a = 0; a < 2; ++a)
#pragma unroll
            for (int b = 0; b < 2; ++b)
#pragma unroll
                for (int m = 0; m < 4; ++m)
#pragma unroll
                    for (int n = 0; n < 2; ++n) acc[a][b][m][n] = (f32x4){0.f, 0.f, 0.f, 0.f};
        cur = nxt; cA = nA; cB = nB; ++ui;
        if constexpr (ALIGN_EPI) { if (wr == 1) PG8_BAR; }
    }
    PG8_WAIT_V(0);
    if constexpr (!ALIGN_EPI) { if (wr == 0) PG8_BAR; }
    PG8_BAR;
    if constexpr (Epi::AFTER_DRAIN) { E.fused(acc, cur, wr, wc, fr, fq, lds, wid, lane); S.done(cur); }
#undef PG8_SA
#undef PG8_SB
#undef PG8_STAGE
#undef PG8_LDA
#undef PG8_LDB
#undef PG8_MMA
#undef PG8_WAIT_V
#undef PG8_WAIT_L
#undef PG8_BAR
#undef PG8_SCHED
}
}

constexpr int DM = 4096, SEQ = 16384, DBATCH = 16, DSEQ = 32, PAST = 4096, HD = 128, NH = 8, DSB = 1024, DLRU = 3072, NBLK = 16, BD = 192, DIN = 9216, DFF = 12288;
constexpr int MP = SEQ, MS = DBATCH * DSEQ, M = MP + MS;
constexpr float EPS = 1e-6f;
constexpr int NWAVES = 8;
#ifndef MK_PER_PHASE
#define MK_PER_PHASE 0
#endif
#ifndef MK_GRID
#define MK_GRID 0
#endif

constexpr size_t O_Y = 0, O_KP = (size_t)M * DM, O_VP = O_KP + (size_t)MP * DSB, O_HP = O_VP + (size_t)MP * DSB, O_CP = O_HP + DLRU, O_FP = O_CP + 3 * DLRU,
                 O_KS = O_FP + 2 * DFF, O_VS = O_KS + (size_t)MS * DSB, O_HS = O_VS + (size_t)MS * DSB, O_CS = O_HS + (size_t)DBATCH * DLRU, O_FS = O_CS + (size_t)DBATCH * 3 * DLRU,
                 O_END = O_FS + (size_t)DBATCH * 2 * DFF;
static_assert(O_END == 104435712, "d_out size");

constexpr size_t MiB = 1u << 20;
constexpr size_t WS_CTL = 0, CTL_ZERO_BYTES = 1 * MiB;
constexpr size_t WS_WA = 1 * MiB, WS_WX = WS_WA + (size_t)NBLK * BD * BD * 2;
constexpr size_t WS_AGGA = 4 * MiB, WS_AGGB = 7 * MiB;
constexpr size_t WS_C8 = 10 * MiB, WS_SSQ2 = 1292 * MiB, WS_S2 = 10 * MiB + 65536, WS_SSQS = 11 * MiB, WS_CARRY = 12 * MiB;
constexpr size_t WS_DUMP = 15 * MiB;
constexpr size_t WS_HALO = 832 * MiB, WS_DEFC = 840 * MiB, WS_DEFV = 848 * MiB;
constexpr size_t WS_Z = 970 * MiB;
constexpr size_t WS_WDOWN = 16 * MiB, WS_WUP = 112 * MiB, WS_BUFA = 304 * MiB, WS_ACT = 436 * MiB, WS_VALPRE = 832 * MiB, WS_PART = 1228 * MiB, WS_END = 1294 * MiB;
constexpr size_t WS_WIN = 436 * MiB, WS_WOUT = 508 * MiB, WS_U = 540 * MiB, WS_G = 639 * MiB, WS_QN = 738 * MiB, WS_KN = 771 * MiB, WS_VB = 804 * MiB, WS_Y = 837 * MiB;
static_assert(WS_SSQ2 + (size_t)M * 16 * 4 <= 1294 * MiB && WS_WX + (size_t)NBLK * BD * BD * 2 <= WS_AGGA && WS_SSQS + (size_t)M * 8 * 4 <= WS_CARRY && WS_CARRY + (size_t)256 * DLRU * 4 <= WS_WDOWN, "ws map (small)");
static_assert(WS_Z >= WS_Y + (size_t)M * DM * 2 && WS_Z + (size_t)MP * DLRU * 2 <= WS_PART, "ws map (Z)");
static_assert(WS_WDOWN + (size_t)DM * DFF * 2 <= WS_WUP && WS_WUP + (size_t)2 * DFF * DM * 2 <= WS_BUFA && WS_BUFA + (size_t)M * DM * 2 <= WS_ACT, "ws map (weights)");
static_assert(WS_ACT + (size_t)M * DFF * 2 <= WS_VALPRE && WS_VALPRE + (size_t)M * DFF * 2 <= WS_PART && WS_PART + (size_t)8 * MS * DM * 4 <= WS_SSQ2, "ws map (ffn)");
static_assert(WS_WIN + (size_t)DIN * DM * 2 <= WS_WOUT && WS_WOUT + (size_t)DM * DM * 2 <= WS_U && WS_U + (size_t)M * DLRU * 2 <= WS_G && WS_G + (size_t)M * DLRU * 2 <= WS_QN, "ws map (early 1)");
static_assert(WS_QN + (size_t)M * DSB * 2 <= WS_KN && WS_KN + (size_t)M * DSB * 2 <= WS_VB && WS_VB + (size_t)M * DSB * 2 <= WS_Y && WS_Y + (size_t)M * DM * 2 <= WS_PART, "ws map (early 2)");
constexpr int CW_TMO = 0, CW_CODE = 1, CW_Q1 = 64, CW_Q2 = 128, CW_DONE = 192, CW_BAR = 4096;

constexpr int RING_OFF = 0, RING_BYTES = 131072;
constexpr int EPI_OFF = RING_BYTES, EPI_BYTES = 8192;
constexpr int LDSCTL_OFF = EPI_OFF + EPI_BYTES, MISC_OFF = LDSCTL_OFF + 320;
constexpr int LDS_BYTES = 147456;
static_assert(MISC_OFF + 128 <= LDS_BYTES, "LDS map");

#define GAS __attribute__((address_space(1)))
#define LAS __attribute__((address_space(3)))
typedef unsigned short bf16;
typedef unsigned v4u __attribute__((ext_vector_type(4)));
typedef unsigned v2u __attribute__((ext_vector_type(2)));
typedef float f32x4 __attribute__((ext_vector_type(4)));
typedef short bf16x8 __attribute__((ext_vector_type(8)));
typedef GAS unsigned gu32;
#define RLX_AGENT __ATOMIC_RELAXED, __HIP_MEMORY_SCOPE_AGENT
#define LDS_WAIT() asm volatile("s_waitcnt lgkmcnt(0)" ::: "memory")
#define VM_WAIT() asm volatile("s_waitcnt vmcnt(0)" ::: "memory")
#define WG_BAR() do { asm volatile("s_waitcnt lgkmcnt(0)" ::: "memory"); __builtin_amdgcn_s_barrier(); asm volatile("" ::: "memory"); } while (0)
using pg8::cvt_pk_bf16;
__device__ __forceinline__ float bflo(unsigned w) { return __builtin_bit_cast(float, w << 16); }
__device__ __forceinline__ float bfhi(unsigned w) { return __builtin_bit_cast(float, w & 0xffff0000u); }
__device__ __forceinline__ float fexp2(float x) { return __builtin_amdgcn_exp2f(x); }
__device__ __forceinline__ float flog2(float x) { return __builtin_amdgcn_logf(x); }
__device__ __forceinline__ float frcp(float x) { return __builtin_amdgcn_rcpf(x); }
__device__ __forceinline__ float sigmoidf_(float x) { return frcp(1.0f + fexp2(-1.4426950408889634f * x)); }
__device__ __forceinline__ float gelu_tanh(float x) { const float u = x * (1.0f + 0.044715f * x * x); return x * frcp(1.0f + fexp2(-2.302208198f * u)); }
typedef float f32x2 __attribute__((ext_vector_type(2)));
__device__ __forceinline__ f32x2 gelu_tanh2(f32x2 x) {
    const f32x2 t = (x * x) * (-2.302208198f * 0.044715f) + (-2.302208198f), a = x * t;
    f32x2 e; e.x = fexp2(a.x); e.y = fexp2(a.y);
    const f32x2 d = e + 1.0f;
    f32x2 r; r.x = frcp(d.x); r.y = frcp(d.y);
    return x * r;
}
__device__ __forceinline__ f32x2 sigmoid2(f32x2 x) { const f32x2 a = x * (-1.4426950408889634f); f32x2 e; e.x = fexp2(a.x); e.y = fexp2(a.y); const f32x2 d = e + 1.0f; f32x2 r; r.x = frcp(d.x); r.y = frcp(d.y); return r; }
__device__ __forceinline__ float wave_sum(float v) {
#pragma unroll
    for (int o = 1; o < 64; o <<= 1) v += __shfl_xor(v, o);
    return v;
}
template <int S> __device__ __forceinline__ float dpp_ror(float v) {
    return __builtin_bit_cast(float, __builtin_amdgcn_update_dpp(0, __builtin_bit_cast(int, v), 0x120 + S, 0xF, 0xF, true));
}
template <int S> __device__ __forceinline__ float dpp_shr(float oldv, float v) {
    return __builtin_bit_cast(float, __builtin_amdgcn_update_dpp(__builtin_bit_cast(int, oldv), __builtin_bit_cast(int, v), 0x110 + S, 0xF, 0xF, false));
}
__device__ __forceinline__ void row_scan_ab(float& a, float& b) {
    { const float ap = dpp_shr<1>(1.0f, a), bp = dpp_shr<1>(0.0f, b); b = a * bp + b; a = a * ap; }
    { const float ap = dpp_shr<2>(1.0f, a), bp = dpp_shr<2>(0.0f, b); b = a * bp + b; a = a * ap; }
    { const float ap = dpp_shr<4>(1.0f, a), bp = dpp_shr<4>(0.0f, b); b = a * bp + b; a = a * ap; }
    { const float ap = dpp_shr<8>(1.0f, a), bp = dpp_shr<8>(0.0f, b); b = a * bp + b; a = a * ap; }
}

#define SCAN_STEP_(S) \
    "v_fmac_f32_dpp %0, %0, %4 row_shr:" #S " row_mask:0xf bank_mask:0xf\n\t" "v_fmac_f32_dpp %1, %1, %5 row_shr:" #S " row_mask:0xf bank_mask:0xf\n\t" \
    "v_fmac_f32_dpp %2, %2, %6 row_shr:" #S " row_mask:0xf bank_mask:0xf\n\t" "v_fmac_f32_dpp %3, %3, %7 row_shr:" #S " row_mask:0xf bank_mask:0xf\n\t" \
    "v_mul_f32_dpp %4, %4, %4 row_shr:" #S " row_mask:0xf bank_mask:0xf\n\t" "v_mul_f32_dpp %5, %5, %5 row_shr:" #S " row_mask:0xf bank_mask:0xf\n\t" \
    "v_mul_f32_dpp %6, %6, %6 row_shr:" #S " row_mask:0xf bank_mask:0xf\n\t" "v_mul_f32_dpp %7, %7, %7 row_shr:" #S " row_mask:0xf bank_mask:0xf\n\t"
__device__ __forceinline__ void row_scan_ab4(f32x4& a, f32x4& b) {
    float a0 = a[0], a1 = a[1], a2 = a[2], a3 = a[3], b0 = b[0], b1 = b[1], b2 = b[2], b3 = b[3];
    asm volatile("s_nop 1\n\t" SCAN_STEP_(1) SCAN_STEP_(2) SCAN_STEP_(4) SCAN_STEP_(8) "s_nop 0"
                 : "+v"(b0), "+v"(b1), "+v"(b2), "+v"(b3), "+v"(a0), "+v"(a1), "+v"(a2), "+v"(a3));
    a = (f32x4){a0, a1, a2, a3}; b = (f32x4){b0, b1, b2, b3};
}

#define XB_TMO      128
#define XB_XCNT(j)  (256  + 64 * (j))
#define XB_XSUB(j)  (1280 + 64 * (j))
#define XB_XGEN(j)  (2304 + 64 * (j))
#define XB_TOP      3328
#define XB_TOPGEN   3392
#define XCD_BAR_WORDS 3456
#define XB_SPIN_CAP (1u << 18)

__device__ __forceinline__ unsigned xb_ld(unsigned* p)              { return __hip_atomic_load(p, __ATOMIC_RELAXED, __HIP_MEMORY_SCOPE_AGENT); }
__device__ __forceinline__ unsigned xb_add(unsigned* p, unsigned v) { return __hip_atomic_fetch_add(p, v, __ATOMIC_RELAXED, __HIP_MEMORY_SCOPE_AGENT); }
__device__ __forceinline__ unsigned xb_xcc_id() { return (unsigned)__builtin_amdgcn_s_getreg((3 << 11) | 20) & 0xFu; }
#define XB_SPIN(cond, bar) do { unsigned _sp = 0; while (cond) { __builtin_amdgcn_s_sleep(1); \
    if ((++_sp & 255u) == 0u) { if (xb_ld(&(bar)[XB_TMO])) break; if (_sp > XB_SPIN_CAP) { atomicAdd(&(bar)[XB_TMO], 1u); break; } } } } while (0)

struct XcdBarrier {
    unsigned* bar; unsigned x;
    volatile LAS unsigned* st;
};

__device__ __forceinline__ XcdBarrier xcd_barrier_post(unsigned* bar, volatile LAS unsigned* st) {
    XcdBarrier b; b.bar = bar; b.x = xb_xcc_id(); b.st = st;
    if (threadIdx.x == 0) (void)xb_add(&bar[XB_XCNT(b.x)], 1u);
    return b;
}
__device__ __forceinline__ void xcd_barrier_complete(unsigned* bar, unsigned x, unsigned& nloc, unsigned& nx) {
    const unsigned G = gridDim.x * gridDim.y * gridDim.z;
    unsigned sum, cnt, mine, sp = 0u;
    for (;;) {
        sum = 0u; cnt = 0u; mine = 0u;
#pragma unroll
        for (unsigned j = 0; j < 16; ++j) { const unsigned c = xb_ld(&bar[XB_XCNT(j)]); sum += c; cnt += (c > 0u) ? 1u : 0u; mine = (j == x) ? c : mine; }
        if (sum == G) break;
        __builtin_amdgcn_s_sleep(1);
        if ((++sp & 255u) == 0u) { if (xb_ld(&bar[XB_TMO])) break; if (sp > XB_SPIN_CAP) { atomicAdd(&bar[XB_TMO], 1u); break; } }
    }
    nloc = mine > 0u ? mine : 1u; nx = cnt > 0u ? cnt : 1u;
}

__device__ __forceinline__ void xcd_barrier(const XcdBarrier& b) {
    asm volatile("s_waitcnt vmcnt(0)" ::: "memory");
    __syncthreads();
    if (threadIdx.x == 0) {
        unsigned* bar = b.bar;
        __builtin_amdgcn_s_waitcnt(0);
        unsigned nloc = b.st[0], nx = b.st[1];
        if (nloc == 0u) { xcd_barrier_complete(bar, b.x, nloc, nx); b.st[0] = nloc; b.st[1] = nx; }
        const unsigned old = xb_add(&bar[XB_XSUB(b.x)], 1u);
        const unsigned gen = old / nloc;
        if (old + 1u == (gen + 1u) * nloc) {
            __builtin_amdgcn_fence(__ATOMIC_RELEASE, "agent");
            asm volatile("s_waitcnt vmcnt(0)" ::: "memory");
            const unsigned og = xb_add(&bar[XB_TOP], 1u);
            const unsigned tg = og / nx;
            if (og + 1u == (tg + 1u) * nx) xb_add(&bar[XB_TOPGEN], 1u);
            else XB_SPIN(xb_ld(&bar[XB_TOPGEN]) == tg, bar);
            __builtin_amdgcn_fence(__ATOMIC_ACQUIRE, "agent");
            xb_add(&bar[XB_XGEN(b.x)], 1u);
            asm volatile("s_waitcnt vmcnt(0)" ::: "memory");
        } else {
            XB_SPIN(xb_ld(&bar[XB_XGEN(b.x)]) == gen, bar);
            __builtin_amdgcn_fence(__ATOMIC_ACQUIRE, "agent");
            asm volatile("s_waitcnt vmcnt(0)" ::: "memory");
        }
    }
    __syncthreads();
}
constexpr size_t WS_X1 = WS_Z;
static_assert(WS_X1 >= WS_Y + (size_t)M * DM * 2 && WS_X1 + (size_t)MP * DM * 2 <= WS_PART, "ws map (X1)");

struct Args { const float* in[26]; float* out; unsigned char* ws; int ph_lo, ph_hi, li, pad; };
struct Frame {
    LAS unsigned char* lds;
    volatile LAS unsigned* MISC;
    gu32* ctl;
    int tid, lane, wave, vcu, G;
    const Args* a;
    __device__ __forceinline__ const float* x_p() const { return a->in[0]; }
    __device__ __forceinline__ const float* x_s() const { return a->in[1]; }
    __device__ __forceinline__ const float* cache_k() const { return a->in[2]; }
    __device__ __forceinline__ const float* cache_v() const { return a->in[3]; }
    __device__ __forceinline__ const float* st_h() const { return a->in[4]; }
    __device__ __forceinline__ const float* st_conv() const { return a->in[5]; }
    __device__ __forceinline__ const float* st_ffn() const { return a->in[6]; }
    __device__ __forceinline__ const float* g_mix() const { return a->in[7]; }
    __device__ __forceinline__ const float* w_in() const { return a->in[8]; }
    __device__ __forceinline__ const float* cw() const { return a->in[9]; }
    __device__ __forceinline__ const float* cb() const { return a->in[10]; }
    __device__ __forceinline__ const float* w_a() const { return a->in[11]; }
    __device__ __forceinline__ const float* b_a() const { return a->in[12]; }
    __device__ __forceinline__ const float* w_x() const { return a->in[13]; }
    __device__ __forceinline__ const float* b_x() const { return a->in[14]; }
    __device__ __forceinline__ const float* lam() const { return a->in[15]; }
    __device__ __forceinline__ const float* qg() const { return a->in[16]; }
    __device__ __forceinline__ const float* kg() const { return a->in[17]; }
    __device__ __forceinline__ const float* g_lru() const { return a->in[18]; }
    __device__ __forceinline__ const float* g_sb() const { return a->in[19]; }
    __device__ __forceinline__ const float* w_out() const { return a->in[20]; }
    __device__ __forceinline__ const float* g_ffn() const { return a->in[21]; }
    __device__ __forceinline__ const float* w_up() const { return a->in[22]; }
    __device__ __forceinline__ const float* fcw() const { return a->in[23]; }
    __device__ __forceinline__ const float* fcb() const { return a->in[24]; }
    __device__ __forceinline__ const float* w_down() const { return a->in[25]; }
    __device__ __forceinline__ float* out() const { return a->out; }
    __device__ __forceinline__ bf16* Wa_t() const { return (bf16*)(a->ws + WS_WA); }
    __device__ __forceinline__ bf16* Wx_t() const { return (bf16*)(a->ws + WS_WX); }
    __device__ __forceinline__ bf16* Win_t() const { return (bf16*)(a->ws + WS_WIN); }
    __device__ __forceinline__ bf16* Wout_t() const { return (bf16*)(a->ws + WS_WOUT); }
    __device__ __forceinline__ bf16* Wup_t() const { return (bf16*)(a->ws + WS_WUP); }
    __device__ __forceinline__ bf16* Wdown_t() const { return (bf16*)(a->ws + WS_WDOWN); }
    __device__ __forceinline__ bf16* BUFA() const { return (bf16*)(a->ws + WS_BUFA); }
    __device__ __forceinline__ bf16* ACT() const { return (bf16*)(a->ws + WS_ACT); }
    __device__ __forceinline__ bf16* VALPRE() const { return (bf16*)(a->ws + WS_VALPRE); }
    __device__ __forceinline__ bf16* U() const { return (bf16*)(a->ws + WS_U); }
    __device__ __forceinline__ bf16* Gt() const { return (bf16*)(a->ws + WS_G); }
    __device__ __forceinline__ bf16* Qn() const { return (bf16*)(a->ws + WS_QN); }
    __device__ __forceinline__ bf16* Kn() const { return (bf16*)(a->ws + WS_KN); }
    __device__ __forceinline__ bf16* Vb() const { return (bf16*)(a->ws + WS_VB); }
    __device__ __forceinline__ bf16* Y() const { return (bf16*)(a->ws + WS_Y); }
    __device__ __forceinline__ float* AggA() const { return (float*)(a->ws + WS_AGGA); }
    __device__ __forceinline__ float* AggB() const { return (float*)(a->ws + WS_AGGB); }
    __device__ __forceinline__ float* C8() const { return (float*)(a->ws + WS_C8); }
    __device__ __forceinline__ float* Carry() const { return (float*)(a->ws + WS_CARRY); }
    __device__ __forceinline__ bf16* Z() const { return (bf16*)(a->ws + WS_Z); }
    __device__ __forceinline__ float* Part() const { return (float*)(a->ws + WS_PART); }
    __device__ __forceinline__ bf16* X1() const { return (bf16*)(a->ws + WS_X1); }
    __device__ __forceinline__ float* Halo() const { return (float*)(a->ws + WS_HALO); }
    __device__ __forceinline__ float* DefC() const { return (float*)(a->ws + WS_DEFC); }
    __device__ __forceinline__ float* DefV() const { return (float*)(a->ws + WS_DEFV); }
    __device__ __forceinline__ float* SsqS() const { return (float*)(a->ws + WS_SSQS); }
};

constexpr int TR_WAVE_BYTES = 64 * 65 * 4;
static_assert(NWAVES * TR_WAVE_BYTES <= RING_BYTES + EPI_BYTES, "transposer scratch");
template <bool NT = false> __device__ __forceinline__ void p0_transpose_item(const float* W, int K, int N, bf16* WT, int k0, int n0, int drow, LAS float* scr, int lane) {
    float tv[64];
#pragma unroll
    for (int i = 0; i < 64; ++i) tv[i] = __builtin_nontemporal_load(W + (size_t)(k0 + i) * N + n0 + lane);
#pragma unroll
    for (int i = 0; i < 64; ++i) scr[i * 65 + lane] = tv[i];
    LDS_WAIT(); asm volatile("" ::: "memory");
    const int c = lane & 7;
#pragma unroll
    for (int j = 0; j < 8; ++j) { const int n = (lane >> 3) + 8 * j; const LAS float* s = scr + (8 * c) * 65 + n;
        v4u o; o.x = cvt_pk_bf16(s[0 * 65], s[1 * 65]); o.y = cvt_pk_bf16(s[2 * 65], s[3 * 65]); o.z = cvt_pk_bf16(s[4 * 65], s[5 * 65]); o.w = cvt_pk_bf16(s[6 * 65], s[7 * 65]);
        if (NT) __builtin_nontemporal_store(o, (GAS v4u*)(WT + (size_t)(drow + n) * K + k0 + 8 * c)); else *(GAS v4u*)(WT + (size_t)(drow + n) * K + k0 + 8 * c) = o; }
    LDS_WAIT(); asm volatile("" ::: "memory");
}
#define TR_LOAD(tv, W, N, k0, n0) do { const float* _w = (W) + (size_t)(k0) * (N) + (n0) + lane; _Pragma("unroll") for (int i = 0; i < 64; ++i) tv[i] = __builtin_nontemporal_load(_w + (size_t)i * (N)); } while (0)
#define TR_FIN(tv, WT, K, k0, drow, NT) do { _Pragma("unroll") for (int i = 0; i < 64; ++i) scr[i * 65 + lane] = tv[i]; \
        LDS_WAIT(); asm volatile("" ::: "memory"); const int _c = lane & 7; \
        _Pragma("unroll") for (int j = 0; j < 8; ++j) { const int n = (lane >> 3) + 8 * j; const LAS float* sp = scr + (8 * _c) * 65 + n; \
            v4u o; o.x = cvt_pk_bf16(sp[0 * 65], sp[1 * 65]); o.y = cvt_pk_bf16(sp[2 * 65], sp[3 * 65]); o.z = cvt_pk_bf16(sp[4 * 65], sp[5 * 65]); o.w = cvt_pk_bf16(sp[6 * 65], sp[7 * 65]); \
            if (NT) __builtin_nontemporal_store(o, (GAS v4u*)((WT) + (size_t)((drow) + n) * (K) + (k0) + 8 * _c)); else *(GAS v4u*)((WT) + (size_t)((drow) + n) * (K) + (k0) + 8 * _c) = o; } \
        LDS_WAIT(); asm volatile("" ::: "memory"); } while (0)
#define TR_SB __builtin_amdgcn_sched_barrier(0)
__device__ __forceinline__ void rms_row_to_bf16(const float* xrow, const float* g, bf16* orow, int lane) {
    const GAS f32x4* xr = (const GAS f32x4*)xrow + lane;
    f32x4 v[16]; float s = 0.f;
#pragma unroll
    for (int j = 0; j < 16; ++j) { v[j] = __builtin_nontemporal_load(xr + 64 * j); s += (v[j].x * v[j].x + v[j].y * v[j].y) + (v[j].z * v[j].z + v[j].w * v[j].w); }
    const float rs = 1.0f / sqrtf(wave_sum(s) * (1.0f / DM) + EPS);
    const GAS f32x4* gr = (const GAS f32x4*)g + lane;
    GAS v2u* o8 = (GAS v2u*)orow + lane;
#pragma unroll
    for (int j = 0; j < 16; ++j) { const f32x4 gv = gr[64 * j]; v2u o; o.x = cvt_pk_bf16(v[j].x * rs * gv.x, v[j].y * rs * gv.y); o.y = cvt_pk_bf16(v[j].z * rs * gv.z, v[j].w * rs * gv.w); o8[64 * j] = o; }
}
__device__ __forceinline__ void rms_row_bf16_to_bf16(const bf16* xrow, const float* g, bf16* orow, int lane) {
    const GAS v4u* xr = (const GAS v4u*)xrow + lane;
    v4u v[8]; float s = 0.f;
#pragma unroll
    for (int j = 0; j < 8; ++j) { v[j] = __builtin_nontemporal_load(xr + 64 * j);
        const float a0 = bflo(v[j].x), a1 = bfhi(v[j].x), a2 = bflo(v[j].y), a3 = bfhi(v[j].y), a4 = bflo(v[j].z), a5 = bfhi(v[j].z), a6 = bflo(v[j].w), a7 = bfhi(v[j].w);
        s += ((a0 * a0 + a1 * a1) + (a2 * a2 + a3 * a3)) + ((a4 * a4 + a5 * a5) + (a6 * a6 + a7 * a7)); }
    const float rs = 1.0f / sqrtf(wave_sum(s) * (1.0f / DM) + EPS);
    const GAS f32x4* gr = (const GAS f32x4*)g + 2 * lane;
    GAS v4u* o8 = (GAS v4u*)orow + lane;
#pragma unroll
    for (int j = 0; j < 8; ++j) { const f32x4 g0 = gr[128 * j], g1 = gr[128 * j + 1]; v4u o;
        o.x = cvt_pk_bf16(bflo(v[j].x) * rs * g0.x, bfhi(v[j].x) * rs * g0.y); o.y = cvt_pk_bf16(bflo(v[j].y) * rs * g0.z, bfhi(v[j].y) * rs * g0.w);
        o.z = cvt_pk_bf16(bflo(v[j].z) * rs * g1.x, bfhi(v[j].z) * rs * g1.y); o.w = cvt_pk_bf16(bflo(v[j].w) * rs * g1.z, bfhi(v[j].w) * rs * g1.w); o8[64 * j] = o; }
}
__device__ __forceinline__ void sample_row_reduce(const float* base, const float* part, int rs, float* dst, const float* g, bf16* orow, int lane) {
    f32x4 v[16]; float s = 0.f;
#pragma unroll
    for (int j = 0; j < 16; ++j) v[j] = ((const GAS f32x4*)base)[lane + 64 * j];
#pragma unroll 2
    for (int ks = 0; ks < 8; ++ks) { const GAS f32x4* pr = (const GAS f32x4*)(part + ((size_t)ks * MS + rs) * DM) + lane;
#pragma unroll
        for (int j = 0; j < 16; ++j) v[j] = v[j] + pr[64 * j]; }
#pragma unroll
    for (int j = 0; j < 16; ++j) { ((GAS f32x4*)dst)[lane + 64 * j] = v[j]; s += (v[j].x * v[j].x + v[j].y * v[j].y) + (v[j].z * v[j].z + v[j].w * v[j].w); }
    if (orow) {
        const float rsn = 1.0f / sqrtf(wave_sum(s) * (1.0f / DM) + EPS);
        const GAS f32x4* gr = (const GAS f32x4*)g + lane; GAS v2u* o8 = (GAS v2u*)orow + lane;
#pragma unroll
        for (int j = 0; j < 16; ++j) { const f32x4 gv = gr[64 * j]; v2u o; o.x = cvt_pk_bf16(v[j].x * rsn * gv.x, v[j].y * rsn * gv.y); o.y = cvt_pk_bf16(v[j].z * rsn * gv.z, v[j].w * rsn * gv.w); o8[64 * j] = o; }
    }
}
__device__ __forceinline__ void hn_rows(Frame& F) {
    const int gw = F.vcu * NWAVES + F.wave, NGW = F.G * NWAVES, lane = F.lane, nfull = M / NGW;
    int m = gw;
    if (nfull >= 2 && (nfull & 1) == 0) {
        f32x4 va[16], vb[16];
        LAS f32x4* gl = (LAS f32x4*)(F.lds + RING_OFF + F.wave * TR_WAVE_BYTES) + lane;
#define HN_LOAD(v, mm) do { const int _m = (mm); const GAS f32x4* _x = (const GAS f32x4*)(_m < MP ? F.x_p() + (size_t)_m * DM : F.x_s() + (size_t)(_m - MP) * DM) + lane; \
        _Pragma("unroll") for (int j = 0; j < 16; ++j) v[j] = __builtin_nontemporal_load(_x + 64 * j); } while (0)
#define HN_FIN(v, mm) do { float _s = 0.f; _Pragma("unroll") for (int j = 0; j < 16; ++j) _s += (v[j].x * v[j].x + v[j].y * v[j].y) + (v[j].z * v[j].z + v[j].w * v[j].w); \
        const float _rs = 1.0f / sqrtf(wave_sum(_s) * (1.0f / DM) + EPS); GAS v2u* _o = (GAS v2u*)(F.BUFA() + (size_t)(mm) * DM) + lane; \
        LAS f32x4* _g = gl; asm volatile("" : "+v"(_g));     \
        _Pragma("unroll") for (int j = 0; j < 16; ++j) { const f32x4 g = _g[64 * j]; v2u o; o.x = cvt_pk_bf16(v[j].x * _rs * g.x, v[j].y * _rs * g.y); o.y = cvt_pk_bf16(v[j].z * _rs * g.z, v[j].w * _rs * g.w); _o[64 * j] = o; } } while (0)
        HN_LOAD(va, m); __builtin_amdgcn_sched_barrier(0);
        { const GAS f32x4* gr = (const GAS f32x4*)F.g_mix() + lane;
#pragma unroll
          for (int j = 0; j < 16; ++j) gl[64 * j] = gr[64 * j]; }
        LDS_WAIT(); asm volatile("" ::: "memory");
        for (int k = 0; k + 2 < nfull; k += 2) { HN_LOAD(vb, m + NGW); __builtin_amdgcn_sched_barrier(0); HN_FIN(va, m); __builtin_amdgcn_sched_barrier(0); HN_LOAD(va, m + 2 * NGW); __builtin_amdgcn_sched_barrier(0); HN_FIN(vb, m + NGW); __builtin_amdgcn_sched_barrier(0); m += 2 * NGW; }
        HN_LOAD(vb, m + NGW); __builtin_amdgcn_sched_barrier(0); HN_FIN(va, m); __builtin_amdgcn_sched_barrier(0); HN_FIN(vb, m + NGW); m += 2 * NGW;
#undef HN_LOAD
#undef HN_FIN
    }
    if (NGW == 2048 && m == nfull * NGW + gw) { int r = gw - 1312; if (r < 0) r += NGW; m = nfull * NGW + r; }
    for (; m < M; m += NGW) rms_row_to_bf16(m < MP ? F.x_p() + (size_t)m * DM : F.x_s() + (size_t)(m - MP) * DM, F.g_mix(), F.BUFA() + (size_t)m * DM, lane);
}
__device__ __forceinline__ void hn2_rows(Frame& F) {
    const int gw = F.vcu * NWAVES + F.wave, NGW = F.G * NWAVES, lane = F.lane, nfull = MP / NGW;
    int m = gw;
    if (nfull >= 2 && (nfull & 1) == 0) {
        v4u va[8], vb[8];
        LAS f32x4* gl = (LAS f32x4*)(F.lds + RING_OFF + F.wave * TR_WAVE_BYTES);

#define H2_LOAD(v, mm) do { const GAS v4u* _x = (const GAS v4u*)(F.X1() + (size_t)(mm) * DM) + lane; _Pragma("unroll") for (int j = 0; j < 8; ++j) v[j] = __builtin_nontemporal_load(_x + 64 * j); } while (0)
#define H2_FIN(v, mm) do { float _s = 0.f; _Pragma("unroll") for (int j = 0; j < 8; ++j) { \
            const float a0 = bflo(v[j].x), a1 = bfhi(v[j].x), a2 = bflo(v[j].y), a3 = bfhi(v[j].y), a4 = bflo(v[j].z), a5 = bfhi(v[j].z), a6 = bflo(v[j].w), a7 = bfhi(v[j].w); \
            _s += ((a0 * a0 + a1 * a1) + (a2 * a2 + a3 * a3)) + ((a4 * a4 + a5 * a5) + (a6 * a6 + a7 * a7)); } \
        const float _rs = 1.0f / sqrtf(wave_sum(_s) * (1.0f / DM) + EPS); GAS v4u* _o = (GAS v4u*)(F.BUFA() + (size_t)(mm) * DM) + lane; \
        LAS f32x4* _g = gl; asm volatile("" : "+v"(_g)); \
        _Pragma("unroll") for (int j = 0; j < 8; ++j) { const f32x4 g0 = _g[128 * j], g1 = _g[128 * j + 1]; v4u o; \
            o.x = cvt_pk_bf16(bflo(v[j].x) * _rs * g0.x, bfhi(v[j].x) * _rs * g0.y); o.y = cvt_pk_bf16(bflo(v[j].y) * _rs * g0.z, bfhi(v[j].y) * _rs * g0.w); \
            o.z = cvt_pk_bf16(bflo(v[j].z) * _rs * g1.x, bfhi(v[j].z) * _rs * g1.y); o.w = cvt_pk_bf16(bflo(v[j].w) * _rs * g1.z, bfhi(v[j].w) * _rs * g1.w); _o[64 * j] = o; } } while (0)
        H2_LOAD(va, m); __builtin_amdgcn_sched_barrier(0);
        { const GAS f32x4* gr = (const GAS f32x4*)F.g_ffn() + lane;
#pragma unroll
          for (int j = 0; j < 16; ++j) gl[lane + 64 * j] = gr[64 * j]; }
        LDS_WAIT(); asm volatile("" ::: "memory");
        gl += 2 * lane;
        for (int k = 0; k + 2 < nfull; k += 2) { H2_LOAD(vb, m + NGW); __builtin_amdgcn_sched_barrier(0); H2_FIN(va, m); __builtin_amdgcn_sched_barrier(0); H2_LOAD(va, m + 2 * NGW); __builtin_amdgcn_sched_barrier(0); H2_FIN(vb, m + NGW); __builtin_amdgcn_sched_barrier(0); m += 2 * NGW; }
        H2_LOAD(vb, m + NGW); __builtin_amdgcn_sched_barrier(0); H2_FIN(va, m); __builtin_amdgcn_sched_barrier(0); H2_FIN(vb, m + NGW); m += 2 * NGW;
#undef H2_LOAD
#undef H2_FIN
    }
    for (; m < MP; m += NGW) rms_row_bf16_to_bf16(F.X1() + (size_t)m * DM, F.g_ffn(), F.BUFA() + (size_t)m * DM, lane);
}
__device__ __forceinline__ void p0_prologue(Frame& F) {
    LAS float* scr = (LAS float*)(F.lds + RING_OFF + F.wave * TR_WAVE_BYTES);
    const int gw = F.vcu * NWAVES + F.wave, NGW = F.G * NWAVES;
    constexpr int I_IN = (DM / 64) * (DIN / 64), I_G = NBLK * 3 * 3;
    constexpr int NITEMS = I_IN + 2 * I_G;
    int it0 = gw;
    if (4 * NGW <= I_IN) {
        const int lane = F.lane; constexpr int nb = DIN / 64; float ta[64], tb[64];
        const int i0 = gw, i1 = gw + NGW, i2 = gw + 2 * NGW, i3 = gw + 3 * NGW;
        TR_LOAD(ta, F.w_in(), DIN, 64 * (i0 / nb), 64 * (i0 % nb)); TR_SB;
        TR_LOAD(tb, F.w_in(), DIN, 64 * (i1 / nb), 64 * (i1 % nb)); TR_SB; TR_FIN(ta, F.Win_t(), DM, 64 * (i0 / nb), 64 * (i0 % nb), false); TR_SB;
        TR_LOAD(ta, F.w_in(), DIN, 64 * (i2 / nb), 64 * (i2 % nb)); TR_SB; TR_FIN(tb, F.Win_t(), DM, 64 * (i1 / nb), 64 * (i1 % nb), false); TR_SB;
        TR_LOAD(tb, F.w_in(), DIN, 64 * (i3 / nb), 64 * (i3 % nb)); TR_SB; TR_FIN(ta, F.Win_t(), DM, 64 * (i2 / nb), 64 * (i2 % nb), false); TR_SB;
        TR_FIN(tb, F.Win_t(), DM, 64 * (i3 / nb), 64 * (i3 % nb), false);
        it0 = gw + 4 * NGW;
    }
    for (int it = it0; it < NITEMS; it += NGW) {
        int r = it;
        if (r < I_IN) { const int nb = DIN / 64, kb = r / nb, n0 = 64 * (r % nb); p0_transpose_item(F.w_in(), DM, DIN, F.Win_t(), 64 * kb, n0, n0, scr, F.lane); continue; } r -= I_IN;
        { const int which = r / I_G; r -= which * I_G; const int blk = r / 9, q = r % 9, kb = q / 3, n0 = 64 * (q % 3);
          p0_transpose_item((which ? F.w_x() : F.w_a()) + (size_t)blk * BD * BD, BD, BD, (which ? F.Wx_t() : F.Wa_t()) + (size_t)blk * BD * BD, 64 * kb, n0, n0, scr, F.lane); }
    }
    if (gw < DLRU / 64) { const int ch = gw * 64 + F.lane; const float l = F.lam()[ch]; F.C8()[ch] = 8.0f * 1.4426950408889634f * (fminf(l, 0.f) - log1pf(expf(-fabsf(l)))); }
    hn_rows(F);
}

constexpr int NCONV = 16;
template <bool SECOND> __device__ __forceinline__ void conv_queue(Frame& F) {
    LAS float* scr = (LAS float*)(F.lds + RING_OFF + F.wave * TR_WAVE_BYTES);
    constexpr int I_OUT = (DM / 64) * (DM / 64), I_DN = (DFF / 64) * (DM / 64), I_UP = (DM / 64) * (2 * DFF / 64), I_DN1 = I_DN / 3, NIT = SECOND ? I_DN - I_DN1 : I_OUT + I_UP + I_DN1;
    for (;;) {
        int base = 0;
        if (F.lane == 0) base = (int)__hip_atomic_fetch_add((unsigned*)(F.ctl + (SECOND ? CW_Q2 : CW_Q1)), 4u, __ATOMIC_RELAXED, __HIP_MEMORY_SCOPE_AGENT);
        base = __builtin_amdgcn_readfirstlane(base);
        if (base >= NIT) break;
        for (int it = base; it < base + 4 && it < NIT; ++it) {
            int r = it;
            if (SECOND || r >= I_OUT + I_UP) { r = SECOND ? r + I_DN1 : r - (I_OUT + I_UP); const int nb = DM / 64, kb = r / nb, n0 = 64 * (r % nb); p0_transpose_item<true>(F.w_down(), DFF, DM, F.Wdown_t(), 64 * kb, n0, n0, scr, F.lane); continue; }
            if (r < I_OUT) { const int nb = DM / 64, kb = r / nb, n0 = 64 * (r % nb); p0_transpose_item<true>(F.w_out(), DM, DM, F.Wout_t(), 64 * kb, n0, n0, scr, F.lane); continue; } r -= I_OUT;
            { const int nb = 2 * DFF / 64, kb = r / nb, n0 = 64 * (r % nb);
              const int f = n0 < DFF ? n0 : n0 - DFF; const int drow = 256 * (f >> 7) + (n0 < DFF ? 0 : 128) + (f & 127);
              p0_transpose_item<true>(F.w_up(), DM, 2 * DFF, F.Wup_t(), 64 * kb, n0, drow, scr, F.lane); }
        }
    }
}

struct Epi1 {
    static constexpr bool PERM = true, AFTER_DRAIN = false;
    bf16 *U, *G, *Qn, *Kn, *Vb; float* out; const float *qg, *kg; LAS float* P;
    __device__ __forceinline__ void operator()(const f32x4 (&acc)[2][2][4][2], const pg8::Unit& u, int wr, int wc, int fr, int fq) const {
        const int pn = u.pn, row0 = u.pm * 256 + wr * 64 + fr, cw8 = wc * 32 + 8 * fq;
        if (pn < 24) {
            bf16* base = pn < 12 ? U : G; const int col0 = (pn < 12 ? pn : pn - 12) * 256 + cw8;
#pragma unroll
            for (int ai = 0; ai < 2; ++ai)
#pragma unroll
                for (int m = 0; m < 4; ++m) { const int row = row0 + ai * 128 + m * 16; bf16* rowp = base + (size_t)row * DLRU + col0;
#pragma unroll
                    for (int bj = 0; bj < 2; ++bj) { const f32x4 v0 = acc[ai][bj][m][0], v1 = acc[ai][bj][m][1];
                        v4u w; w.x = cvt_pk_bf16(v0[0], v0[1]); w.y = cvt_pk_bf16(v0[2], v0[3]); w.z = cvt_pk_bf16(v1[0], v1[1]); w.w = cvt_pk_bf16(v1[2], v1[3]);
                        *(v4u*)(rowp + bj * 128) = w; }
                    if (pn < 12) {
                        float* cdst = nullptr;
                        if (row < MP) { if (row >= MP - 3) cdst = out + O_CP + (size_t)(row - (MP - 3)) * DLRU; }
                        else { const int t = (row - MP) & 31, b = (row - MP) >> 5; if (t >= 29) cdst = out + O_CS + (size_t)(b * 3 + (t - 29)) * DLRU; }
                        if (cdst) {
#pragma unroll
                            for (int bj = 0; bj < 2; ++bj) { *(f32x4*)(cdst + col0 + bj * 128) = acc[ai][bj][m][0]; *(f32x4*)(cdst + col0 + bj * 128 + 4) = acc[ai][bj][m][1]; } }
                    } }
        } else if (pn < 32) {
            const bool isk = pn >= 28; const float* gp = isk ? kg : qg;
#pragma unroll
            for (int ai = 0; ai < 2; ++ai)
#pragma unroll
                for (int m = 0; m < 4; ++m)
#pragma unroll
                    for (int bj = 0; bj < 2; ++bj) { const f32x4 v0 = acc[ai][bj][m][0], v1 = acc[ai][bj][m][1];
                        float s = (v0[0] * v0[0] + v0[1] * v0[1]) + (v0[2] * v0[2] + v0[3] * v0[3]) + (v1[0] * v1[0] + v1[1] * v1[1]) + (v1[2] * v1[2] + v1[3] * v1[3]);
                        s += __shfl_xor(s, 16); s += __shfl_xor(s, 32);
                        if (fq == 0) P[((ai * 128 + wr * 64 + m * 16 + fr) * 2 + bj) * 4 + wc] = s; }
            WG_BAR();
            const f32x4 g0 = *(const f32x4*)(gp + cw8), g1 = *(const f32x4*)(gp + cw8 + 4);
            bf16* base = isk ? Kn : Qn; const int col0 = (pn - (isk ? 28 : 24)) * 256 + cw8;
#pragma unroll
            for (int ai = 0; ai < 2; ++ai)
#pragma unroll
                for (int m = 0; m < 4; ++m) { const int row = row0 + ai * 128 + m * 16; bf16* rowp = base + (size_t)row * DSB + col0;
                    float* kdst = isk ? (row < MP ? out + O_KP + (size_t)row * DSB : out + O_KS + (size_t)(row - MP) * DSB) + col0 : nullptr;
#pragma unroll
                    for (int bj = 0; bj < 2; ++bj) { const f32x4 p = *(const LAS f32x4*)(P + ((ai * 128 + wr * 64 + m * 16 + fr) * 2 + bj) * 4);
                        const float sc = 1.0f / sqrtf(((p[0] + p[1]) + (p[2] + p[3])) * (1.0f / HD) + EPS);
                        const f32x4 v0 = acc[ai][bj][m][0] * sc * g0, v1 = acc[ai][bj][m][1] * sc * g1;
                        v4u w; w.x = cvt_pk_bf16(v0[0], v0[1]); w.y = cvt_pk_bf16(v0[2], v0[3]); w.z = cvt_pk_bf16(v1[0], v1[1]); w.w = cvt_pk_bf16(v1[2], v1[3]);
                        *(v4u*)(rowp + bj * 128) = w;
                        if (isk) { __builtin_nontemporal_store(v0, (f32x4*)(kdst + bj * 128)); __builtin_nontemporal_store(v1, (f32x4*)(kdst + bj * 128 + 4)); } } }
        } else {
            const int col0 = (pn - 32) * 256 + cw8;
#pragma unroll
            for (int ai = 0; ai < 2; ++ai)
#pragma unroll
                for (int m = 0; m < 4; ++m) { const int row = row0 + ai * 128 + m * 16; bf16* rowp = Vb + (size_t)row * DSB + col0;
                    float* vdst = (row < MP ? out + O_VP + (size_t)row * DSB : out + O_VS + (size_t)(row - MP) * DSB) + col0;
#pragma unroll
                    for (int bj = 0; bj < 2; ++bj) { const f32x4 v0 = acc[ai][bj][m][0], v1 = acc[ai][bj][m][1];
                        v4u w; w.x = cvt_pk_bf16(v0[0], v0[1]); w.y = cvt_pk_bf16(v0[2], v0[3]); w.z = cvt_pk_bf16(v1[0], v1[1]); w.w = cvt_pk_bf16(v1[2], v1[3]);
                        *(v4u*)(rowp + bj * 128) = w; __builtin_nontemporal_store(v0, (f32x4*)(vdst + bj * 128)); __builtin_nontemporal_store(v1, (f32x4*)(vdst + bj * 128 + 4)); } }
        }
    }
};
template <int SECOND>
struct EpiRes {
    static constexpr bool PERM = true, AFTER_DRAIN = false;
    const float* xp; bf16* x1; float* out; float* part;
    __device__ __forceinline__ void operator()(const f32x4 (&acc)[2][2][4][2], const pg8::Unit& u, int wr, int wc, int fr, int fq) const {
        const int row0 = u.pm * 256 + wr * 64 + fr, col0 = u.pn * 256 + wc * 32 + 8 * fq;
        if (u.ks >= 0) {
#pragma unroll
            for (int ai = 0; ai < 2; ++ai)
#pragma unroll
                for (int m = 0; m < 4; ++m) { const int row = row0 + ai * 128 + m * 16; float* op = part + ((size_t)u.ks * MS + (row - MP)) * DM + col0;
#pragma unroll
                    for (int bj = 0; bj < 2; ++bj)
#pragma unroll
                        for (int n = 0; n < 2; ++n) *(f32x4*)(op + bj * 128 + n * 4) = acc[ai][bj][m][n]; }
            return;
        }
        if constexpr (SECOND == 0) {
#pragma unroll
            for (int ai = 0; ai < 2; ++ai) {
                f32x4 b[4][2][2];
#pragma unroll
                for (int m = 0; m < 4; ++m) { const float* bp = xp + (size_t)(row0 + ai * 128 + m * 16) * DM + col0;
#pragma unroll
                    for (int bj = 0; bj < 2; ++bj)
#pragma unroll
                        for (int n = 0; n < 2; ++n) b[m][bj][n] = *(const f32x4*)(bp + bj * 128 + n * 4); }
#pragma unroll
                for (int m = 0; m < 4; ++m) { bf16* op = x1 + (size_t)(row0 + ai * 128 + m * 16) * DM + col0;
#pragma unroll
                    for (int bj = 0; bj < 2; ++bj) { const f32x4 lo = b[m][bj][0] + acc[ai][bj][m][0], hi = b[m][bj][1] + acc[ai][bj][m][1];
                        v4u o; o.x = cvt_pk_bf16(lo.x, lo.y); o.y = cvt_pk_bf16(lo.z, lo.w); o.z = cvt_pk_bf16(hi.x, hi.y); o.w = cvt_pk_bf16(hi.z, hi.w); *(v4u*)(op + bj * 128) = o; } }
            }
        } else {
            v4u b[2][4][2];
#pragma unroll
            for (int ai = 0; ai < 2; ++ai)
#pragma unroll
                for (int m = 0; m < 4; ++m) { const bf16* bp = x1 + (size_t)(row0 + ai * 128 + m * 16) * DM + col0;
#pragma unroll
                    for (int bj = 0; bj < 2; ++bj) b[ai][m][bj] = __builtin_nontemporal_load((const v4u*)(bp + bj * 128)); }
#pragma unroll
            for (int ai = 0; ai < 2; ++ai)
#pragma unroll
                for (int m = 0; m < 4; ++m) { float* op = out + O_Y + (size_t)(row0 + ai * 128 + m * 16) * DM + col0;
#pragma unroll
                    for (int bj = 0; bj < 2; ++bj) { const v4u w = b[ai][m][bj];
                        const f32x4 lo = {bflo(w.x), bfhi(w.x), bflo(w.y), bfhi(w.y)}, hi = {bflo(w.z), bfhi(w.z), bflo(w.w), bfhi(w.w)};
                        *(f32x4*)(op + bj * 128) = lo + acc[ai][bj][m][0]; *(f32x4*)(op + bj * 128 + 4) = hi + acc[ai][bj][m][1]; } }
        }
    }
};
struct EpiUp {
    static constexpr bool PERM = true, AFTER_DRAIN = false;
    bf16* ACT; const float *fcw, *fcb, *st_ffn; float* out; float *halo, *defc, *defv; LAS float* HX;
    template <bool SMP> __device__ __forceinline__ void body(const f32x4 (&acc)[2][2][4][2], const pg8::Unit& u, int wr, int wc, int fr, int fq) const {
        const int pm = u.pm, cl = wc * 32 + 8 * fq, f0 = u.pn * 128 + cl;
        const f32x4 w0a = *(const f32x4*)(fcw + f0), w0b = *(const f32x4*)(fcw + f0 + 4), w1a = *(const f32x4*)(fcw + DFF + f0), w1b = *(const f32x4*)(fcw + DFF + f0 + 4);
        const f32x4 w2a = *(const f32x4*)(fcw + 2 * DFF + f0), w2b = *(const f32x4*)(fcw + 2 * DFF + f0 + 4), cba = *(const f32x4*)(fcb + f0), cbb = *(const f32x4*)(fcb + f0 + 4);
        if (!SMP && fr >= 14) {
#pragma unroll
            for (int ai = 0; ai < 2; ++ai) { LAS f32x4* hp = (LAS f32x4*)(HX + (((ai * 2 + wr) * 2 + (fr - 14)) * 128 + cl)); hp[0] = acc[ai][1][3][0]; hp[1] = acc[ai][1][3][1]; }
            if (wr == 1) { float* hd = (pm == MP / 256 - 1) ? out + O_FP + (size_t)(fr - 14) * DFF + f0 : halo + ((size_t)pm * 2 + (fr - 14)) * DFF + f0;
                *(f32x4*)hd = acc[1][1][3][0]; *(f32x4*)(hd + 4) = acc[1][1][3][1]; }
        }
        if (!SMP) WG_BAR();
        f32x4 R1pa, R1pb, R2pa, R2pb;
#pragma unroll
        for (int ai = 0; ai < 2; ++ai) {
#pragma unroll
            for (int m = 0; m < 4; ++m) {
                const int row = pm * 256 + ai * 128 + wr * 64 + m * 16 + fr;
                const f32x4 Pa = acc[ai][1][m][0], Pb = acc[ai][1][m][1], Va = acc[ai][0][m][0], Vb = acc[ai][0][m][1];
                f32x4 R1a, R1b, R2a, R2b;
#pragma unroll
                for (int j = 0; j < 4; ++j) { R1a[j] = dpp_ror<1>(Pa[j]); R1b[j] = dpp_ror<1>(Pb[j]); R2a[j] = dpp_ror<2>(Pa[j]); R2b[j] = dpp_ror<2>(Pb[j]); }
                if (m == 0 || (SMP && m == 2)) {
                    f32x4 B1a, B1b, B2a, B2b;
                    if (SMP) { const int b = (row - MP) >> 5; const float* s0 = st_ffn + (size_t)(b * 2) * DFF + f0; const float* s1 = s0 + DFF;
                        B2a = *(const f32x4*)s0; B2b = *(const f32x4*)(s0 + 4); B1a = *(const f32x4*)s1; B1b = *(const f32x4*)(s1 + 4);
                    } else if (ai == 0 && wr == 0) { B1a = B1b = B2a = B2b = (f32x4){0.f, 0.f, 0.f, 0.f};
                    } else { const int pg = ai * 2 + wr - 1; const LAS f32x4* h2 = (const LAS f32x4*)(HX + ((pg * 2 + 0) * 128 + cl)); const LAS f32x4* h1 = (const LAS f32x4*)(HX + ((pg * 2 + 1) * 128 + cl));
                        B2a = h2[0]; B2b = h2[1]; B1a = h1[0]; B1b = h1[1]; }
                    R1pa = B1a; R1pb = B1b; R2pa = (fr == 0) ? B2a : B1a; R2pb = (fr == 0) ? B2b : B1b;
                }
                const f32x4 p1a = (fr >= 1) ? R1a : R1pa, p1b = (fr >= 1) ? R1b : R1pb, p2a = (fr >= 2) ? R2a : R2pa, p2b = (fr >= 2) ? R2b : R2pb;
                const f32x4 ca = cba + (w0a * p2a + w1a * p1a) + w2a * Pa, cbv = cbb + (w0b * p2b + w1b * p1b) + w2b * Pb;
                f32x4 oa, ob;
                { const f32x2 g0 = gelu_tanh2((f32x2){ca[0], ca[1]}) * (f32x2){Va[0], Va[1]}, g1 = gelu_tanh2((f32x2){ca[2], ca[3]}) * (f32x2){Va[2], Va[3]};
                  const f32x2 g2 = gelu_tanh2((f32x2){cbv[0], cbv[1]}) * (f32x2){Vb[0], Vb[1]}, g3 = gelu_tanh2((f32x2){cbv[2], cbv[3]}) * (f32x2){Vb[2], Vb[3]};
                  oa = (f32x4){g0.x, g0.y, g1.x, g1.y}; ob = (f32x4){g2.x, g2.y, g3.x, g3.y}; }
                v4u q; q.x = cvt_pk_bf16(oa[0], oa[1]); q.y = cvt_pk_bf16(oa[2], oa[3]); q.z = cvt_pk_bf16(ob[0], ob[1]); q.w = cvt_pk_bf16(ob[2], ob[3]);
                *(v4u*)(ACT + (size_t)row * DFF + f0) = q;
                if (m == 0 && ai == 0) { if (!SMP && pm >= 1 && wr == 0 && fr < 2) { float* dc = defc + ((size_t)pm * 2 + fr) * DFF + f0; float* dv = defv + ((size_t)pm * 2 + fr) * DFF + f0;
                        *(f32x4*)dc = ca; *(f32x4*)(dc + 4) = cbv; *(f32x4*)dv = Va; *(f32x4*)(dv + 4) = Vb; } }
                if ((m & 1) && SMP && fr >= 14) { float* fd = out + O_FS + (size_t)(((row - MP) >> 5) * 2 + (fr - 14)) * DFF + f0; *(f32x4*)fd = Pa; *(f32x4*)(fd + 4) = Pb; }
                R1pa = R1a; R1pb = R1b; R2pa = R2a; R2pb = R2b;
            }
        }
    }
    __device__ __forceinline__ void operator()(const f32x4 (&acc)[2][2][4][2], const pg8::Unit& u, int wr, int wc, int fr, int fq) const {
        if (u.pm >= MP / 256) body<true>(acc, u, wr, wc, fr, fq); else body<false>(acc, u, wr, wc, fr, fq);
    }
};
struct EpiBf {
    static constexpr bool PERM = true, AFTER_DRAIN = false;
    bf16* O; int ldc;
    __device__ __forceinline__ void operator()(const f32x4 (&acc)[2][2][4][2], const pg8::Unit& u, int wr, int wc, int fr, int fq) const {
        const int row0 = u.pm * 256 + wr * 64 + fr, col0 = u.pn * 256 + wc * 32 + 8 * fq;
#pragma unroll
        for (int ai = 0; ai < 2; ++ai)
#pragma unroll
            for (int m = 0; m < 4; ++m) { bf16* rowp = O + (size_t)(row0 + ai * 128 + m * 16) * ldc + col0;
#pragma unroll
                for (int bj = 0; bj < 2; ++bj) { const f32x4 v0 = acc[ai][bj][m][0], v1 = acc[ai][bj][m][1];
                    v4u w; w.x = cvt_pk_bf16(v0[0], v0[1]); w.y = cvt_pk_bf16(v0[2], v0[3]); w.z = cvt_pk_bf16(v1[0], v1[1]); w.w = cvt_pk_bf16(v1[2], v1[3]);
                    *(v4u*)(rowp + bj * 128) = w; } }
    }
};

constexpr int UC_LD = 196;
constexpr int UC_TEAM_BYTES = 64 * UC_LD * 4;
static_assert(2 * UC_TEAM_BYTES <= RING_BYTES, "lru lds");
__device__ __forceinline__ void team_bar(LAS unsigned* cnt, unsigned& phase, int lane) {
    asm volatile("s_waitcnt lgkmcnt(0)" ::: "memory");
    ++phase;
    if (lane == 0) __hip_atomic_fetch_add(cnt, 1u, __ATOMIC_RELAXED, __HIP_MEMORY_SCOPE_WORKGROUP);
    while (__hip_atomic_load(cnt, __ATOMIC_RELAXED, __HIP_MEMORY_SCOPE_WORKGROUP) < 4u * phase) __builtin_amdgcn_s_sleep(1);
    asm volatile("" ::: "memory");
}
__device__ __forceinline__ void lru_unit(Frame& F, int chunk, int blk, LAS unsigned* tcnt, unsigned& tphase) {
    const int lane = F.lane, w = F.wave, fr = lane & 15, fq = lane >> 4, team = w >> 2, ttid = F.tid & 255;
    LAS float* UC = (LAS float*)(F.lds + RING_OFF + team * UC_TEAM_BYTES);
    const bool smp = chunk >= 256;
    const int row0 = smp ? MP + 64 * (chunk - 256) : 64 * chunk;
    const int chb = 192 * blk;
    const int cg = w & 3, cwl = 48 * cg;
    team_bar(tcnt, tphase, lane);
    if (ttid < 192) {
        const int cgp = ttid % 24, tg = ttid / 24, ch = chb + 8 * cgp, tok0 = 8 * tg;
        float wv[4][8], bv[8], xw[3][8];
#pragma unroll
        for (int k = 0; k < 4; ++k) { const f32x4 a = *(const f32x4*)(F.cw() + k * DLRU + ch), b = *(const f32x4*)(F.cw() + k * DLRU + ch + 4);
            wv[k][0] = a[0]; wv[k][1] = a[1]; wv[k][2] = a[2]; wv[k][3] = a[3]; wv[k][4] = b[0]; wv[k][5] = b[1]; wv[k][6] = b[2]; wv[k][7] = b[3]; }
        { const f32x4 a = *(const f32x4*)(F.cb() + ch), b = *(const f32x4*)(F.cb() + ch + 4); bv[0] = a[0]; bv[1] = a[1]; bv[2] = a[2]; bv[3] = a[3]; bv[4] = b[0]; bv[5] = b[1]; bv[6] = b[2]; bv[7] = b[3]; }
        const int r0 = row0 + tok0;
        const bool from_state = smp && ((tok0 & 31) == 0), zero_prev = (!smp) && (r0 == 0);
#pragma unroll
        for (int d = 0; d < 3; ++d) {
            if (zero_prev) {
#pragma unroll
                for (int e = 0; e < 8; ++e) xw[d][e] = 0.f;
            } else if (from_state) { const int b = (r0 - MP) >> 5; const float* sp = F.st_conv() + (size_t)(b * 3 + d) * DLRU + ch; const f32x4 a = *(const f32x4*)sp, c = *(const f32x4*)(sp + 4);
                xw[d][0] = a[0]; xw[d][1] = a[1]; xw[d][2] = a[2]; xw[d][3] = a[3]; xw[d][4] = c[0]; xw[d][5] = c[1]; xw[d][6] = c[2]; xw[d][7] = c[3];
            } else { const v4u q = *(const v4u*)(F.U() + (size_t)(r0 - 3 + d) * DLRU + ch);
                xw[d][0] = bflo(q.x); xw[d][1] = bfhi(q.x); xw[d][2] = bflo(q.y); xw[d][3] = bfhi(q.y); xw[d][4] = bflo(q.z); xw[d][5] = bfhi(q.z); xw[d][6] = bflo(q.w); xw[d][7] = bfhi(q.w); }
        }
#pragma unroll
        for (int t = 0; t < 8; ++t) {
            const v4u q = *(const v4u*)(F.U() + (size_t)(r0 + t) * DLRU + ch);
            float xc[8]; xc[0] = bflo(q.x); xc[1] = bfhi(q.x); xc[2] = bflo(q.y); xc[3] = bfhi(q.y); xc[4] = bflo(q.z); xc[5] = bfhi(q.z); xc[6] = bflo(q.w); xc[7] = bfhi(q.w);
            float o[8];
#pragma unroll
            for (int e = 0; e < 8; ++e) o[e] = bv[e] + ((wv[0][e] * xw[0][e] + wv[1][e] * xw[1][e]) + (wv[2][e] * xw[2][e] + wv[3][e] * xc[e]));
            LAS f32x4* dst = (LAS f32x4*)(UC + (tok0 + t) * UC_LD + 8 * cgp);
            dst[0] = (f32x4){o[0], o[1], o[2], o[3]}; dst[1] = (f32x4){o[4], o[5], o[6], o[7]};
#pragma unroll
            for (int e = 0; e < 8; ++e) { xw[0][e] = xw[1][e]; xw[1][e] = xw[2][e]; xw[2][e] = xc[e]; }
        }
    }
    team_bar(tcnt, tphase, lane);
    f32x4 pba[3], pbx[3], pc8[3]; v2u gq[3];
#pragma unroll
    for (int ct = 0; ct < 3; ++ct) { const int chg = chb + cwl + 16 * ct + 4 * fq;
        pba[ct] = *(const f32x4*)(F.b_a() + chg); pbx[ct] = *(const f32x4*)(F.b_x() + chg); pc8[ct] = *(const f32x4*)(F.C8() + chg);
        gq[ct] = *(const v2u*)(F.Gt() + (size_t)(row0 + fr) * DLRU + chg); }
    f32x4 accA[4][3], accX[4][3];
#pragma unroll
    for (int tt = 0; tt < 4; ++tt)
#pragma unroll
        for (int ct = 0; ct < 3; ++ct) { accA[tt][ct] = (f32x4){0.f, 0.f, 0.f, 0.f}; accX[tt][ct] = (f32x4){0.f, 0.f, 0.f, 0.f}; }
    const bf16* wa_base = F.Wa_t() + (size_t)blk * BD * BD + (size_t)(48 * cg + fr) * BD + 8 * fq;
    const bf16* wx_base = F.Wx_t() + (size_t)blk * BD * BD + (size_t)(48 * cg + fr) * BD + 8 * fq;
#pragma unroll 1
    for (int kb = 0; kb < 3; ++kb) {
        bf16x8 fa[2][3], fx[2][3];
#pragma unroll
        for (int kk = 0; kk < 2; ++kk)
#pragma unroll
            for (int ct = 0; ct < 3; ++ct) {
                fa[kk][ct] = __builtin_bit_cast(bf16x8, *(const v4u*)(wa_base + (size_t)(16 * ct) * BD + 32 * (2 * kb + kk)));
                fx[kk][ct] = __builtin_bit_cast(bf16x8, *(const v4u*)(wx_base + (size_t)(16 * ct) * BD + 32 * (2 * kb + kk))); }
#pragma unroll
        for (int kk = 0; kk < 2; ++kk) {
            const int ks = 2 * kb + kk;
            bf16x8 uf[4];
#pragma unroll
            for (int tt = 0; tt < 4; ++tt) { const LAS f32x4* s = (const LAS f32x4*)(UC + (16 * tt + fr) * UC_LD + 32 * ks + 8 * fq); const f32x4 a = s[0], b = s[1];
                v4u p; p.x = cvt_pk_bf16(a[0], a[1]); p.y = cvt_pk_bf16(a[2], a[3]); p.z = cvt_pk_bf16(b[0], b[1]); p.w = cvt_pk_bf16(b[2], b[3]); uf[tt] = __builtin_bit_cast(bf16x8, p); }
#pragma unroll
            for (int ct = 0; ct < 3; ++ct)
#pragma unroll
                for (int tt = 0; tt < 4; ++tt) { accA[tt][ct] = __builtin_amdgcn_mfma_f32_16x16x32_bf16(fa[kk][ct], uf[tt], accA[tt][ct], 0, 0, 0);
                                                 accX[tt][ct] = __builtin_amdgcn_mfma_f32_16x16x32_bf16(fx[kk][ct], uf[tt], accX[tt][ct], 0, 0, 0); }
        }
    }
    f32x4 carry[3], acar[3];
#pragma unroll
    for (int ct = 0; ct < 3; ++ct) { acar[ct] = (f32x4){1.f, 1.f, 1.f, 1.f};
        carry[ct] = smp ? *(const f32x4*)(F.st_h() + (size_t)(2 * (chunk - 256)) * DLRU + chb + cwl + 16 * ct + 4 * fq) : (f32x4){0.f, 0.f, 0.f, 0.f}; }
#pragma unroll
    for (int tt = 0; tt < 4; ++tt) {
        if (smp && tt == 2) {
#pragma unroll
            for (int ct = 0; ct < 3; ++ct) { acar[ct] = (f32x4){1.f, 1.f, 1.f, 1.f}; carry[ct] = *(const f32x4*)(F.st_h() + (size_t)(2 * (chunk - 256) + 1) * DLRU + chb + cwl + 16 * ct + 4 * fq); } }
        const int row = row0 + 16 * tt + fr;
        v2u gqn[3];
#pragma unroll
        for (int ct = 0; ct < 3; ++ct) gqn[ct] = (tt < 3) ? *(const v2u*)(F.Gt() + (size_t)(row + 16) * DLRU + chb + cwl + 16 * ct + 4 * fq) : (v2u){0u, 0u};
#pragma unroll
        for (int ct = 0; ct < 3; ++ct) {
            const int chg = chb + cwl + 16 * ct + 4 * fq;
            const f32x4 ba = pba[ct], bx = pbx[ct], c8 = pc8[ct];
            const f32x4 uc = *(const LAS f32x4*)(UC + (16 * tt + fr) * UC_LD + cwl + 16 * ct + 4 * fq);
            f32x4 av, bv;
#pragma unroll
            for (int p = 0; p < 2; ++p) {
                const f32x2 rg = sigmoid2((f32x2){accA[tt][ct][2 * p], accA[tt][ct][2 * p + 1]} + (f32x2){ba[2 * p], ba[2 * p + 1]});
                const f32x2 ig = sigmoid2((f32x2){accX[tt][ct][2 * p], accX[tt][ct][2 * p + 1]} + (f32x2){bx[2 * p], bx[2 * p + 1]});
                const f32x2 la2 = (f32x2){c8[2 * p], c8[2 * p + 1]} * rg;
                f32x2 a; a.x = fexp2(la2.x); a.y = fexp2(la2.y);
                const f32x2 x = la2 * (2.0f * 0.6931471805599453f);
                f32x2 omp = (x * (-1.0f)) * (1.0f + x * (0.5f + x * (0.16666667f + x * (0.041666668f + x * (0.008333334f + x * 0.0013888889f))))), omq = 1.0f - a * a;
                asm("" : "+v"(omp), "+v"(omq));
                f32x2 sq; sq.x = __builtin_amdgcn_sqrtf(x.x > -0.25f ? omp.x : omq.x); sq.y = __builtin_amdgcn_sqrtf(x.y > -0.25f ? omp.y : omq.y);
                const f32x2 b = sq * ig * (f32x2){uc[2 * p], uc[2 * p + 1]};
                av[2 * p] = a.x; av[2 * p + 1] = a.y; bv[2 * p] = b.x; bv[2 * p + 1] = b.y;
            }
            row_scan_ab4(av, bv);
            const f32x4 h = bv + av * carry[ct];
            const f32x4 hA = av * acar[ct];
            f32x4 ge; { const f32x2 g0 = gelu_tanh2((f32x2){bflo(gq[ct].x), bfhi(gq[ct].x)}), g1 = gelu_tanh2((f32x2){bflo(gq[ct].y), bfhi(gq[ct].y)}); ge = (f32x4){g0.x, g0.y, g1.x, g1.y}; }
            const f32x4 y = h * ge;
            v2u o; o.x = cvt_pk_bf16(y[0], y[1]); o.y = cvt_pk_bf16(y[2], y[3]);
            *(v2u*)(F.Y() + (size_t)row * DM + chg) = o;
            if (!smp) { const f32x4 z = hA * ge; v2u oz; oz.x = cvt_pk_bf16(z[0], z[1]); oz.y = cvt_pk_bf16(z[2], z[3]); *(v2u*)(F.Z() + (size_t)row * DLRU + chg) = oz;
                if (tt == 3 && fr == 15) { *(f32x4*)(F.AggA() + (size_t)chunk * DLRU + chg) = hA; *(f32x4*)(F.AggB() + (size_t)chunk * DLRU + chg) = h; } }
            else if (((row - MP) & 31) == 31) *(f32x4*)(F.out() + O_HS + (size_t)((row - MP) >> 5) * DLRU + chg) = h;
#pragma unroll
            for (int r = 0; r < 4; ++r) { carry[ct][r] = __shfl(h[r], (lane & 48) | 15); acar[ct][r] = __shfl(hA[r], (lane & 48) | 15); }
        }
#pragma unroll
        for (int ct = 0; ct < 3; ++ct) gq[ct] = gqn[ct];
        __builtin_amdgcn_sched_barrier(0);
    }
}
__device__ __forceinline__ void lru_prefix(Frame& F) {
    const int gw = F.vcu * NWAVES + F.wave, NGW = F.G * NWAVES, fr = F.lane & 15, fq = F.lane >> 4;
    for (int item = gw; item < DLRU / 16; item += NGW) {
        const int chg = 16 * item + 4 * fq;
        f32x4 la[16], lb[16];
#pragma unroll
        for (int i = 0; i < 16; ++i) { la[i] = *(const f32x4*)(F.AggA() + (size_t)(16 * fr + i) * DLRU + chg); lb[i] = *(const f32x4*)(F.AggB() + (size_t)(16 * fr + i) * DLRU + chg); }
        f32x4 PA = la[0], PB = lb[0];
#pragma unroll
        for (int i = 1; i < 16; ++i) { PB = la[i] * PB + lb[i]; PA = la[i] * PA; }
        f32x4 h;
#pragma unroll
        for (int r = 0; r < 4; ++r) { float a = PA[r], b = PB[r]; row_scan_ab(a, b); h[r] = dpp_shr<1>(0.0f, b); }
#pragma unroll
        for (int i = 0; i < 16; ++i) { *(f32x4*)(F.Carry() + (size_t)(16 * fr + i) * DLRU + chg) = h; h = la[i] * h + lb[i]; }
        if (fr == 15) *(f32x4*)(F.out() + O_HP + chg) = h;
    }
}

constexpr int KS_LD = 272, KS_OFF = 0, VT_OFF = 128 * KS_LD, WM_OFF = 2 * 128 * KS_LD;
constexpr float ATT_SC = 0.12751743082459868f;
constexpr float ATT_STOP = -160.0f;
__device__ __forceinline__ int vt_pos(int k) { return (k & ~31) | (((k >> 2) & 3) << 3) | (((k >> 4) & 1) << 2) | (k & 3); }
__device__ __forceinline__ void vt_store(LAS unsigned char* VT, int key, int dc, const v4u q) {
    LAS unsigned short* vp = (LAS unsigned short*)(VT + (8 * dc) * KS_LD + 2 * vt_pos(key));
    vp[0 * (KS_LD / 2)] = (unsigned short)(q.x & 0xffffu); vp[1 * (KS_LD / 2)] = (unsigned short)(q.x >> 16); vp[2 * (KS_LD / 2)] = (unsigned short)(q.y & 0xffffu); vp[3 * (KS_LD / 2)] = (unsigned short)(q.y >> 16);
    vp[4 * (KS_LD / 2)] = (unsigned short)(q.z & 0xffffu); vp[5 * (KS_LD / 2)] = (unsigned short)(q.z >> 16); vp[6 * (KS_LD / 2)] = (unsigned short)(q.w & 0xffffu); vp[7 * (KS_LD / 2)] = (unsigned short)(q.w >> 16);
}
template <bool SMP> __device__ __forceinline__ void attn_unit(Frame& F, int ui) {
    const int tid = F.tid, lane = F.lane, w = F.wave, fr = lane & 15, fq = lane >> 4;
    LAS unsigned char* KS = F.lds + RING_OFF + KS_OFF; LAS unsigned char* VT = F.lds + RING_OFF + VT_OFF; LAS float* WM = (LAS float*)(F.lds + RING_OFF + WM_OFF);
    const int h = ui & 7;
    const int qt = ui >> 3, b = (ui - 1024) >> 3;
    const int qrow0 = SMP ? MP + 32 * b : 128 * qt;
    const int nkb = SMP ? 1 + PAST / 128 : qt + 1;
    const bool active = SMP ? (w < 2) : true;
    const int qi = 16 * w + fr;
    bf16x8 qf[4];
    if (active) {
#pragma unroll
        for (int ds = 0; ds < 4; ++ds) qf[ds] = __builtin_bit_cast(bf16x8, *(const v4u*)(F.Qn() + (size_t)(qrow0 + qi) * DSB + h * HD + 32 * ds + 8 * fq));
    } else {
#pragma unroll
        for (int ds = 0; ds < 4; ++ds) qf[ds] = (bf16x8){0, 0, 0, 0, 0, 0, 0, 0};
    }
    f32x4 o[8];
#pragma unroll
    for (int dt = 0; dt < 8; ++dt) o[dt] = (f32x4){0.f, 0.f, 0.f, 0.f};
    float carry = 0.f;
    v4u pk[4], pv[4];
    f32x4 fk[SMP ? 4 : 1][2], fv[SMP ? 4 : 1][2];
    if (!SMP) {
#pragma unroll
        for (int c = 0; c < 4; ++c) { const int id = tid + 512 * c; const int krow0 = 128 * qt;
            pk[c] = *(const v4u*)(F.Kn() + (size_t)(krow0 + (id >> 4)) * DSB + h * HD + 8 * (id & 15));
            pv[c] = *(const v4u*)(F.Vb() + (size_t)(krow0 + (id & 127)) * DSB + h * HD + 8 * (id >> 7)); }
    }
    for (int j = 0; j < nkb; ++j) {
        WG_BAR();
        if (!SMP) {
#pragma unroll
            for (int c = 0; c < 4; ++c) { const int id = tid + 512 * c; *(LAS v4u*)(KS + (id >> 4) * KS_LD + 16 * (id & 15)) = pk[c]; vt_store(VT, id & 127, id >> 7, pv[c]); }
        } else if (j == 0) {
#pragma unroll
            for (int c = 0; c < 4; ++c) { const int id = tid + 512 * c;
                { const int key = id >> 4, dc = id & 15; v4u q = (v4u){0u, 0u, 0u, 0u}; if (key < 32) q = *(const v4u*)(F.Kn() + (size_t)(qrow0 + key) * DSB + h * HD + 8 * dc);
                  *(LAS v4u*)(KS + key * KS_LD + 16 * dc) = q; }
                { const int key = id & 127, dc = id >> 7; v4u q = (v4u){0u, 0u, 0u, 0u}; if (key < 32) q = *(const v4u*)(F.Vb() + (size_t)(qrow0 + key) * DSB + h * HD + 8 * dc);
                  vt_store(VT, key, dc, q); }
            }
        } else {
#pragma unroll
            for (int c = 0; c < (SMP ? 4 : 1); ++c) { const int id = tid + 512 * c;
                { const f32x4 a = fk[c][0], bb = fk[c][1]; v4u q; q.x = cvt_pk_bf16(a[0], a[1]); q.y = cvt_pk_bf16(a[2], a[3]); q.z = cvt_pk_bf16(bb[0], bb[1]); q.w = cvt_pk_bf16(bb[2], bb[3]);
                  *(LAS v4u*)(KS + (id >> 4) * KS_LD + 16 * (id & 15)) = q; }
                { const f32x4 a = fv[c][0], bb = fv[c][1]; v4u q; q.x = cvt_pk_bf16(a[0], a[1]); q.y = cvt_pk_bf16(a[2], a[3]); q.z = cvt_pk_bf16(bb[0], bb[1]); q.w = cvt_pk_bf16(bb[2], bb[3]);
                  vt_store(VT, id & 127, id >> 7, q); }
            }
        }
        WG_BAR();
        if (SMP && j + 1 < nkb) {
            const int pos0 = PAST - 128 * (j + 1);
            const float* ck = F.cache_k() + ((size_t)b * PAST + pos0) * DSB + h * HD; const float* cv = F.cache_v() + ((size_t)b * PAST + pos0) * DSB + h * HD;
#pragma unroll
            for (int c = 0; c < (SMP ? 4 : 1); ++c) { const int id = tid + 512 * c;
                { const float* p = ck + (size_t)(id >> 4) * DSB + 8 * (id & 15); fk[c][0] = __builtin_nontemporal_load((const f32x4*)p); fk[c][1] = __builtin_nontemporal_load((const f32x4*)(p + 4)); }
                { const float* p = cv + (size_t)(id & 127) * DSB + 8 * (id >> 7); fv[c][0] = __builtin_nontemporal_load((const f32x4*)p); fv[c][1] = __builtin_nontemporal_load((const f32x4*)(p + 4)); } }
        }
        if (!SMP && j + 1 < nkb) {
#pragma unroll
            for (int c = 0; c < 4; ++c) { const int id = tid + 512 * c; const int krow0 = 128 * (qt - j - 1);
                pk[c] = *(const v4u*)(F.Kn() + (size_t)(krow0 + (id >> 4)) * DSB + h * HD + 8 * (id & 15));
                pv[c] = *(const v4u*)(F.Vb() + (size_t)(krow0 + (id & 127)) * DSB + h * HD + 8 * (id >> 7)); }
        }
        float wmax = -3.0e38f;
        if (active) {
            f32x4 s[8];
            const bool diag = (j == 0);
#pragma unroll
            for (int kt = 0; kt < 8; ++kt) { s[kt] = (f32x4){0.f, 0.f, 0.f, 0.f};
                if (!(diag && kt > w))
#pragma unroll
                for (int ds = 0; ds < 4; ++ds) { const bf16x8 kf = *(const LAS bf16x8*)(KS + (16 * kt + fr) * KS_LD + 2 * (32 * ds + 8 * fq)); s[kt] = __builtin_amdgcn_mfma_f32_16x16x32_bf16(kf, qf[ds], s[kt], 0, 0, 0); } }
            float Fq[8], TT[8];
#pragma unroll
            for (int kt = 0; kt < 8; ++kt) {
                if (diag && kt > w) { s[kt] = (f32x4){-1.0e30f, -1.0e30f, -1.0e30f, -1.0e30f}; Fq[kt] = 0.f; TT[kt] = 0.f; continue; }
                f32x4 z = s[kt] * ATT_SC;
                if (diag) {
#pragma unroll
                    for (int r = 0; r < 4; ++r) z[r] = ((16 * kt + 4 * fq + r) < qi) ? z[r] : -1.0e30f; }
                f32x4 e, l, mx;
#pragma unroll
                for (int r = 0; r < 4; ++r) { e[r] = fexp2(-fabsf(z[r])); mx[r] = fmaxf(z[r], 0.f); }
                const f32x4 d = e + 1.0f;
#pragma unroll
                for (int r = 0; r < 4; ++r) l[r] = flog2(d[r]);
                const f32x4 lbv = (mx + l) * (-1.0f);
                f32x4 xsv; xsv[3] = 0.f; xsv[2] = lbv[3]; xsv[1] = lbv[3] + lbv[2]; xsv[0] = xsv[1] + lbv[1];
                const float T = xsv[0] + lbv[0];
                s[kt] = (z + lbv) + xsv;
                const float t1 = __shfl_xor(T, 16), t2 = __shfl_xor(T, 32), t3 = __shfl_xor(T, 48);
                Fq[kt] = (((fq ^ 1) > fq) ? t1 : 0.f) + (((fq ^ 2) > fq) ? t2 : 0.f) + (((fq ^ 3) > fq) ? t3 : 0.f);
                TT[kt] = (T + t1) + (t2 + t3);
            }
            float run = carry; bf16x8 pf[4];
            unsigned pw[8][2];
#pragma unroll
            for (int kt = 7; kt >= 0; --kt) {
                if (diag && kt > w) { pw[kt][0] = 0u; pw[kt][1] = 0u; continue; }
                const f32x4 arg = s[kt] + (run + Fq[kt]);
                float wv[4];
#pragma unroll
                for (int r = 0; r < 4; ++r) wv[r] = fexp2(arg[r]);
                pw[kt][0] = cvt_pk_bf16(wv[0], wv[1]); pw[kt][1] = cvt_pk_bf16(wv[2], wv[3]);
                run += TT[kt];
            }
            carry = run;
#pragma unroll
            for (int sI = 0; sI < 4; ++sI) { v4u p; p.x = pw[2 * sI][0]; p.y = pw[2 * sI][1]; p.z = pw[2 * sI + 1][0]; p.w = pw[2 * sI + 1][1]; pf[sI] = __builtin_bit_cast(bf16x8, p); }
#pragma unroll
            for (int dt = 0; dt < 8; ++dt)
#pragma unroll
                for (int sI = 0; sI < 4; ++sI) { if (!(diag && 2 * sI > w)) { const bf16x8 vf = *(const LAS bf16x8*)(VT + (16 * dt + fr) * KS_LD + 2 * (32 * sI + 8 * fq)); o[dt] = __builtin_amdgcn_mfma_f32_16x16x32_bf16(vf, pf[sI], o[dt], 0, 0, 0); } }
            wmax = carry;
#pragma unroll
            for (int off = 1; off < 16; off <<= 1) wmax = fmaxf(wmax, __shfl_xor(wmax, off));
        }
        if (lane == 0) WM[w] = wmax;
        WG_BAR();
        float mx = WM[0];
#pragma unroll
        for (int k = 1; k < 8; ++k) mx = fmaxf(mx, WM[k]);
        if (mx < ATT_STOP) break;
    }
    if (active) {
        const int row = qrow0 + qi;
        float ss = 0.f;
#pragma unroll
        for (int dt = 0; dt < 8; ++dt) ss += (o[dt][0] * o[dt][0] + o[dt][1] * o[dt][1]) + (o[dt][2] * o[dt][2] + o[dt][3] * o[dt][3]);
        ss += __shfl_xor(ss, 16); ss += __shfl_xor(ss, 32);
        if (fq == 0) F.SsqS()[(size_t)row * 8 + h] = ss;
#pragma unroll
        for (int dt = 0; dt < 8; ++dt) { const int d = 16 * dt + 4 * fq; const f32x4 gv = *(const f32x4*)(F.g_sb() + h * HD + d); const f32x4 y = o[dt] * gv;
            v2u q; q.x = cvt_pk_bf16(y[0], y[1]); q.y = cvt_pk_bf16(y[2], y[3]); *(v2u*)(F.Y() + (size_t)row * DM + DLRU + h * HD + d) = q; }
    }
}

__device__ __forceinline__ void mix_row_plain(Frame& F, int m, int lane) {
    {
        GAS v4u* yr = (GAS v4u*)(F.Y() + (size_t)m * DM);
        float y[6][8]; float ss = 0.f;
#pragma unroll
        for (int j = 0; j < 6; ++j) { const int ci = lane + 64 * j; const v4u q = yr[ci];
            y[j][0] = bflo(q.x); y[j][1] = bfhi(q.x); y[j][2] = bflo(q.y); y[j][3] = bfhi(q.y); y[j][4] = bflo(q.z); y[j][5] = bfhi(q.z); y[j][6] = bflo(q.w); y[j][7] = bfhi(q.w);
            if (m < MP) { const v4u z = __builtin_nontemporal_load((const GAS v4u*)(F.Z() + (size_t)m * DLRU) + ci); const float* cp = F.Carry() + (size_t)(m >> 6) * DLRU + 8 * ci; const f32x4 c0 = *(const f32x4*)cp, c1 = *(const f32x4*)(cp + 4);
                y[j][0] += bflo(z.x) * c0[0]; y[j][1] += bfhi(z.x) * c0[1]; y[j][2] += bflo(z.y) * c0[2]; y[j][3] += bfhi(z.y) * c0[3]; y[j][4] += bflo(z.z) * c1[0]; y[j][5] += bfhi(z.z) * c1[1]; y[j][6] += bflo(z.w) * c1[2]; y[j][7] += bfhi(z.w) * c1[3]; }
#pragma unroll
            for (int e = 0; e < 8; ++e) ss += y[j][e] * y[j][e]; }
        const f32x4 b0 = *(const f32x4*)(F.SsqS() + (size_t)m * 8), b1 = *(const f32x4*)(F.SsqS() + (size_t)m * 8 + 4);
        const float ssb = 1.0f / sqrtf((((b0[0] + b0[1]) + (b0[2] + b0[3])) + ((b1[0] + b1[1]) + (b1[2] + b1[3]))) * (1.0f / DSB) + EPS);
        const float sl = 1.0f / sqrtf(wave_sum(ss) * (1.0f / DLRU) + EPS);
#pragma unroll
        for (int j = 0; j < 6; ++j) { const int ci = lane + 64 * j; v4u q; const f32x4 g0 = *(const f32x4*)(F.g_lru() + 8 * ci) * sl, g1 = *(const f32x4*)(F.g_lru() + 8 * ci + 4) * sl;
            q.x = cvt_pk_bf16(y[j][0] * g0[0], y[j][1] * g0[1]); q.y = cvt_pk_bf16(y[j][2] * g0[2], y[j][3] * g0[3]); q.z = cvt_pk_bf16(y[j][4] * g1[0], y[j][5] * g1[1]); q.w = cvt_pk_bf16(y[j][6] * g1[2], y[j][7] * g1[3]); yr[ci] = q; }
#pragma unroll
        for (int j = 6; j < 8; ++j) { const int ci = lane + 64 * j; v4u q = yr[ci];
            q.x = cvt_pk_bf16(bflo(q.x) * ssb, bfhi(q.x) * ssb); q.y = cvt_pk_bf16(bflo(q.y) * ssb, bfhi(q.y) * ssb); q.z = cvt_pk_bf16(bflo(q.z) * ssb, bfhi(q.z) * ssb); q.w = cvt_pk_bf16(bflo(q.w) * ssb, bfhi(q.w) * ssb); yr[ci] = q; }
    }
}
__device__ __forceinline__ void mix_rows(Frame& F) {
    const int gw = F.vcu * NWAVES + F.wave, NGW = F.G * NWAVES;
    for (int m = gw; m < M; m += NGW) mix_row_plain(F, m, F.lane);
}
__device__ __forceinline__ void mix_row_sample(Frame& F, int m, int lane) {
    GAS v4u* yr = (GAS v4u*)(F.Y() + (size_t)m * DM) + lane;
    v4u q[8]; f32x4 g[6][2];
#pragma unroll
    for (int j = 0; j < 8; ++j) q[j] = yr[64 * j];
    const f32x4 b0 = *(const f32x4*)(F.SsqS() + (size_t)m * 8), b1 = *(const f32x4*)(F.SsqS() + (size_t)m * 8 + 4);
#pragma unroll
    for (int j = 0; j < 6; ++j) { g[j][0] = *(const f32x4*)(F.g_lru() + 8 * (lane + 64 * j)); g[j][1] = *(const f32x4*)(F.g_lru() + 8 * (lane + 64 * j) + 4); }
    float ss = 0.f;
#pragma unroll
    for (int j = 0; j < 6; ++j) { const float a0 = bflo(q[j].x), a1 = bfhi(q[j].x), a2 = bflo(q[j].y), a3 = bfhi(q[j].y), a4 = bflo(q[j].z), a5 = bfhi(q[j].z), a6 = bflo(q[j].w), a7 = bfhi(q[j].w);
        ss += ((a0 * a0 + a1 * a1) + (a2 * a2 + a3 * a3)) + ((a4 * a4 + a5 * a5) + (a6 * a6 + a7 * a7)); }
    const float ssb = 1.0f / sqrtf((((b0[0] + b0[1]) + (b0[2] + b0[3])) + ((b1[0] + b1[1]) + (b1[2] + b1[3]))) * (1.0f / DSB) + EPS);
    const float sl = 1.0f / sqrtf(wave_sum(ss) * (1.0f / DLRU) + EPS);
#pragma unroll
    for (int j = 0; j < 6; ++j) { const f32x4 g0 = g[j][0] * sl, g1 = g[j][1] * sl; v4u o;
        o.x = cvt_pk_bf16(bflo(q[j].x) * g0[0], bfhi(q[j].x) * g0[1]); o.y = cvt_pk_bf16(bflo(q[j].y) * g0[2], bfhi(q[j].y) * g0[3]);
        o.z = cvt_pk_bf16(bflo(q[j].z) * g1[0], bfhi(q[j].z) * g1[1]); o.w = cvt_pk_bf16(bflo(q[j].w) * g1[2], bfhi(q[j].w) * g1[3]); yr[64 * j] = o; }
#pragma unroll
    for (int j = 6; j < 8; ++j) { v4u o = q[j];
        o.x = cvt_pk_bf16(bflo(o.x) * ssb, bfhi(o.x) * ssb); o.y = cvt_pk_bf16(bflo(o.y) * ssb, bfhi(o.y) * ssb); o.z = cvt_pk_bf16(bflo(o.z) * ssb, bfhi(o.z) * ssb); o.w = cvt_pk_bf16(bflo(o.w) * ssb, bfhi(o.w) * ssb); yr[64 * j] = o; }
}
__device__ __forceinline__ void mix_rows_chunk(Frame& F) {
    const int lane = F.lane, c = F.vcu;
    LAS f32x4* cl = (LAS f32x4*)(F.lds + RING_OFF);
    LAS f32x4* gl = cl + 768;
    int m = c * 64 + F.wave * 8;
    v4u ya[8], za[6], yb[8], zb[6]; f32x4 sa[2], sb[2];
#define MX_LOAD(YQ, ZQ, SQ, mm) do { const GAS v4u* _y = (const GAS v4u*)(F.Y() + (size_t)(mm) * DM) + lane; const GAS v4u* _z = (const GAS v4u*)(F.Z() + (size_t)(mm) * DLRU) + lane; \
        _Pragma("unroll") for (int j = 0; j < 8; ++j) YQ[j] = _y[64 * j]; _Pragma("unroll") for (int j = 0; j < 6; ++j) ZQ[j] = __builtin_nontemporal_load(_z + 64 * j); \
        SQ[0] = *(const GAS f32x4*)(F.SsqS() + (size_t)(mm) * 8); SQ[1] = *(const GAS f32x4*)(F.SsqS() + (size_t)(mm) * 8 + 4); } while (0)
#define MX_FIN(YQ, ZQ, SQ, mm) do { LAS f32x4* _c = cl + 2 * lane; LAS f32x4* _g = gl + 2 * lane; asm volatile("" : "+v"(_c), "+v"(_g)); \
        float yv[6][8]; float ss = 0.f; \
        _Pragma("unroll") for (int j = 0; j < 6; ++j) { const f32x4 c0 = _c[128 * j], c1 = _c[128 * j + 1]; \
            yv[j][0] = bflo(YQ[j].x) + bflo(ZQ[j].x) * c0[0]; yv[j][1] = bfhi(YQ[j].x) + bfhi(ZQ[j].x) * c0[1]; yv[j][2] = bflo(YQ[j].y) + bflo(ZQ[j].y) * c0[2]; yv[j][3] = bfhi(YQ[j].y) + bfhi(ZQ[j].y) * c0[3]; \
            yv[j][4] = bflo(YQ[j].z) + bflo(ZQ[j].z) * c1[0]; yv[j][5] = bfhi(YQ[j].z) + bfhi(ZQ[j].z) * c1[1]; yv[j][6] = bflo(YQ[j].w) + bflo(ZQ[j].w) * c1[2]; yv[j][7] = bfhi(YQ[j].w) + bfhi(ZQ[j].w) * c1[3]; \
            _Pragma("unroll") for (int e = 0; e < 8; ++e) ss += yv[j][e] * yv[j][e]; } \
        const float ssb = 1.0f / sqrtf((((SQ[0][0] + SQ[0][1]) + (SQ[0][2] + SQ[0][3])) + ((SQ[1][0] + SQ[1][1]) + (SQ[1][2] + SQ[1][3]))) * (1.0f / DSB) + EPS); \
        const float sl = 1.0f / sqrtf(wave_sum(ss) * (1.0f / DLRU) + EPS); \
        GAS v4u* _o = (GAS v4u*)(F.Y() + (size_t)(mm) * DM) + lane; \
        _Pragma("unroll") for (int j = 0; j < 6; ++j) { const f32x4 g0 = _g[128 * j] * sl, g1 = _g[128 * j + 1] * sl; v4u q; \
            q.x = cvt_pk_bf16(yv[j][0] * g0[0], yv[j][1] * g0[1]); q.y = cvt_pk_bf16(yv[j][2] * g0[2], yv[j][3] * g0[3]); q.z = cvt_pk_bf16(yv[j][4] * g1[0], yv[j][5] * g1[1]); q.w = cvt_pk_bf16(yv[j][6] * g1[2], yv[j][7] * g1[3]); _o[64 * j] = q; } \
        _Pragma("unroll") for (int j = 6; j < 8; ++j) { v4u q = YQ[j]; \
            q.x = cvt_pk_bf16(bflo(q.x) * ssb, bfhi(q.x) * ssb); q.y = cvt_pk_bf16(bflo(q.y) * ssb, bfhi(q.y) * ssb); q.z = cvt_pk_bf16(bflo(q.z) * ssb, bfhi(q.z) * ssb); q.w = cvt_pk_bf16(bflo(q.w) * ssb, bfhi(q.w) * ssb); _o[64 * j] = q; } } while (0)
    MX_LOAD(ya, za, sa, m); __builtin_amdgcn_sched_barrier(0);
    for (int i = F.tid; i < 768; i += NWAVES * 64) { cl[i] = ((const GAS f32x4*)(F.Carry() + (size_t)c * DLRU))[i]; gl[i] = ((const GAS f32x4*)F.g_lru())[i]; }
    WG_BAR();
    for (int k = 0; k < 3; ++k) { MX_LOAD(yb, zb, sb, m + 1); __builtin_amdgcn_sched_barrier(0); MX_FIN(ya, za, sa, m); __builtin_amdgcn_sched_barrier(0);
                                  MX_LOAD(ya, za, sa, m + 2); __builtin_amdgcn_sched_barrier(0); MX_FIN(yb, zb, sb, m + 1); __builtin_amdgcn_sched_barrier(0); m += 2; }
    MX_LOAD(yb, zb, sb, m + 1); __builtin_amdgcn_sched_barrier(0); MX_FIN(ya, za, sa, m); __builtin_amdgcn_sched_barrier(0); MX_FIN(yb, zb, sb, m + 1);
#undef MX_LOAD
#undef MX_FIN
    for (int ms = MP + F.wave * F.G + F.vcu; ms < M; ms += F.G * NWAVES) mix_row_sample(F, ms, lane);
}
__device__ __forceinline__ void act_pass(Frame& F, int hf) {
    const int gt = F.vcu * (NWAVES * 64) + F.tid, NGT = F.G * NWAVES * 64;
    constexpr int NFG = DFF / 2 / 8, NRB = M / 32;
    for (int it = gt; it < NFG * NRB; it += NGT) {
        const int fg = it % NFG, rb = it / NFG, pnl = fg >> 4, wi = (fg & 15) * 8, vcol = 256 * pnl + wi, f = (DFF / 2) * hf + 128 * pnl + wi, r0 = 32 * rb;
        float w0[8], w1[8], w2[8], cbv[8], p2[8], p1[8];
        { const f32x4 a = *(const f32x4*)(F.fcw() + f), b = *(const f32x4*)(F.fcw() + f + 4); w0[0] = a[0]; w0[1] = a[1]; w0[2] = a[2]; w0[3] = a[3]; w0[4] = b[0]; w0[5] = b[1]; w0[6] = b[2]; w0[7] = b[3]; }
        { const f32x4 a = *(const f32x4*)(F.fcw() + DFF + f), b = *(const f32x4*)(F.fcw() + DFF + f + 4); w1[0] = a[0]; w1[1] = a[1]; w1[2] = a[2]; w1[3] = a[3]; w1[4] = b[0]; w1[5] = b[1]; w1[6] = b[2]; w1[7] = b[3]; }
        { const f32x4 a = *(const f32x4*)(F.fcw() + 2 * DFF + f), b = *(const f32x4*)(F.fcw() + 2 * DFF + f + 4); w2[0] = a[0]; w2[1] = a[1]; w2[2] = a[2]; w2[3] = a[3]; w2[4] = b[0]; w2[5] = b[1]; w2[6] = b[2]; w2[7] = b[3]; }
        { const f32x4 a = *(const f32x4*)(F.fcb() + f), b = *(const f32x4*)(F.fcb() + f + 4); cbv[0] = a[0]; cbv[1] = a[1]; cbv[2] = a[2]; cbv[3] = a[3]; cbv[4] = b[0]; cbv[5] = b[1]; cbv[6] = b[2]; cbv[7] = b[3]; }
        if (r0 >= MP) { const int b = (r0 - MP) >> 5; const float* s0 = F.st_ffn() + (size_t)(b * 2) * DFF + f; const float* s1 = s0 + DFF;
            const f32x4 a = *(const f32x4*)s0, c = *(const f32x4*)(s0 + 4), d = *(const f32x4*)s1, e = *(const f32x4*)(s1 + 4);
            p2[0] = a[0]; p2[1] = a[1]; p2[2] = a[2]; p2[3] = a[3]; p2[4] = c[0]; p2[5] = c[1]; p2[6] = c[2]; p2[7] = c[3];
            p1[0] = d[0]; p1[1] = d[1]; p1[2] = d[2]; p1[3] = d[3]; p1[4] = e[0]; p1[5] = e[1]; p1[6] = e[2]; p1[7] = e[3];
        } else if (r0 == 0) {
#pragma unroll
            for (int e = 0; e < 8; ++e) { p2[e] = 0.f; p1[e] = 0.f; }
        } else { const v4u a = *(const v4u*)(F.VALPRE() + (size_t)(r0 - 2) * DFF + vcol + 128), b = *(const v4u*)(F.VALPRE() + (size_t)(r0 - 1) * DFF + vcol + 128);
            p2[0] = bflo(a.x); p2[1] = bfhi(a.x); p2[2] = bflo(a.y); p2[3] = bfhi(a.y); p2[4] = bflo(a.z); p2[5] = bfhi(a.z); p2[6] = bflo(a.w); p2[7] = bfhi(a.w);
            p1[0] = bflo(b.x); p1[1] = bfhi(b.x); p1[2] = bflo(b.y); p1[3] = bfhi(b.y); p1[4] = bflo(b.z); p1[5] = bfhi(b.z); p1[6] = bflo(b.w); p1[7] = bfhi(b.w); }
#pragma unroll 4
        for (int t = 0; t < 32; ++t) { const int row = r0 + t;
            const v4u pq = *(const v4u*)(F.VALPRE() + (size_t)row * DFF + vcol + 128), vq = *(const v4u*)(F.VALPRE() + (size_t)row * DFF + vcol);
            float pc[8], vv[8], o[8];
            pc[0] = bflo(pq.x); pc[1] = bfhi(pq.x); pc[2] = bflo(pq.y); pc[3] = bfhi(pq.y); pc[4] = bflo(pq.z); pc[5] = bfhi(pq.z); pc[6] = bflo(pq.w); pc[7] = bfhi(pq.w);
            vv[0] = bflo(vq.x); vv[1] = bfhi(vq.x); vv[2] = bflo(vq.y); vv[3] = bfhi(vq.y); vv[4] = bflo(vq.z); vv[5] = bfhi(vq.z); vv[6] = bflo(vq.w); vv[7] = bfhi(vq.w);
#pragma unroll
            for (int e = 0; e < 8; ++e) { const float c = cbv[e] + (w0[e] * p2[e] + w1[e] * p1[e]) + w2[e] * pc[e]; o[e] = gelu_tanh(c) * vv[e]; p2[e] = p1[e]; p1[e] = pc[e]; }
            v4u q; q.x = cvt_pk_bf16(o[0], o[1]); q.y = cvt_pk_bf16(o[2], o[3]); q.z = cvt_pk_bf16(o[4], o[5]); q.w = cvt_pk_bf16(o[6], o[7]);
            *(v4u*)(F.ACT() + (size_t)row * DFF + f) = q;
            float* fdst = nullptr;
            if (row < MP) { if (row >= MP - 2) fdst = F.out() + O_FP + (size_t)(row - (MP - 2)) * DFF + f; }
            else { const int tt = (row - MP) & 31; if (tt >= 30) fdst = F.out() + O_FS + (size_t)(((row - MP) >> 5) * 2 + (tt - 30)) * DFF + f; }
            if (fdst) { *(f32x4*)fdst = (f32x4){pc[0], pc[1], pc[2], pc[3]}; *(f32x4*)(fdst + 4) = (f32x4){pc[4], pc[5], pc[6], pc[7]}; }
        }
    }
}

__device__ __forceinline__ void ffn_fixup(Frame& F) {
    const int gt = F.vcu * (NWAVES * 64) + F.tid, NGT = F.G * NWAVES * 64;
    constexpr int NF4 = DFF / 4, NITEM = (MP / 256 - 1) * 2 * NF4;
    for (int it0 = gt; it0 < NITEM; it0 += 3 * NGT) {
        f32x4 c[3], v[3], H1[3], H0[3], w0[3], w1[3];
#pragma unroll
        for (int k = 0; k < 3; ++k) { const int it = min(it0 + k * NGT, NITEM - 1); const int f = 4 * (it % NF4), q = it / NF4, rr = q & 1, pm = 1 + (q >> 1);
            c[k] = *(const f32x4*)(F.DefC() + ((size_t)pm * 2 + rr) * DFF + f); v[k] = *(const f32x4*)(F.DefV() + ((size_t)pm * 2 + rr) * DFF + f);
            H1[k] = *(const f32x4*)(F.Halo() + ((size_t)(pm - 1) * 2 + 1) * DFF + f); H0[k] = *(const f32x4*)(F.Halo() + ((size_t)(pm - 1) * 2 + 0) * DFF + f);
            w0[k] = *(const f32x4*)(F.fcw() + f); w1[k] = *(const f32x4*)(F.fcw() + DFF + f); }
#pragma unroll
        for (int k = 0; k < 3; ++k) { const int it = it0 + k * NGT; if (it >= NITEM) break; const int f = 4 * (it % NF4), q = it / NF4, rr = q & 1, pm = 1 + (q >> 1);
            const f32x4 cc = rr == 0 ? c[k] + (w1[k] * H1[k] + w0[k] * H0[k]) : c[k] + w0[k] * H1[k];
            v2u o; o.x = cvt_pk_bf16(gelu_tanh(cc[0]) * v[k][0], gelu_tanh(cc[1]) * v[k][1]); o.y = cvt_pk_bf16(gelu_tanh(cc[2]) * v[k][2], gelu_tanh(cc[3]) * v[k][3]);
            *(v2u*)(F.ACT() + (size_t)(256 * pm + rr) * DFF + f) = o; }
    }
}

template <int RPW> __device__ __forceinline__ void sample_rows_norm(Frame& F) {
    const int lane = F.lane, w = F.wave;
    LAS float* xs = (LAS float*)(F.lds + RING_OFF + NWAVES * TR_WAVE_BYTES);
    f32x4 v[RPW][2];
#pragma unroll
    for (int rr = 0; rr < RPW; ++rr) { const int r = F.vcu * RPW + rr, c4 = w * 128 + lane;
        const GAS f32x4* bp = (const GAS f32x4*)(F.x_s() + (size_t)r * DM) + c4; f32x4 p[8][2];
        v[rr][0] = bp[0]; v[rr][1] = bp[64];
#pragma unroll
        for (int ks = 0; ks < 8; ++ks) { const GAS f32x4* pr = (const GAS f32x4*)(F.Part() + ((size_t)ks * MS + r) * DM) + c4; p[ks][0] = pr[0]; p[ks][1] = pr[64]; }
#pragma unroll
        for (int ks = 0; ks < 8; ++ks) { v[rr][0] = v[rr][0] + p[ks][0]; v[rr][1] = v[rr][1] + p[ks][1]; }
        GAS f32x4* dp = (GAS f32x4*)(F.out() + O_Y + (size_t)(MP + r) * DM) + c4; dp[0] = v[rr][0]; dp[64] = v[rr][1];
        float sq = 0.f;
#pragma unroll
        for (int j = 0; j < 2; ++j) sq += (v[rr][j].x * v[rr][j].x + v[rr][j].y * v[rr][j].y) + (v[rr][j].z * v[rr][j].z + v[rr][j].w * v[rr][j].w);
        sq = wave_sum(sq); if (lane == 0) xs[rr * 8 + w] = sq; }
    WG_BAR();
#pragma unroll
    for (int rr = 0; rr < RPW; ++rr) { const int r = F.vcu * RPW + rr, c4 = w * 128 + lane;
        float tot = 0.f;
#pragma unroll
        for (int k = 0; k < 8; ++k) tot += xs[rr * 8 + k];
        const float rsn = 1.0f / sqrtf(tot * (1.0f / DM) + EPS);
        const GAS f32x4* gr = (const GAS f32x4*)F.g_ffn() + c4; GAS v2u* o8 = (GAS v2u*)(F.BUFA() + (size_t)(MP + r) * DM) + c4;
#pragma unroll
        for (int j = 0; j < 2; ++j) { const f32x4 gv = gr[64 * j]; const f32x4 x = v[rr][j]; v2u o; o.x = cvt_pk_bf16(x.x * rsn * gv.x, x.y * rsn * gv.y); o.y = cvt_pk_bf16(x.z * rsn * gv.z, x.w * rsn * gv.w); o8[64 * j] = o; } }
}
__device__ __forceinline__ void sample_rows_final(Frame& F) {
    const int gw = F.vcu * NWAVES + F.wave, NGW = F.G * NWAVES;
    int lane = (int)threadIdx.x; asm volatile("" : "+v"(lane)); lane &= 63;
    for (int it = gw; it < MS * 4; it += NGW) {
        const int r = it >> 2, c4 = (it & 3) * 256 + lane;
        GAS f32x4* yr = (GAS f32x4*)(F.out() + O_Y + (size_t)(MP + r) * DM) + c4;
        f32x4 v[4], p[8][4];
#pragma unroll
        for (int j = 0; j < 4; ++j) v[j] = yr[64 * j];
#pragma unroll
        for (int ks = 0; ks < 8; ++ks) { const GAS f32x4* pr = (const GAS f32x4*)(F.Part() + ((size_t)ks * MS + r) * DM) + c4;
#pragma unroll
            for (int j = 0; j < 4; ++j) p[ks][j] = pr[64 * j]; }
#pragma unroll
        for (int ks = 0; ks < 8; ++ks)
#pragma unroll
            for (int j = 0; j < 4; ++j) v[j] = v[j] + p[ks][j];
#pragma unroll
        for (int j = 0; j < 4; ++j) yr[64 * j] = v[j];
    }
}

constexpr int NPH = 11;
__global__ void __launch_bounds__(NWAVES * 64, 2) hymba_fwd(Args args) {
    extern __shared__ __attribute__((aligned(16))) unsigned char lds[];
    Frame F;
    F.lds = (LAS unsigned char*)lds;
    F.MISC = (volatile LAS unsigned*)(F.lds + MISC_OFF);
    F.tid = threadIdx.x; F.lane = F.tid & 63; F.wave = __builtin_amdgcn_readfirstlane(F.tid >> 6);
    F.G = gridDim.x; { const int bx = blockIdx.x; F.vcu = (F.G % 8 == 0) ? (bx % 8) * (F.G / 8) + bx / 8 : bx; }
    F.a = &args;
    F.ctl = (gu32*)(args.ws + WS_CTL);
    for (int u = F.tid; u < (LDS_BYTES - LDSCTL_OFF) / 4; u += NWAVES * 64) ((LAS unsigned*)(F.lds + LDSCTL_OFF))[u] = 0u;
    __syncthreads();
    XcdBarrier bar; bar.bar = (unsigned*)(F.ctl + CW_BAR); bar.x = 0; bar.st = nullptr;
    if (!MK_PER_PHASE) bar = xcd_barrier_post((unsigned*)(F.ctl + CW_BAR), F.MISC + 8);
#define GRID_BAR(seam) do { if (MK_PER_PHASE) { if (F.tid == 0) __hip_atomic_store(F.ctl + CW_TMO, 0xBADBA0u | (unsigned)(seam), RLX_AGENT); } else { xcd_barrier(bar); } } while (0)
    const int lo = args.ph_lo, hi = args.ph_hi;
#ifndef PH_MASK
#define PH_MASK 0xFFFF
#endif
#define IN(k) (((PH_MASK >> (k)) & 1) && lo <= (k) && (k) < hi)
#define BOTH(k) (IN(k) && IN((k) + 1))
#ifndef REP_MASK
#define REP_MASK 0
#endif
#define REP2(k) if constexpr (((REP_MASK >> (k)) & 1) != 0)
    LAS float* EPI = (LAS float*)(F.lds + EPI_OFF);

    if (IN(0)) { p0_prologue(F); REP2(0) p0_prologue(F); if (BOTH(0)) GRID_BAR(0); }
    if (IN(1)) {
        const int nconv = (F.G >= 8 * NCONV) ? NCONV : 0, gc = F.G - nconv;
        if ((int)blockIdx.x < gc) {
            pg8::Gemm g{F.BUFA(), F.Win_t(), M, DIN, DM}; pg8::StaticOrder S; S.init(M, DIN, gc, (int)blockIdx.x, DM / 64);
            Epi1 E{F.U(), F.Gt(), F.Qn(), F.Kn(), F.Vb(), F.out(), F.qg(), F.kg(), EPI};
            pg8::gemm_phase<Epi1, pg8::StaticOrder, true, true>(F.lds + RING_OFF, g, S, E);
        }
        conv_queue<false>(F);
        if (BOTH(1)) GRID_BAR(1);
    }
    if (IN(2)) {
        { LAS unsigned* tcnt = (LAS unsigned*)(F.lds + LDSCTL_OFF) + 16 * (F.wave >> 2); unsigned tphase = 0;
          if (F.G == 256) {
              for (int u = F.vcu * 2 + (F.wave >> 2); u < 256 * 16; u += 2 * F.G) lru_unit(F, u >> 4, u & 15, tcnt, tphase);
              if ((F.vcu & 3) == 0) { const int u = 256 * 16 + (F.vcu >> 2) * 2 + (F.wave >> 2); lru_unit(F, u >> 4, u & 15, tcnt, tphase); }
          } else for (int u = F.vcu * 2 + (F.wave >> 2); u < 264 * 16; u += 2 * F.G) lru_unit(F, u >> 4, u & 15, tcnt, tphase); }
        WG_BAR();
        for (int u = F.vcu; u < 1024; u += F.G) attn_unit<false>(F, u);
        if (F.G == 256) { if ((F.vcu & 3) == 1 || (F.vcu & 3) == 2) attn_unit<true>(F, 1024 + (F.vcu >> 2) * 2 + (F.vcu & 3) - 1); }
        else if (F.G >= 192) { if (F.vcu >= 64 && F.vcu < 192) attn_unit<true>(F, 1024 + F.vcu - 64); }
        else for (int u = 1024 + F.vcu; u < 1152; u += F.G) attn_unit<true>(F, u);
        if (BOTH(2)) GRID_BAR(2);
    }
    if (IN(3)) { lru_prefix(F); if (BOTH(3)) GRID_BAR(3); }
    if (IN(4)) { if (F.G == MP / 64) mix_rows_chunk(F); else mix_rows(F); if (BOTH(4)) GRID_BAR(4); }
    if (IN(5)) {
        pg8::Gemm g{F.Y(), F.Wout_t(), M, DM, DM}; pg8::StaticOrder S; S.init(MP, DM, F.G, (int)blockIdx.x, DM / 64, 8);
        EpiRes<0> E{F.x_p(), F.X1(), F.out(), F.Part()};
        pg8::gemm_phase<EpiRes<0>, pg8::StaticOrder, true, true>(F.lds + RING_OFF, g, S, E);
        if (BOTH(5)) GRID_BAR(5);
    }
    if (IN(6)) {
        const int gw = F.vcu * NWAVES + F.wave, NGW = F.G * NWAVES;
        hn2_rows(F);
        if (F.G * 2 == MS) sample_rows_norm<2>(F);
        else for (int r = gw; r < MS; r += NGW) sample_row_reduce(F.x_s() + (size_t)r * DM, F.Part(), r, F.out() + O_Y + (size_t)(MP + r) * DM, F.g_ffn(), F.BUFA() + (size_t)(MP + r) * DM, F.lane);
        if (BOTH(6)) GRID_BAR(6);
    }
    if (IN(7)) {
        pg8::Gemm g{F.BUFA(), F.Wup_t(), M, 2 * DFF, DM}; pg8::StaticOrder S; S.init(M, 2 * DFF, F.G, (int)blockIdx.x, DM / 64);
        EpiUp E{F.ACT(), F.fcw(), F.fcb(), F.st_ffn(), F.out(), F.Halo(), F.DefC(), F.DefV(), EPI};
        pg8::gemm_phase<EpiUp, pg8::StaticOrder, true, true>(F.lds + RING_OFF, g, S, E);
        conv_queue<true>(F);
        if (BOTH(7)) GRID_BAR(7);
    }
    if (IN(8)) { ffn_fixup(F); if (BOTH(8)) GRID_BAR(8); }
    if (IN(9)) {
        pg8::Gemm g{F.ACT(), F.Wdown_t(), M, DM, DFF}; pg8::StaticOrder S; S.init(MP, DM, F.G, (int)blockIdx.x, DFF / 64, 8);
        EpiRes<1> E{F.x_p(), F.X1(), F.out(), F.Part()};
        pg8::gemm_phase<EpiRes<1>, pg8::StaticOrder, true, true>(F.lds + RING_OFF, g, S, E);
        if (BOTH(9)) GRID_BAR(9);
    }
    if (IN(10)) sample_rows_final(F);
#undef IN
#undef BOTH
}

extern "C" void kernel_launch(void* const* d_in, const int* in_sizes, int n_in, void* d_out, int out_size, void* d_ws, size_t ws_size, hipStream_t stream) {
    static int grid = 0;
    if (grid == 0) {
        if (n_in != 26 || out_size != (int)O_END || ws_size < WS_END) { fprintf(stderr, "kernel_launch: unexpected shapes (n_in %d, out %d, ws %zu); nothing launched\n", n_in, out_size, ws_size); grid = -1; return; }
        int dev = 0, cus = 0, per_cu = 0;
        if (hipGetDevice(&dev) != hipSuccess || hipDeviceGetAttribute(&cus, hipDeviceAttributeMultiprocessorCount, dev) != hipSuccess) { grid = -1; return; }
        if (hipFuncSetAttribute((const void*)hymba_fwd, hipFuncAttributeMaxDynamicSharedMemorySize, LDS_BYTES) != hipSuccess) { fprintf(stderr, "kernel_launch: hipFuncSetAttribute failed\n"); grid = -1; return; }
        if (hipOccupancyMaxActiveBlocksPerMultiprocessor(&per_cu, (const void*)hymba_fwd, NWAVES * 64, LDS_BYTES) != hipSuccess || per_cu < 1) { fprintf(stderr, "kernel_launch: occupancy query reports %d blocks per CU\n", per_cu); }
        (void)hipGetLastError();
        grid = cus;
        if (MK_GRID) grid = MK_GRID;
    }
    if (grid < 0) return;
    if (hipMemsetAsync((char*)d_ws + WS_CTL, 0, CTL_ZERO_BYTES, stream) != hipSuccess) return;
    Args a{};
    for (int i = 0; i < 26; ++i) a.in[i] = (const float*)d_in[i];
    a.out = (float*)d_out; a.ws = (unsigned char*)d_ws;
    const int nl = MK_PER_PHASE ? NPH : 1;
    for (int li = 0; li < nl; ++li) {
        a.ph_lo = MK_PER_PHASE ? li : 0; a.ph_hi = MK_PER_PHASE ? li + 1 : NPH; a.li = li;
        hipLaunchKernelGGL(hymba_fwd, dim3(grid), dim3(NWAVES * 64), LDS_BYTES, stream, a);
        const hipError_t le = hipPeekAtLastError();
        if (le != hipSuccess) { fprintf(stderr, "kernel_launch: launch %d failed: %s\n", li, hipGetErrorName(le)); break; }
    }
}
```

```cpp
#include <hip/hip_runtime.h>
#include <cstdio>
#include <cstdint>
#define MK_PER_PHASE 0
namespace pg8 {
#define PG8_LAS __attribute__((address_space(3)))
typedef unsigned short bf16_t;
typedef short bf16x8 __attribute__((ext_vector_type(8)));
typedef float f32x4 __attribute__((ext_vector_type(4)));
typedef unsigned u32x4 __attribute__((ext_vector_type(4)));
constexpr int BM = 256, BK = 64, HALF = 128, HTB = HALF * BK * 2  , STAGE_BYTES = 8 * HTB, NXCD = 8, WGM = 8;

__host__ __device__ __forceinline__ int lds_byte(int r, int c) { const int st = (r >> 4) * 2 + (c >> 5), rr = r & 15, cc = c & 31, ob = rr * 64 + cc * 2; return st * 1024 + (ob ^ (((ob >> 9) & 1) << 5)); }
__host__ __device__ __forceinline__ void stage_rc(int b, int& R, int& C) { const int st = b / 1024, sb = b % 1024, swz = sb ^ (((sb >> 9) & 1) << 5); R = (st >> 1) * 16 + swz / 64; C = (st & 1) * 32 + (swz % 64) / 2; }
__host__ __device__ __forceinline__ int perm32(int rho) { const int n = rho >> 4, i = rho & 15; return 8 * (i >> 2) + 4 * n + (i & 3); }

struct Unit { int pm, pn, k0, nt, ks; };
struct Gemm { const bf16_t* A; const bf16_t* Bt; int M, N, K; };

struct StaticOrder {
    int nM, nN, nwg, G, c, ntK, nsplit;
    __host__ __device__ void init(int M, int N, int G_, int c_, int ntK_, int nsplit_ = 0) { nM = M / BM; nN = N / BM; nwg = nM * nN; G = G_; c = c_; ntK = ntK_; nsplit = nsplit_; }
    __host__ __device__ __forceinline__ bool next(int i, Unit& u) const {
        int ii = i;
        if (nsplit > 0 && (nwg % G) == 0 && 2 * nN * nsplit == G && (c & 7) < 4) { const int nmain = nwg / G; ii = (i == 0) ? nmain : (i <= nmain ? i - 1 : i); }
        const long L = (long)ii * G + c;
        int pm, pn, k0 = 0, nt = ntK, ks = -1; bool ok = true;
        if (L >= nwg) {
            const int s = (int)(L - nwg); ok = (nsplit != 0) && (s < 2 * nN * nsplit);
            const int nsp = nsplit > 0 ? nsplit : 1, tile = s / nsp; ks = s - tile * nsp; pm = nM + tile / nN; pn = tile % nN; nt = ntK / nsp; k0 = ks * nt;
        } else {
            int wgid = (int)L; { const int q = nwg / NXCD, r = nwg % NXCD, xcd = wgid % NXCD, off = wgid / NXCD; wgid = (xcd < r ? xcd * (q + 1) : r * (q + 1) + (xcd - r) * q) + off; }
            const int nig = WGM * nN, gid = wgid / nig, fm = gid * WGM, gsz = (nM - fm) < WGM ? (nM - fm) : WGM;
            pm = fm + ((wgid % nig) % gsz); pn = (wgid % nig) / gsz;
        }
        u.pm = pm; u.pn = pn; u.k0 = k0; u.nt = nt; u.ks = ks; return ok;
    }
    __device__ __forceinline__ void a_ready(const Unit&) const {}
    __device__ __forceinline__ void done(const Unit&) const {}
};

typedef float f32x2c __attribute__((ext_vector_type(2)));
typedef __bf16 bf16x2c __attribute__((ext_vector_type(2)));
__device__ __forceinline__ unsigned cvt_pk_bf16(float lo, float hi) { const f32x2c v = {lo, hi}; return __builtin_bit_cast(unsigned, __builtin_convertvector(v, bf16x2c)); }
typedef float f32x2 __attribute__((ext_vector_type(2)));
template <class Epi, class Sched, bool ALIGN_EPI = false, bool SP2 = false>
__device__ __forceinline__ void gemm_phase(PG8_LAS unsigned char* lds, const Gemm g, const Sched& S, const Epi& E) {
    const int tid = threadIdx.x, wid = __builtin_amdgcn_readfirstlane(tid >> 6), lane = tid & 63, wr = wid >> 2, wc = wid & 3, fr = lane & 15, fq = lane >> 4;
    const int K = g.K;
    unsigned voffA[2], voffB[2];
#pragma unroll
    for (int i = 0; i < 2; ++i) { int R, C; stage_rc(tid * 16 + i * 8192, R, C); const int Rb = Epi::PERM ? ((R & ~31) + perm32(R & 31)) : R;
        voffA[i] = (unsigned)(R * K + C) * 2u; voffB[i] = (unsigned)(Rb * K + C) * 2u; }
    const size_t kstep = (size_t)(BK * 2);
    const size_t hstep = (size_t)HALF * K * 2;
    const size_t tstep = 2 * hstep;
    const unsigned ldsw = (unsigned)wid * 1024u;
    const int aoff = lds_byte(wr * 64 + fr, fq * 8), boff = lds_byte(wc * 32 + fr, fq * 8);
#define PG8_SA(b, h) (((b) * 2 + (h)) * HTB)
#define PG8_SB(b, h) ((4 + (b) * 2 + (h)) * HTB)
#define PG8_STAGE(bufoff, gbase, voff) do { _Pragma("unroll") for (int _i = 0; _i < 2; ++_i) \
        __builtin_amdgcn_global_load_lds((const unsigned*)((const char*)(gbase) + (voff)[_i]), (PG8_LAS unsigned*)(lds + (bufoff) + ldsw + _i * 8192), 16, 0, 0); } while (0)
#define PG8_LDA(dst, b, h) do { _Pragma("unroll") for (int m = 0; m < 4; ++m) _Pragma("unroll") for (int k = 0; k < 2; ++k) dst[m][k] = *(const PG8_LAS bf16x8*)(lds + PG8_SA(b, h) + aoff + m * 2048 + k * 1024); } while (0)
#define PG8_LDB(dst, b, h) do { _Pragma("unroll") for (int n = 0; n < 2; ++n) _Pragma("unroll") for (int k = 0; k < 2; ++k) dst[n][k] = *(const PG8_LAS bf16x8*)(lds + PG8_SB(b, h) + boff + n * 2048 + k * 1024); } while (0)
#define PG8_MMA(ai, bj, At, Bt) do { __builtin_amdgcn_s_setprio(1); _Pragma("unroll") for (int m = 0; m < 4; ++m) _Pragma("unroll") for (int n = 0; n < 2; ++n) _Pragma("unroll") for (int k = 0; k < 2; ++k) \
        acc[ai][bj][m][n] = __builtin_amdgcn_mfma_f32_16x16x32_bf16(Bt[n][k], At[m][k], acc[ai][bj][m][n], 0, 0, 0); __builtin_amdgcn_s_setprio(0); } while (0)
#define PG8_WAIT_V(n) asm volatile("s_waitcnt vmcnt(" #n ")" ::: "memory")
#define PG8_WAIT_L(n) asm volatile("s_waitcnt lgkmcnt(" #n ")" ::: "memory")
#define PG8_BAR __builtin_amdgcn_s_barrier()
#define PG8_SCHED __builtin_amdgcn_sched_barrier(0)
    Unit cur, nxt; int ui = 0;
    if (!S.next(0, cur)) return;
    f32x4 acc[2][2][4][2];
#pragma unroll
    for (int a = 0; a < 2; ++a)
#pragma unroll
        for (int b = 0; b < 2; ++b)
#pragma unroll
            for (int m = 0; m < 4; ++m)
#pragma unroll
                for (int n = 0; n < 2; ++n) acc[a][b][m][n] = (f32x4){0.f, 0.f, 0.f, 0.f};
    bf16x8 At[4][2], B0[2][2], B1[2][2];
    const char* cA = (const char*)g.A + (size_t)cur.pm * tstep + (size_t)cur.k0 * kstep; const char* cB = (const char*)g.Bt + (size_t)cur.pn * tstep + (size_t)cur.k0 * kstep;
    S.a_ready(cur);
    if constexpr (SP2) {
        PG8_STAGE(PG8_SB(0, 0), cB, voffB); PG8_STAGE(PG8_SB(0, 1), cB + hstep, voffB); PG8_STAGE(PG8_SA(0, 0), cA, voffA); PG8_STAGE(PG8_SA(0, 1), cA + hstep, voffA);
        if (wr == 1) PG8_BAR;
        PG8_WAIT_V(2); PG8_BAR;
        PG8_STAGE(PG8_SB(1, 0), cB + kstep, voffB); PG8_STAGE(PG8_SA(1, 0), cA + kstep, voffA); PG8_STAGE(PG8_SB(1, 1), cB + hstep + kstep, voffB);
        PG8_WAIT_V(6); PG8_BAR;
    } else {
        PG8_STAGE(PG8_SB(0, 0), cB, voffB); PG8_STAGE(PG8_SA(0, 0), cA, voffA); PG8_STAGE(PG8_SB(0, 1), cB + hstep, voffB); PG8_STAGE(PG8_SA(0, 1), cA + hstep, voffA);
        if (wr == 1) PG8_BAR;
        PG8_WAIT_V(4); PG8_BAR;
        PG8_STAGE(PG8_SB(1, 0), cB + kstep, voffB); PG8_STAGE(PG8_SA(1, 0), cA + kstep, voffA); PG8_STAGE(PG8_SB(1, 1), cB + hstep + kstep, voffB);
        PG8_WAIT_V(6); PG8_BAR;
    }
    for (;;) {
        const bool has_next = S.next(ui + 1, nxt);
        const char* nA = has_next ? (const char*)g.A + (size_t)nxt.pm * tstep + (size_t)nxt.k0 * kstep : cA; const char* nB = has_next ? (const char*)g.Bt + (size_t)nxt.pn * tstep + (size_t)nxt.k0 * kstep : cB;
        const int nt = cur.nt;
        for (int t = 0; t < nt; t += 2) {
            const bool last = (t == nt - 2);
            const char* a1 = cA + (size_t)(t + 1) * kstep;
            const char* a2 = last ? nA : cA + (size_t)(t + 2) * kstep; const char* b2 = last ? nB : cB + (size_t)(t + 2) * kstep;
            const char* a3 = a2 + kstep; const char* b3 = b2 + kstep;
            if (last && has_next) S.a_ready(nxt);
            if constexpr (SP2) {
            PG8_LDB(B0, 0, 0); PG8_LDB(B1, 0, 1); PG8_SCHED; PG8_LDA(At, 0, 0); PG8_STAGE(PG8_SA(1, 1), a1 + hstep, voffA);
            PG8_WAIT_V(8); PG8_WAIT_L(0); PG8_BAR; PG8_MMA(0, 0, At, B0); PG8_MMA(0, 1, At, B1); PG8_BAR; PG8_SCHED;
            PG8_LDA(At, 0, 1); PG8_STAGE(PG8_SB(0, 0), b2, voffB); PG8_STAGE(PG8_SB(0, 1), b2 + hstep, voffB); PG8_STAGE(PG8_SA(0, 0), a2, voffA);
            PG8_WAIT_V(8); PG8_WAIT_L(0); PG8_BAR; PG8_MMA(1, 0, At, B0); PG8_MMA(1, 1, At, B1); PG8_BAR; PG8_SCHED;
            PG8_LDB(B0, 1, 0); PG8_LDB(B1, 1, 1); PG8_SCHED; PG8_LDA(At, 1, 0); PG8_STAGE(PG8_SA(0, 1), a2 + hstep, voffA);
            PG8_WAIT_V(8); PG8_WAIT_L(0); PG8_BAR; PG8_MMA(0, 0, At, B0); PG8_MMA(0, 1, At, B1); PG8_BAR; PG8_SCHED;
            PG8_LDA(At, 1, 1); PG8_STAGE(PG8_SB(1, 0), b3, voffB); PG8_STAGE(PG8_SB(1, 1), b3 + hstep, voffB); PG8_STAGE(PG8_SA(1, 0), a3, voffA);
            PG8_WAIT_V(8); PG8_WAIT_L(0); PG8_BAR; PG8_MMA(1, 0, At, B0); PG8_MMA(1, 1, At, B1); PG8_BAR; PG8_SCHED;
            } else {
            PG8_LDB(B0, 0, 0); PG8_SCHED; PG8_LDA(At, 0, 0); PG8_STAGE(PG8_SA(1, 1), a1 + hstep, voffA);
            PG8_WAIT_L(8); PG8_BAR; PG8_WAIT_L(0); PG8_MMA(0, 0, At, B0); PG8_BAR; PG8_SCHED;
            PG8_LDB(B1, 0, 1); PG8_STAGE(PG8_SB(0, 0), b2, voffB);
            PG8_BAR; PG8_WAIT_L(0); PG8_MMA(0, 1, At, B1); PG8_BAR;
            PG8_LDA(At, 0, 1); PG8_STAGE(PG8_SA(0, 0), a2, voffA);
            PG8_BAR; PG8_WAIT_L(0); PG8_MMA(1, 0, At, B0); PG8_BAR; PG8_SCHED;
            PG8_STAGE(PG8_SB(0, 1), b2 + hstep, voffB);
            PG8_WAIT_V(6); PG8_BAR; PG8_MMA(1, 1, At, B1); PG8_BAR;
            PG8_LDB(B0, 1, 0); PG8_SCHED; PG8_LDA(At, 1, 0); PG8_STAGE(PG8_SA(0, 1), a2 + hstep, voffA);
            PG8_WAIT_L(8); PG8_BAR; PG8_WAIT_L(0); PG8_MMA(0, 0, At, B0); PG8_BAR; PG8_SCHED;
            PG8_LDB(B1, 1, 1); PG8_STAGE(PG8_SB(1, 0), b3, voffB);
            PG8_BAR; PG8_WAIT_L(0); PG8_MMA(0, 1, At, B1); PG8_BAR;
            PG8_LDA(At, 1, 1); PG8_STAGE(PG8_SA(1, 0), a3, voffA);
            PG8_BAR; PG8_WAIT_L(0); PG8_MMA(1, 0, At, B0); PG8_BAR; PG8_SCHED;
            PG8_STAGE(PG8_SB(1, 1), b3 + hstep, voffB);
            PG8_WAIT_V(6); PG8_BAR; PG8_MMA(1, 1, At, B1); PG8_BAR;
            }
        }
        if constexpr (ALIGN_EPI) { if (wr == 0) PG8_BAR; }
        if constexpr (!Epi::AFTER_DRAIN) { E(acc, cur, wr, wc, fr, fq); S.done(cur); }
        if (!has_next) break;
#pragma unroll
        for (int a = 0; a < 2; ++a)
#pragma unroll
            for (int b = 0; b < 2; ++b)
#pragma unroll
                for (int m = 0; m < 4; ++m)
#pragma unroll
                    for (int n = 0; n < 2; ++n) acc[a][b][m][n] = (f32x4){0.f, 0.f, 0.f, 0.f};
        cur = nxt; cA = nA; cB = nB; ++ui;
        if constexpr (ALIGN_EPI) { if (wr == 1) PG8_BAR; }
    }
    PG8_WAIT_V(0);
    if constexpr (!ALIGN_EPI) { if (wr == 0) PG8_BAR; }
    PG8_BAR;
    if constexpr (Epi::AFTER_DRAIN) { E.fused(acc, cur, wr, wc, fr, fq, lds, wid, lane); S.done(cur); }
#undef PG8_SA
#undef PG8_SB
#undef PG8_STAGE
#undef PG8_LDA
#undef PG8_LDB
#undef PG8_MMA
#undef PG8_WAIT_V
#undef PG8_WAIT_L
#undef PG8_BAR
#undef PG8_SCHED
}
}

constexpr int DM = 4096, SEQ = 16384, DBATCH = 16, DSEQ = 32, PAST = 4096, HD = 128, NH = 8, DSB = 1024, DLRU = 3072, NBLK = 16, BD = 192, DIN = 9216, DFF = 12288;
constexpr int MP = SEQ, MS = DBATCH * DSEQ, M = MP + MS;
constexpr float EPS = 1e-6f;
constexpr int NWAVES = 8;
#ifndef MK_PER_PHASE
#define MK_PER_PHASE 0
#endif
#ifndef MK_GRID
#define MK_GRID 0
#endif

constexpr size_t O_Y = 0, O_KP = (size_t)M * DM, O_VP = O_KP + (size_t)MP * DSB, O_HP = O_VP + (size_t)MP * DSB, O_CP = O_HP + DLRU, O_FP = O_CP + 3 * DLRU,
                 O_KS = O_FP + 2 * DFF, O_VS = O_KS + (size_t)MS * DSB, O_HS = O_VS + (size_t)MS * DSB, O_CS = O_HS + (size_t)DBATCH * DLRU, O_FS = O_CS + (size_t)DBATCH * 3 * DLRU,
                 O_END = O_FS + (size_t)DBATCH * 2 * DFF;
static_assert(O_END == 104435712, "d_out size");

constexpr size_t MiB = 1u << 20;
constexpr size_t WS_CTL = 0, CTL_ZERO_BYTES = 1 * MiB;
constexpr size_t WS_WA = 1 * MiB, WS_WX = WS_WA + (size_t)NBLK * BD * BD * 2;
constexpr size_t WS_AGGA = 4 * MiB, WS_AGGB = 7 * MiB;
constexpr size_t WS_C8 = 10 * MiB, WS_SSQ2 = 1292 * MiB, WS_S2 = 10 * MiB + 65536, WS_SSQS = 11 * MiB, WS_CARRY = 12 * MiB;
constexpr size_t WS_DUMP = 15 * MiB;
constexpr size_t WS_HALO = 832 * MiB, WS_DEFC = 840 * MiB, WS_DEFV = 848 * MiB;
constexpr size_t WS_Z = 970 * MiB;
constexpr size_t WS_WDOWN = 16 * MiB, WS_WUP = 112 * MiB, WS_BUFA = 304 * MiB, WS_ACT = 436 * MiB, WS_VALPRE = 832 * MiB, WS_PART = 1228 * MiB, WS_END = 1294 * MiB;
constexpr size_t WS_WIN = 436 * MiB, WS_WOUT = 508 * MiB, WS_U = 540 * MiB, WS_G = 639 * MiB, WS_QN = 738 * MiB, WS_KN = 771 * MiB, WS_VB = 804 * MiB, WS_Y = 837 * MiB;
static_assert(WS_SSQ2 + (size_t)M * 16 * 4 <= 1294 * MiB && WS_WX + (size_t)NBLK * BD * BD * 2 <= WS_AGGA && WS_SSQS + (size_t)M * 8 * 4 <= WS_CARRY && WS_CARRY + (size_t)256 * DLRU * 4 <= WS_WDOWN, "ws map (small)");
static_assert(WS_Z >= WS_Y + (size_t)M * DM * 2 && WS_Z + (size_t)MP * DLRU * 2 <= WS_PART, "ws map (Z)");
static_assert(WS_WDOWN + (size_t)DM * DFF * 2 <= WS_WUP && WS_WUP + (size_t)2 * DFF * DM * 2 <= WS_BUFA && WS_BUFA + (size_t)M * DM * 2 <= WS_ACT, "ws map (weights)");
static_assert(WS_ACT + (size_t)M * DFF * 2 <= WS_VALPRE && WS_VALPRE + (size_t)M * DFF * 2 <= WS_PART && WS_PART + (size_t)8 * MS * DM * 4 <= WS_SSQ2, "ws map (ffn)");
static_assert(WS_WIN + (size_t)DIN * DM * 2 <= WS_WOUT && WS_WOUT + (size_t)DM * DM * 2 <= WS_U && WS_U + (size_t)M * DLRU * 2 <= WS_G && WS_G + (size_t)M * DLRU * 2 <= WS_QN, "ws map (early 1)");
static_assert(WS_QN + (size_t)M * DSB * 2 <= WS_KN && WS_KN + (size_t)M * DSB * 2 <= WS_VB && WS_VB + (size_t)M * DSB * 2 <= WS_Y && WS_Y + (size_t)M * DM * 2 <= WS_PART, "ws map (early 2)");
constexpr int CW_TMO = 0, CW_CODE = 1, CW_Q1 = 64, CW_Q2 = 128, CW_DONE = 192, CW_BAR = 4096;

constexpr int RING_OFF = 0, RING_BYTES = 131072;
constexpr int EPI_OFF = RING_BYTES, EPI_BYTES = 8192;
constexpr int LDSCTL_OFF = EPI_OFF + EPI_BYTES, MISC_OFF = LDSCTL_OFF + 320;
constexpr int LDS_BYTES = 147456;
static_assert(MISC_OFF + 128 <= LDS_BYTES, "LDS map");

#define GAS __attribute__((address_space(1)))
#define LAS __attribute__((address_space(3)))
typedef unsigned short bf16;
typedef unsigned v4u __attribute__((ext_vector_type(4)));
typedef unsigned v2u __attribute__((ext_vector_type(2)));
typedef float f32x4 __attribute__((ext_vector_type(4)));
typedef short bf16x8 __attribute__((ext_vector_type(8)));
typedef GAS unsigned gu32;
#define RLX_AGENT __ATOMIC_RELAXED, __HIP_MEMORY_SCOPE_AGENT
#define LDS_WAIT() asm volatile("s_waitcnt lgkmcnt(0)" ::: "memory")
#define VM_WAIT() asm volatile("s_waitcnt vmcnt(0)" ::: "memory")
#define WG_BAR() do { asm volatile("s_waitcnt lgkmcnt(0)" ::: "memory"); __builtin_amdgcn_s_barrier(); asm volatile("" ::: "memory"); } while (0)
using pg8::cvt_pk_bf16;
__device__ __forceinline__ float bflo(unsigned w) { return __builtin_bit_cast(float, w << 16); }
__device__ __forceinline__ float bfhi(unsigned w) { return __builtin_bit_cast(float, w & 0xffff0000u); }
__device__ __forceinline__ float fexp2(float x) { return __builtin_amdgcn_exp2f(x); }
__device__ __forceinline__ float flog2(float x) { return __builtin_amdgcn_logf(x); }
__device__ __forceinline__ float frcp(float x) { return __builtin_amdgcn_rcpf(x); }
__device__ __forceinline__ float sigmoidf_(float x) { return frcp(1.0f + fexp2(-1.4426950408889634f * x)); }
__device__ __forceinline__ float gelu_tanh(float x) { const float u = x * (1.0f + 0.044715f * x * x); return x * frcp(1.0f + fexp2(-2.302208198f * u)); }
typedef float f32x2 __attribute__((ext_vector_type(2)));
__device__ __forceinline__ f32x2 gelu_tanh2(f32x2 x) {
    const f32x2 t = (x * x) * (-2.302208198f * 0.044715f) + (-2.302208198f), a = x * t;
    f32x2 e; e.x = fexp2(a.x); e.y = fexp2(a.y);
    const f32x2 d = e + 1.0f;
    f32x2 r; r.x = frcp(d.x); r.y = frcp(d.y);
    return x * r;
}
__device__ __forceinline__ f32x2 sigmoid2(f32x2 x) { const f32x2 a = x * (-1.4426950408889634f); f32x2 e; e.x = fexp2(a.x); e.y = fexp2(a.y); const f32x2 d = e + 1.0f; f32x2 r; r.x = frcp(d.x); r.y = frcp(d.y); return r; }
__device__ __forceinline__ float wave_sum(float v) {
#pragma unroll
    for (int o = 1; o < 64; o <<= 1) v += __shfl_xor(v, o);
    return v;
}
template <int S> __device__ __forceinline__ float dpp_ror(float v) {
    return __builtin_bit_cast(float, __builtin_amdgcn_update_dpp(0, __builtin_bit_cast(int, v), 0x120 + S, 0xF, 0xF, true));
}
template <int S> __device__ __forceinline__ float dpp_shr(float oldv, float v) {
    return __builtin_bit_cast(float, __builtin_amdgcn_update_dpp(__builtin_bit_cast(int, oldv), __builtin_bit_cast(int, v), 0x110 + S, 0xF, 0xF, false));
}
__device__ __forceinline__ void row_scan_ab(float& a, float& b) {
    { const float ap = dpp_shr<1>(1.0f, a), bp = dpp_shr<1>(0.0f, b); b = a * bp + b; a = a * ap; }
    { const float ap = dpp_shr<2>(1.0f, a), bp = dpp_shr<2>(0.0f, b); b = a * bp + b; a = a * ap; }
    { const float ap = dpp_shr<4>(1.0f, a), bp = dpp_shr<4>(0.0f, b); b = a * bp + b; a = a * ap; }
    { const float ap = dpp_shr<8>(1.0f, a), bp = dpp_shr<8>(0.0f, b); b = a * bp + b; a = a * ap; }
}

#define SCAN_STEP_(S) \
    "v_fmac_f32_dpp %0, %0, %4 row_shr:" #S " row_mask:0xf bank_mask:0xf\n\t" "v_fmac_f32_dpp %1, %1, %5 row_shr:" #S " row_mask:0xf bank_mask:0xf\n\t" \
    "v_fmac_f32_dpp %2, %2, %6 row_shr:" #S " row_mask:0xf bank_mask:0xf\n\t" "v_fmac_f32_dpp %3, %3, %7 row_shr:" #S " row_mask:0xf bank_mask:0xf\n\t" \
    "v_mul_f32_dpp %4, %4, %4 row_shr:" #S " row_mask:0xf bank_mask:0xf\n\t" "v_mul_f32_dpp %5, %5, %5 row_shr:" #S " row_mask:0xf bank_mask:0xf\n\t" \
    "v_mul_f32_dpp %6, %6, %6 row_shr:" #S " row_mask:0xf bank_mask:0xf\n\t" "v_mul_f32_dpp %7, %7, %7 row_shr:" #S " row_mask:0xf bank_mask:0xf\n\t"
__device__ __forceinline__ void row_scan_ab4(f32x4& a, f32x4& b) {
    float a0 = a[0], a1 = a[1], a2 = a[2], a3 = a[3], b0 = b[0], b1 = b[1], b2 = b[2], b3 = b[3];
    asm volatile("s_nop 1\n\t" SCAN_STEP_(1) SCAN_STEP_(2) SCAN_STEP_(4) SCAN_STEP_(8) "s_nop 0"
                 : "+v"(b0), "+v"(b1), "+v"(b2), "+v"(b3), "+v"(a0), "+v"(a1), "+v"(a2), "+v"(a3));
    a = (f32x4){a0, a1, a2, a3}; b = (f32x4){b0, b1, b2, b3};
}

#define XB_TMO      128
#define XB_XCNT(j)  (256  + 64 * (j))
#define XB_XSUB(j)  (1280 + 64 * (j))
#define XB_XGEN(j)  (2304 + 64 * (j))
#define XB_TOP      3328
#define XB_TOPGEN   3392
#define XCD_BAR_WORDS 3456
#define XB_SPIN_CAP (1u << 18)

__device__ __forceinline__ unsigned xb_ld(unsigned* p)              { return __hip_atomic_load(p, __ATOMIC_RELAXED, __HIP_MEMORY_SCOPE_AGENT); }
__device__ __forceinline__ unsigned xb_add(unsigned* p, unsigned v) { return __hip_atomic_fetch_add(p, v, __ATOMIC_RELAXED, __HIP_MEMORY_SCOPE_AGENT); }
__device__ __forceinline__ unsigned xb_xcc_id() { return (unsigned)__builtin_amdgcn_s_getreg((3 << 11) | 20) & 0xFu; }
#define XB_SPIN(cond, bar) do { unsigned _sp = 0; while (cond) { __builtin_amdgcn_s_sleep(1); \
    if ((++_sp & 255u) == 0u) { if (xb_ld(&(bar)[XB_TMO])) break; if (_sp > XB_SPIN_CAP) { atomicAdd(&(bar)[XB_TMO], 1u); break; } } } } while (0)

struct XcdBarrier {
    unsigned* bar; unsigned x;
    volatile LAS unsigned* st;
};

__device__ __forceinline__ XcdBarrier xcd_barrier_post(unsigned* bar, volatile LAS unsigned* st) {
    XcdBarrier b; b.bar = bar; b.x = xb_xcc_id(); b.st = st;
    if (threadIdx.x == 0) (void)xb_add(&bar[XB_XCNT(b.x)], 1u);
    return b;
}
__device__ __forceinline__ void xcd_barrier_complete(unsigned* bar, unsigned x, unsigned& nloc, unsigned& nx) {
    const unsigned G = gridDim.x * gridDim.y * gridDim.z;
    unsigned sum, cnt, mine, sp = 0u;
    for (;;) {
        sum = 0u; cnt = 0u; mine = 0u;
#pragma unroll
        for (unsigned j = 0; j < 16; ++j) { const unsigned c = xb_ld(&bar[XB_XCNT(j)]); sum += c; cnt += (c > 0u) ? 1u : 0u; mine = (j == x) ? c : mine; }
        if (sum == G) break;
        __builtin_amdgcn_s_sleep(1);
        if ((++sp & 255u) == 0u) { if (xb_ld(&bar[XB_TMO])) break; if (sp > XB_SPIN_CAP) { atomicAdd(&bar[XB_TMO], 1u); break; } }
    }
    nloc = mine > 0u ? mine : 1u; nx = cnt > 0u ? cnt : 1u;
}

__device__ __forceinline__ void xcd_barrier(const XcdBarrier& b) {
    asm volatile("s_waitcnt vmcnt(0)" ::: "memory");
    __syncthreads();
    if (threadIdx.x == 0) {
        unsigned* bar = b.bar;
        __builtin_amdgcn_s_waitcnt(0);
        unsigned nloc = b.st[0], nx = b.st[1];
        if (nloc == 0u) { xcd_barrier_complete(bar, b.x, nloc, nx); b.st[0] = nloc; b.st[1] = nx; }
        const unsigned old = xb_add(&bar[XB_XSUB(b.x)], 1u);
        const unsigned gen = old / nloc;
        if (old + 1u == (gen + 1u) * nloc) {
            __builtin_amdgcn_fence(__ATOMIC_RELEASE, "agent");
            asm volatile("s_waitcnt vmcnt(0)" ::: "memory");
            const unsigned og = xb_add(&bar[XB_TOP], 1u);
            const unsigned tg = og / nx;
            if (og + 1u == (tg + 1u) * nx) xb_add(&bar[XB_TOPGEN], 1u);
            else XB_SPIN(xb_ld(&bar[XB_TOPGEN]) == tg, bar);
            __builtin_amdgcn_fence(__ATOMIC_ACQUIRE, "agent");
            xb_add(&bar[XB_XGEN(b.x)], 1u);
            asm volatile("s_waitcnt vmcnt(0)" ::: "memory");
        } else {
            XB_SPIN(xb_ld(&bar[XB_XGEN(b.x)]) == gen, bar);
            __builtin_amdgcn_fence(__ATOMIC_ACQUIRE, "agent");
            asm volatile("s_waitcnt vmcnt(0)" ::: "memory");
        }
    }
    __syncthreads();
}
constexpr size_t WS_X1 = WS_Z;
static_assert(WS_X1 >= WS_Y + (size_t)M * DM * 2 && WS_X1 + (size_t)MP * DM * 2 <= WS_PART, "ws map (X1)");

struct Args { const float* in[26]; float* out; unsigned char* ws; int ph_lo, ph_hi, li, pad; };
struct Frame {
    LAS unsigned char* lds;
    volatile LAS unsigned* MISC;
    gu32* ctl;
    int tid, lane, wave, vcu, G;
    const Args* a;
    __device__ __forceinline__ const float* x_p() const { return a->in[0]; }
    __device__ __forceinline__ const float* x_s() const { return a->in[1]; }
    __device__ __forceinline__ const float* cache_k() const { return a->in[2]; }
    __device__ __forceinline__ const float* cache_v() const { return a->in[3]; }
    __device__ __forceinline__ const float* st_h() const { return a->in[4]; }
    __device__ __forceinline__ const float* st_conv() const { return a->in[5]; }
    __device__ __forceinline__ const float* st_ffn() const { return a->in[6]; }
    __device__ __forceinline__ const float* g_mix() const { return a->in[7]; }
    __device__ __forceinline__ const float* w_in() const { return a->in[8]; }
    __device__ __forceinline__ const float* cw() const { return a->in[9]; }
    __device__ __forceinline__ const float* cb() const { return a->in[10]; }
    __device__ __forceinline__ const float* w_a() const { return a->in[11]; }
    __device__ __forceinline__ const float* b_a() const { return a->in[12]; }
    __device__ __forceinline__ const float* w_x() const { return a->in[13]; }
    __device__ __forceinline__ const float* b_x() const { return a->in[14]; }
    __device__ __forceinline__ const float* lam() const { return a->in[15]; }
    __device__ __forceinline__ const float* qg() const { return a->in[16]; }
    __device__ __forceinline__ const float* kg() const { return a->in[17]; }
    __device__ __forceinline__ const float* g_lru() const { return a->in[18]; }
    __device__ __forceinline__ const float* g_sb() const { return a->in[19]; }
    __device__ __forceinline__ const float* w_out() const { return a->in[20]; }
    __device__ __forceinline__ const float* g_ffn() const { return a->in[21]; }
    __device__ __forceinline__ const float* w_up() const { return a->in[22]; }
    __device__ __forceinline__ const float* fcw() const { return a->in[23]; }
    __device__ __forceinline__ const float* fcb() const { return a->in[24]; }
    __device__ __forceinline__ const float* w_down() const { return a->in[25]; }
    __device__ __forceinline__ float* out() const { return a->out; }
    __device__ __forceinline__ bf16* Wa_t() const { return (bf16*)(a->ws + WS_WA); }
    __device__ __forceinline__ bf16* Wx_t() const { return (bf16*)(a->ws + WS_WX); }
    __device__ __forceinline__ bf16* Win_t() const { return (bf16*)(a->ws + WS_WIN); }
    __device__ __forceinline__ bf16* Wout_t() const { return (bf16*)(a->ws + WS_WOUT); }
    __device__ __forceinline__ bf16* Wup_t() const { return (bf16*)(a->ws + WS_WUP); }
    __device__ __forceinline__ bf16* Wdown_t() const { return (bf16*)(a->ws + WS_WDOWN); }
    __device__ __forceinline__ bf16* BUFA() const { return (bf16*)(a->ws + WS_BUFA); }
    __device__ __forceinline__ bf16* ACT() const { return (bf16*)(a->ws + WS_ACT); }
    __device__ __forceinline__ bf16* VALPRE() const { return (bf16*)(a->ws + WS_VALPRE); }
    __device__ __forceinline__ bf16* U() const { return (bf16*)(a->ws + WS_U); }
    __device__ __forceinline__ bf16* Gt() const { return (bf16*)(a->ws + WS_G); }
    __device__ __forceinline__ bf16* Qn() const { return (bf16*)(a->ws + WS_QN); }
    __device__ __forceinline__ bf16* Kn() const { return (bf16*)(a->ws + WS_KN); }
    __device__ __forceinline__ bf16* Vb() const { return (bf16*)(a->ws + WS_VB); }
    __device__ __forceinline__ bf16* Y() const { return (bf16*)(a->ws + WS_Y); }
    __device__ __forceinline__ float* AggA() const { return (float*)(a->ws + WS_AGGA); }
    __device__ __forceinline__ float* AggB() const { return (float*)(a->ws + WS_AGGB); }
    __device__ __forceinline__ float* C8() const { return (float*)(a->ws + WS_C8); }
    __device__ __forceinline__ float* Carry() const { return (float*)(a->ws + WS_CARRY); }
    __device__ __forceinline__ bf16* Z() const { return (bf16*)(a->ws + WS_Z); }
    __device__ __forceinline__ float* Part() const { return (float*)(a->ws + WS_PART); }
    __device__ __forceinline__ bf16* X1() const { return (bf16*)(a->ws + WS_X1); }
    __device__ __forceinline__ float* Halo() const { return (float*)(a->ws + WS_HALO); }
    __device__ __forceinline__ float* DefC() const { return (float*)(a->ws + WS_DEFC); }
    __device__ __forceinline__ float* DefV() const { return (float*)(a->ws + WS_DEFV); }
    __device__ __forceinline__ float* SsqS() const { return (float*)(a->ws + WS_SSQS); }
};

constexpr int TR_WAVE_BYTES = 64 * 65 * 4;
static_assert(NWAVES * TR_WAVE_BYTES <= RING_BYTES + EPI_BYTES, "transposer scratch");
template <bool NT = false> __device__ __forceinline__ void p0_transpose_item(const float* W, int K, int N, bf16* WT, int k0, int n0, int drow, LAS float* scr, int lane) {
    float tv[64];
#pragma unroll
    for (int i = 0; i < 64; ++i) tv[i] = __builtin_nontemporal_load(W + (size_t)(k0 + i) * N + n0 + lane);
#pragma unroll
    for (int i = 0; i < 64; ++i) scr[i * 65 + lane] = tv[i];
    LDS_WAIT(); asm volatile("" ::: "memory");
    const int c = lane & 7;
#pragma unroll
    for (int j = 0; j < 8; ++j) { const int n = (lane >> 3) + 8 * j; const LAS float* s = scr + (8 * c) * 65 + n;
        v4u o; o.x = cvt_pk_bf16(s[0 * 65], s[1 * 65]); o.y = cvt_pk_bf16(s[2 * 65], s[3 * 65]); o.z = cvt_pk_bf16(s[4 * 65], s[5 * 65]); o.w = cvt_pk_bf16(s[6 * 65], s[7 * 65]);
        if (NT) __builtin_nontemporal_store(o, (GAS v4u*)(WT + (size_t)(drow + n) * K + k0 + 8 * c)); else *(GAS v4u*)(WT + (size_t)(drow + n) * K + k0 + 8 * c) = o; }
    LDS_WAIT(); asm volatile("" ::: "memory");
}
#define TR_LOAD(tv, W, N, k0, n0) do { const float* _w = (W) + (size_t)(k0) * (N) + (n0) + lane; _Pragma("unroll") for (int i = 0; i < 64; ++i) tv[i] = __builtin_nontemporal_load(_w + (size_t)i * (N)); } while (0)
#define TR_FIN(tv, WT, K, k0, drow, NT) do { _Pragma("unroll") for (int i = 0; i < 64; ++i) scr[i * 65 + lane] = tv[i]; \
        LDS_WAIT(); asm volatile("" ::: "memory"); const int _c = lane & 7; \
        _Pragma("unroll") for (int j = 0; j < 8; ++j) { const int n = (lane >> 3) + 8 * j; const LAS float* sp = scr + (8 * _c) * 65 + n; \
            v4u o; o.x = cvt_pk_bf16(sp[0 * 65], sp[1 * 65]); o.y = cvt_pk_bf16(sp[2 * 65], sp[3 * 65]); o.z = cvt_pk_bf16(sp[4 * 65], sp[5 * 65]); o.w = cvt_pk_bf16(sp[6 * 65], sp[7 * 65]); \
            if (NT) __builtin_nontemporal_store(o, (GAS v4u*)((WT) + (size_t)((drow) + n) * (K) + (k0) + 8 * _c)); else *(GAS v4u*)((WT) + (size_t)((drow) + n) * (K) + (k0) + 8 * _c) = o; } \
        LDS_WAIT(); asm volatile("" ::: "memory"); } while (0)
#define TR_SB __builtin_amdgcn_sched_barrier(0)
__device__ __forceinline__ void rms_row_to_bf16(const float* xrow, const float* g, bf16* orow, int lane) {
    const GAS f32x4* xr = (const GAS f32x4*)xrow + lane;
    f32x4 v[16]; float s = 0.f;
#pragma unroll
    for (int j = 0; j < 16; ++j) { v[j] = __builtin_nontemporal_load(xr + 64 * j); s += (v[j].x * v[j].x + v[j].y * v[j].y) + (v[j].z * v[j].z + v[j].w * v[j].w); }
    const float rs = 1.0f / sqrtf(wave_sum(s) * (1.0f / DM) + EPS);
    const GAS f32x4* gr = (const GAS f32x4*)g + lane;
    GAS v2u* o8 = (GAS v2u*)orow + lane;
#pragma unroll
    for (int j = 0; j < 16; ++j) { const f32x4 gv = gr[64 * j]; v2u o; o.x = cvt_pk_bf16(v[j].x * rs * gv.x, v[j].y * rs * gv.y); o.y = cvt_pk_bf16(v[j].z * rs * gv.z, v[j].w * rs * gv.w); o8[64 * j] = o; }
}
__device__ __forceinline__ void rms_row_bf16_to_bf16(const bf16* xrow, const float* g, bf16* orow, int lane) {
    const GAS v4u* xr = (const GAS v4u*)xrow + lane;
    v4u v[8]; float s = 0.f;
#pragma unroll
    for (int j = 0; j < 8; ++j) { v[j] = __builtin_nontemporal_load(xr + 64 * j);
        const float a0 = bflo(v[j].x), a1 = bfhi(v[j].x), a2 = bflo(v[j].y), a3 = bfhi(v[j].y), a4 = bflo(v[j].z), a5 = bfhi(v[j].z), a6 = bflo(v[j].w), a7 = bfhi(v[j].w);
        s += ((a0 * a0 + a1 * a1) + (a2 * a2 + a3 * a3)) + ((a4 * a4 + a5 * a5) + (a6 * a6 + a7 * a7)); }
    const float rs = 1.0f / sqrtf(wave_sum(s) * (1.0f / DM) + EPS);
    const GAS f32x4* gr = (const GAS f32x4*)g + 2 * lane;
    GAS v4u* o8 = (GAS v4u*)orow + lane;
#pragma unroll
    for (int j = 0; j < 8; ++j) { const f32x4 g0 = gr[128 * j], g1 = gr[128 * j + 1]; v4u o;
        o.x = cvt_pk_bf16(bflo(v[j].x) * rs * g0.x, bfhi(v[j].x) * rs * g0.y); o.y = cvt_pk_bf16(bflo(v[j].y) * rs * g0.z, bfhi(v[j].y) * rs * g0.w);
        o.z = cvt_pk_bf16(bflo(v[j].z) * rs * g1.x, bfhi(v[j].z) * rs * g1.y); o.w = cvt_pk_bf16(bflo(v[j].w) * rs * g1.z, bfhi(v[j].w) * rs * g1.w); o8[64 * j] = o; }
}
__device__ __forceinline__ void sample_row_reduce(const float* base, const float* part, int rs, float* dst, const float* g, bf16* orow, int lane) {
    f32x4 v[16]; float s = 0.f;
#pragma unroll
    for (int j = 0; j < 16; ++j) v[j] = ((const GAS f32x4*)base)[lane + 64 * j];
#pragma unroll 2
    for (int ks = 0; ks < 8; ++ks) { const GAS f32x4* pr = (const GAS f32x4*)(part + ((size_t)ks * MS + rs) * DM) + lane;
#pragma unroll
        for (int j = 0; j < 16; ++j) v[j] = v[j] + pr[64 * j]; }
#pragma unroll
    for (int j = 0; j < 16; ++j) { ((GAS f32x4*)dst)[lane + 64 * j] = v[j]; s += (v[j].x * v[j].x + v[j].y * v[j].y) + (v[j].z * v[j].z + v[j].w * v[j].w); }
    if (orow) {
        const float rsn = 1.0f / sqrtf(wave_sum(s) * (1.0f / DM) + EPS);
        const GAS f32x4* gr = (const GAS f32x4*)g + lane; GAS v2u* o8 = (GAS v2u*)orow + lane;
#pragma unroll
        for (int j = 0; j < 16; ++j) { const f32x4 gv = gr[64 * j]; v2u o; o.x = cvt_pk_bf16(v[j].x * rsn * gv.x, v[j].y * rsn * gv.y); o.y = cvt_pk_bf16(v[j].z * rsn * gv.z, v[j].w * rsn * gv.w); o8[64 * j] = o; }
    }
}
__device__ __forceinline__ void hn_rows(Frame& F) {
    const int gw = F.vcu * NWAVES + F.wave, NGW = F.G * NWAVES, lane = F.lane, nfull = M / NGW;
    int m = gw;
    if (nfull >= 2 && (nfull & 1) == 0) {
        f32x4 va[16], vb[16];
        LAS f32x4* gl = (LAS f32x4*)(F.lds + RING_OFF + F.wave * TR_WAVE_BYTES) + lane;
#define HN_LOAD(v, mm) do { const int _m = (mm); const GAS f32x4* _x = (const GAS f32x4*)(_m < MP ? F.x_p() + (size_t)_m * DM : F.x_s() + (size_t)(_m - MP) * DM) + lane; \
        _Pragma("unroll") for (int j = 0; j < 16; ++j) v[j] = __builtin_nontemporal_load(_x + 64 * j); } while (0)
#define HN_FIN(v, mm) do { float _s = 0.f; _Pragma("unroll") for (int j = 0; j < 16; ++j) _s += (v[j].x * v[j].x + v[j].y * v[j].y) + (v[j].z * v[j].z + v[j].w * v[j].w); \
        const float _rs = 1.0f / sqrtf(wave_sum(_s) * (1.0f / DM) + EPS); GAS v2u* _o = (GAS v2u*)(F.BUFA() + (size_t)(mm) * DM) + lane; \
        LAS f32x4* _g = gl; asm volatile("" : "+v"(_g));     \
        _Pragma("unroll") for (int j = 0; j < 16; ++j) { const f32x4 g = _g[64 * j]; v2u o; o.x = cvt_pk_bf16(v[j].x * _rs * g.x, v[j].y * _rs * g.y); o.y = cvt_pk_bf16(v[j].z * _rs * g.z, v[j].w * _rs * g.w); _o[64 * j] = o; } } while (0)
        HN_LOAD(va, m); __builtin_amdgcn_sched_barrier(0);
        { const GAS f32x4* gr = (const GAS f32x4*)F.g_mix() + lane;
#pragma unroll
          for (int j = 0; j < 16; ++j) gl[64 * j] = gr[64 * j]; }
        LDS_WAIT(); asm volatile("" ::: "memory");
        for (int k = 0; k + 2 < nfull; k += 2) { HN_LOAD(vb, m + NGW); __builtin_amdgcn_sched_barrier(0); HN_FIN(va, m); __builtin_amdgcn_sched_barrier(0); HN_LOAD(va, m + 2 * NGW); __builtin_amdgcn_sched_barrier(0); HN_FIN(vb, m + NGW); __builtin_amdgcn_sched_barrier(0); m += 2 * NGW; }
        HN_LOAD(vb, m + NGW); __builtin_amdgcn_sched_barrier(0); HN_FIN(va, m); __builtin_amdgcn_sched_barrier(0); HN_FIN(vb, m + NGW); m += 2 * NGW;
#undef HN_LOAD
#undef HN_FIN
    }
    if (NGW == 2048 && m == nfull * NGW + gw) m = (F.wave < 2) ? nfull * NGW + F.wave * F.G + F.vcu : M;
    for (; m < M; m += NGW) rms_row_to_bf16(m < MP ? F.x_p() + (size_t)m * DM : F.x_s() + (size_t)(m - MP) * DM, F.g_mix(), F.BUFA() + (size_t)m * DM, lane);
}
__device__ __forceinline__ void hn2_rows(Frame& F) {
    const int gw = F.vcu * NWAVES + F.wave, NGW = F.G * NWAVES, lane = F.lane, nfull = MP / NGW;
    int m = gw;
    if (nfull >= 2 && (nfull & 1) == 0) {
        v4u va[8], vb[8];
        LAS f32x4* gl = (LAS f32x4*)(F.lds + RING_OFF + F.wave * TR_WAVE_BYTES);

#define H2_LOAD(v, mm) do { const GAS v4u* _x = (const GAS v4u*)(F.X1() + (size_t)(mm) * DM) + lane; _Pragma("unroll") for (int j = 0; j < 8; ++j) v[j] = __builtin_nontemporal_load(_x + 64 * j); } while (0)
#define H2_FIN(v, mm) do { float _s = 0.f; _Pragma("unroll") for (int j = 0; j < 8; ++j) { \
            const float a0 = bflo(v[j].x), a1 = bfhi(v[j].x), a2 = bflo(v[j].y), a3 = bfhi(v[j].y), a4 = bflo(v[j].z), a5 = bfhi(v[j].z), a6 = bflo(v[j].w), a7 = bfhi(v[j].w); \
            _s += ((a0 * a0 + a1 * a1) + (a2 * a2 + a3 * a3)) + ((a4 * a4 + a5 * a5) + (a6 * a6 + a7 * a7)); } \
        const float _rs = 1.0f / sqrtf(wave_sum(_s) * (1.0f / DM) + EPS); GAS v4u* _o = (GAS v4u*)(F.BUFA() + (size_t)(mm) * DM) + lane; \
        LAS f32x4* _g = gl; asm volatile("" : "+v"(_g)); \
        _Pragma("unroll") for (int j = 0; j < 8; ++j) { const f32x4 g0 = _g[128 * j], g1 = _g[128 * j + 1]; v4u o; \
            o.x = cvt_pk_bf16(bflo(v[j].x) * _rs * g0.x, bfhi(v[j].x) * _rs * g0.y); o.y = cvt_pk_bf16(bflo(v[j].y) * _rs * g0.z, bfhi(v[j].y) * _rs * g0.w); \
            o.z = cvt_pk_bf16(bflo(v[j].z) * _rs * g1.x, bfhi(v[j].z) * _rs * g1.y); o.w = cvt_pk_bf16(bflo(v[j].w) * _rs * g1.z, bfhi(v[j].w) * _rs * g1.w); _o[64 * j] = o; } } while (0)
        H2_LOAD(va, m); __builtin_amdgcn_sched_barrier(0);
        { const GAS f32x4* gr = (const GAS f32x4*)F.g_ffn() + lane;
#pragma unroll
          for (int j = 0; j < 16; ++j) gl[lane + 64 * j] = gr[64 * j]; }
        LDS_WAIT(); asm volatile("" ::: "memory");
        gl += 2 * lane;
        for (int k = 0; k + 2 < nfull; k += 2) { H2_LOAD(vb, m + NGW); __builtin_amdgcn_sched_barrier(0); H2_FIN(va, m); __builtin_amdgcn_sched_barrier(0); H2_LOAD(va, m + 2 * NGW); __builtin_amdgcn_sched_barrier(0); H2_FIN(vb, m + NGW); __builtin_amdgcn_sched_barrier(0); m += 2 * NGW; }
        H2_LOAD(vb, m + NGW); __builtin_amdgcn_sched_barrier(0); H2_FIN(va, m); __builtin_amdgcn_sched_barrier(0); H2_FIN(vb, m + NGW); m += 2 * NGW;
#undef H2_LOAD
#undef H2_FIN
    }
    for (; m < MP; m += NGW) rms_row_bf16_to_bf16(F.X1() + (size_t)m * DM, F.g_ffn(), F.BUFA() + (size_t)m * DM, lane);
}
__device__ __forceinline__ void p0_prologue(Frame& F) {
    LAS float* scr = (LAS float*)(F.lds + RING_OFF + F.wave * TR_WAVE_BYTES);
    const int gw = F.vcu * NWAVES + F.wave, NGW = F.G * NWAVES;
    constexpr int I_IN = (DM / 64) * (DIN / 64), I_G = NBLK * 3 * 3;
    constexpr int NITEMS = I_IN + 2 * I_G;
    int it0 = gw;
    if (4 * NGW <= I_IN) {
        const int lane = F.lane; constexpr int nb = DIN / 64; float ta[64], tb[64];
        const int i0 = gw, i1 = gw + NGW, i2 = gw + 2 * NGW, i3 = gw + 3 * NGW;
        TR_LOAD(ta, F.w_in(), DIN, 64 * (i0 / nb), 64 * (i0 % nb)); TR_SB;
        TR_LOAD(tb, F.w_in(), DIN, 64 * (i1 / nb), 64 * (i1 % nb)); TR_SB; TR_FIN(ta, F.Win_t(), DM, 64 * (i0 / nb), 64 * (i0 % nb), false); TR_SB;
        TR_LOAD(ta, F.w_in(), DIN, 64 * (i2 / nb), 64 * (i2 % nb)); TR_SB; TR_FIN(tb, F.Win_t(), DM, 64 * (i1 / nb), 64 * (i1 % nb), false); TR_SB;
        TR_LOAD(tb, F.w_in(), DIN, 64 * (i3 / nb), 64 * (i3 % nb)); TR_SB; TR_FIN(ta, F.Win_t(), DM, 64 * (i2 / nb), 64 * (i2 % nb), false); TR_SB;
        TR_FIN(tb, F.Win_t(), DM, 64 * (i3 / nb), 64 * (i3 % nb), false);
        it0 = gw + 4 * NGW;
    }
    for (int it = it0; it < NITEMS; it += NGW) {
        int r = it;
        if (r < I_IN) { const int nb = DIN / 64, kb = r / nb, n0 = 64 * (r % nb); p0_transpose_item(F.w_in(), DM, DIN, F.Win_t(), 64 * kb, n0, n0, scr, F.lane); continue; } r -= I_IN;
        { const int which = r / I_G; r -= which * I_G; const int blk = r / 9, q = r % 9, kb = q / 3, n0 = 64 * (q % 3);
          p0_transpose_item((which ? F.w_x() : F.w_a()) + (size_t)blk * BD * BD, BD, BD, (which ? F.Wx_t() : F.Wa_t()) + (size_t)blk * BD * BD, 64 * kb, n0, n0, scr, F.lane); }
    }
    if (gw < DLRU / 64) { const int ch = gw * 64 + F.lane; const float l = F.lam()[ch]; F.C8()[ch] = 8.0f * 1.4426950408889634f * (fminf(l, 0.f) - log1pf(expf(-fabsf(l)))); }
    hn_rows(F);
}

constexpr int NCONV = 16;
template <bool SECOND> __device__ __forceinline__ void conv_queue(Frame& F) {
    LAS float* scr = (LAS float*)(F.lds + RING_OFF + F.wave * TR_WAVE_BYTES);
    constexpr int I_OUT = (DM / 64) * (DM / 64), I_DN = (DFF / 64) * (DM / 64), I_UP = (DM / 64) * (2 * DFF / 64), I_DN1 = I_DN / 3, NIT = SECOND ? I_DN - I_DN1 : I_OUT + I_UP + I_DN1;
    for (;;) {
        int base = 0;
        if (F.lane == 0) base = (int)__hip_atomic_fetch_add((unsigned*)(F.ctl + (SECOND ? CW_Q2 : CW_Q1)), 4u, __ATOMIC_RELAXED, __HIP_MEMORY_SCOPE_AGENT);
        base = __builtin_amdgcn_readfirstlane(base);
        if (base >= NIT) break;
        for (int it = base; it < base + 4 && it < NIT; ++it) {
            int r = it;
            if (SECOND || r >= I_OUT + I_UP) { r = SECOND ? r + I_DN1 : r - (I_OUT + I_UP); const int nb = DM / 64, kb = r / nb, n0 = 64 * (r % nb); p0_transpose_item<true>(F.w_down(), DFF, DM, F.Wdown_t(), 64 * kb, n0, n0, scr, F.lane); continue; }
            if (r < I_OUT) { const int nb = DM / 64, kb = r / nb, n0 = 64 * (r % nb); p0_transpose_item<true>(F.w_out(), DM, DM, F.Wout_t(), 64 * kb, n0, n0, scr, F.lane); continue; } r -= I_OUT;
            { const int nb = 2 * DFF / 64, kb = r / nb, n0 = 64 * (r % nb);
              const int f = n0 < DFF ? n0 : n0 - DFF; const int drow = 256 * (f >> 7) + (n0 < DFF ? 0 : 128) + (f & 127);
              p0_transpose_item<true>(F.w_up(), DM, 2 * DFF, F.Wup_t(), 64 * kb, n0, drow, scr, F.lane); }
        }
    }
}

struct Epi1 {
    static constexpr bool PERM = true, AFTER_DRAIN = false;
    bf16 *U, *G, *Qn, *Kn, *Vb; float* out; const float *qg, *kg; LAS float* P;
    __device__ __forceinline__ void operator()(const f32x4 (&acc)[2][2][4][2], const pg8::Unit& u, int wr, int wc, int fr, int fq) const {
        const int pn = u.pn, row0 = u.pm * 256 + wr * 64 + fr, cw8 = wc * 32 + 8 * fq;
        if (pn < 24) {
            bf16* base = pn < 12 ? U : G; const int col0 = (pn < 12 ? pn : pn - 12) * 256 + cw8;
#pragma unroll
            for (int ai = 0; ai < 2; ++ai)
#pragma unroll
                for (int m = 0; m < 4; ++m) { const int row = row0 + ai * 128 + m * 16; bf16* rowp = base + (size_t)row * DLRU + col0;
#pragma unroll
                    for (int bj = 0; bj < 2; ++bj) { const f32x4 v0 = acc[ai][bj][m][0], v1 = acc[ai][bj][m][1];
                        v4u w; w.x = cvt_pk_bf16(v0[0], v0[1]); w.y = cvt_pk_bf16(v0[2], v0[3]); w.z = cvt_pk_bf16(v1[0], v1[1]); w.w = cvt_pk_bf16(v1[2], v1[3]);
                        *(v4u*)(rowp + bj * 128) = w; }
                    if (pn < 12) {
                        float* cdst = nullptr;
                        if (row < MP) { if (row >= MP - 3) cdst = out + O_CP + (size_t)(row - (MP - 3)) * DLRU; }
                        else { const int t = (row - MP) & 31, b = (row - MP) >> 5; if (t >= 29) cdst = out + O_CS + (size_t)(b * 3 + (t - 29)) * DLRU; }
                        if (cdst) {
#pragma unroll
                            for (int bj = 0; bj < 2; ++bj) { *(f32x4*)(cdst + col0 + bj * 128) = acc[ai][bj][m][0]; *(f32x4*)(cdst + col0 + bj * 128 + 4) = acc[ai][bj][m][1]; } }
                    } }
        } else if (pn < 32) {
            const bool isk = pn >= 28; const float* gp = isk ? kg : qg;
#pragma unroll
            for (int ai = 0; ai < 2; ++ai)
#pragma unroll
                for (int m = 0; m < 4; ++m)
#pragma unroll
                    for (int bj = 0; bj < 2; ++bj) { const f32x4 v0 = acc[ai][bj][m][0], v1 = acc[ai][bj][m][1];
                        float s = (v0[0] * v0[0] + v0[1] * v0[1]) + (v0[2] * v0[2] + v0[3] * v0[3]) + (v1[0] * v1[0] + v1[1] * v1[1]) + (v1[2] * v1[2] + v1[3] * v1[3]);
                        s += __shfl_xor(s, 16); s += __shfl_xor(s, 32);
                        if (fq == 0) P[((ai * 128 + wr * 64 + m * 16 + fr) * 2 + bj) * 4 + wc] = s; }
            WG_BAR();
            const f32x4 g0 = *(const f32x4*)(gp + cw8), g1 = *(const f32x4*)(gp + cw8 + 4);
            bf16* base = isk ? Kn : Qn; const int col0 = (pn - (isk ? 28 : 24)) * 256 + cw8;
#pragma unroll
            for (int ai = 0; ai < 2; ++ai)
#pragma unroll
                for (int m = 0; m < 4; ++m) { const int row = row0 + ai * 128 + m * 16; bf16* rowp = base + (size_t)row * DSB + col0;
                    float* kdst = isk ? (row < MP ? out + O_KP + (size_t)row * DSB : out + O_KS + (size_t)(row - MP) * DSB) + col0 : nullptr;
#pragma unroll
                    for (int bj = 0; bj < 2; ++bj) { const f32x4 p = *(const LAS f32x4*)(P + ((ai * 128 + wr * 64 + m * 16 + fr) * 2 + bj) * 4);
                        const float sc = 1.0f / sqrtf(((p[0] + p[1]) + (p[2] + p[3])) * (1.0f / HD) + EPS);
                        const f32x4 v0 = acc[ai][bj][m][0] * sc * g0, v1 = acc[ai][bj][m][1] * sc * g1;
                        v4u w; w.x = cvt_pk_bf16(v0[0], v0[1]); w.y = cvt_pk_bf16(v0[2], v0[3]); w.z = cvt_pk_bf16(v1[0], v1[1]); w.w = cvt_pk_bf16(v1[2], v1[3]);
                        *(v4u*)(rowp + bj * 128) = w;
                        if (isk) { __builtin_nontemporal_store(v0, (f32x4*)(kdst + bj * 128)); __builtin_nontemporal_store(v1, (f32x4*)(kdst + bj * 128 + 4)); } } }
        } else {
            const int col0 = (pn - 32) * 256 + cw8;
#pragma unroll
            for (int ai = 0; ai < 2; ++ai)
#pragma unroll
                for (int m = 0; m < 4; ++m) { const int row = row0 + ai * 128 + m * 16; bf16* rowp = Vb + (size_t)row * DSB + col0;
                    float* vdst = (row < MP ? out + O_VP + (size_t)row * DSB : out + O_VS + (size_t)(row - MP) * DSB) + col0;
#pragma unroll
                    for (int bj = 0; bj < 2; ++bj) { const f32x4 v0 = acc[ai][bj][m][0], v1 = acc[ai][bj][m][1];
                        v4u w; w.x = cvt_pk_bf16(v0[0], v0[1]); w.y = cvt_pk_bf16(v0[2], v0[3]); w.z = cvt_pk_bf16(v1[0], v1[1]); w.w = cvt_pk_bf16(v1[2], v1[3]);
                        *(v4u*)(rowp + bj * 128) = w; __builtin_nontemporal_store(v0, (f32x4*)(vdst + bj * 128)); __builtin_nontemporal_store(v1, (f32x4*)(vdst + bj * 128 + 4)); } }
        }
    }
};
template <int SECOND>
struct EpiRes {
    static constexpr bool PERM = true, AFTER_DRAIN = false;
    const float* xp; bf16* x1; float* out; float* part;
    __device__ __forceinline__ void operator()(const f32x4 (&acc)[2][2][4][2], const pg8::Unit& u, int wr, int wc, int fr, int fq) const {
        const int row0 = u.pm * 256 + wr * 64 + fr, col0 = u.pn * 256 + wc * 32 + 8 * fq;
        if (u.ks >= 0) {
#pragma unroll
            for (int ai = 0; ai < 2; ++ai)
#pragma unroll
                for (int m = 0; m < 4; ++m) { const int row = row0 + ai * 128 + m * 16; float* op = part + ((size_t)u.ks * MS + (row - MP)) * DM + col0;
#pragma unroll
                    for (int bj = 0; bj < 2; ++bj)
#pragma unroll
                        for (int n = 0; n < 2; ++n) *(f32x4*)(op + bj * 128 + n * 4) = acc[ai][bj][m][n]; }
            return;
        }
        if constexpr (SECOND == 0) {
#pragma unroll
            for (int ai = 0; ai < 2; ++ai) {
                f32x4 b[4][2][2];
#pragma unroll
                for (int m = 0; m < 4; ++m) { const float* bp = xp + (size_t)(row0 + ai * 128 + m * 16) * DM + col0;
#pragma unroll
                    for (int bj = 0; bj < 2; ++bj)
#pragma unroll
                        for (int n = 0; n < 2; ++n) b[m][bj][n] = *(const f32x4*)(bp + bj * 128 + n * 4); }
#pragma unroll
                for (int m = 0; m < 4; ++m) { bf16* op = x1 + (size_t)(row0 + ai * 128 + m * 16) * DM + col0;
#pragma unroll
                    for (int bj = 0; bj < 2; ++bj) { const f32x4 lo = b[m][bj][0] + acc[ai][bj][m][0], hi = b[m][bj][1] + acc[ai][bj][m][1];
                        v4u o; o.x = cvt_pk_bf16(lo.x, lo.y); o.y = cvt_pk_bf16(lo.z, lo.w); o.z = cvt_pk_bf16(hi.x, hi.y); o.w = cvt_pk_bf16(hi.z, hi.w); *(v4u*)(op + bj * 128) = o; } }
            }
        } else {
            v4u b[2][4][2];
#pragma unroll
            for (int ai = 0; ai < 2; ++ai)
#pragma unroll
                for (int m = 0; m < 4; ++m) { const bf16* bp = x1 + (size_t)(row0 + ai * 128 + m * 16) * DM + col0;
#pragma unroll
                    for (int bj = 0; bj < 2; ++bj) b[ai][m][bj] = __builtin_nontemporal_load((const v4u*)(bp + bj * 128)); }
#pragma unroll
            for (int ai = 0; ai < 2; ++ai)
#pragma unroll
                for (int m = 0; m < 4; ++m) { float* op = out + O_Y + (size_t)(row0 + ai * 128 + m * 16) * DM + col0;
#pragma unroll
                    for (int bj = 0; bj < 2; ++bj) { const v4u w = b[ai][m][bj];
                        const f32x4 lo = {bflo(w.x), bfhi(w.x), bflo(w.y), bfhi(w.y)}, hi = {bflo(w.z), bfhi(w.z), bflo(w.w), bfhi(w.w)};
                        *(f32x4*)(op + bj * 128) = lo + acc[ai][bj][m][0]; *(f32x4*)(op + bj * 128 + 4) = hi + acc[ai][bj][m][1]; } }
        }
    }
};
struct EpiUp {
    static constexpr bool PERM = true, AFTER_DRAIN = false;
    bf16* ACT; const float *fcw, *fcb, *st_ffn; float* out; float *halo, *defc, *defv; LAS float* HX;
    template <bool SMP> __device__ __forceinline__ void body(const f32x4 (&acc)[2][2][4][2], const pg8::Unit& u, int wr, int wc, int fr, int fq) const {
        const int pm = u.pm, cl = wc * 32 + 8 * fq, f0 = u.pn * 128 + cl;
        const f32x4 w0a = *(const f32x4*)(fcw + f0), w0b = *(const f32x4*)(fcw + f0 + 4), w1a = *(const f32x4*)(fcw + DFF + f0), w1b = *(const f32x4*)(fcw + DFF + f0 + 4);
        const f32x4 w2a = *(const f32x4*)(fcw + 2 * DFF + f0), w2b = *(const f32x4*)(fcw + 2 * DFF + f0 + 4), cba = *(const f32x4*)(fcb + f0), cbb = *(const f32x4*)(fcb + f0 + 4);
        if (!SMP && fr >= 14) {
#pragma unroll
            for (int ai = 0; ai < 2; ++ai) { LAS f32x4* hp = (LAS f32x4*)(HX + (((ai * 2 + wr) * 2 + (fr - 14)) * 128 + cl)); hp[0] = acc[ai][1][3][0]; hp[1] = acc[ai][1][3][1]; }
            if (wr == 1) { float* hd = (pm == MP / 256 - 1) ? out + O_FP + (size_t)(fr - 14) * DFF + f0 : halo + ((size_t)pm * 2 + (fr - 14)) * DFF + f0;
                *(f32x4*)hd = acc[1][1][3][0]; *(f32x4*)(hd + 4) = acc[1][1][3][1]; }
        }
        if (!SMP) WG_BAR();
        f32x4 R1pa, R1pb, R2pa, R2pb;
#pragma unroll
        for (int ai = 0; ai < 2; ++ai) {
#pragma unroll
            for (int m = 0; m < 4; ++m) {
                const int row = pm * 256 + ai * 128 + wr * 64 + m * 16 + fr;
                const f32x4 Pa = acc[ai][1][m][0], Pb = acc[ai][1][m][1], Va = acc[ai][0][m][0], Vb = acc[ai][0][m][1];
                f32x4 R1a, R1b, R2a, R2b;
#pragma unroll
                for (int j = 0; j < 4; ++j) { R1a[j] = dpp_ror<1>(Pa[j]); R1b[j] = dpp_ror<1>(Pb[j]); R2a[j] = dpp_ror<2>(Pa[j]); R2b[j] = dpp_ror<2>(Pb[j]); }
                if (m == 0 || (SMP && m == 2)) {
                    f32x4 B1a, B1b, B2a, B2b;
                    if (SMP) { const int b = (row - MP) >> 5; const float* s0 = st_ffn + (size_t)(b * 2) * DFF + f0; const float* s1 = s0 + DFF;
                        B2a = *(const f32x4*)s0; B2b = *(const f32x4*)(s0 + 4); B1a = *(const f32x4*)s1; B1b = *(const f32x4*)(s1 + 4);
                    } else if (ai == 0 && wr == 0) { B1a = B1b = B2a = B2b = (f32x4){0.f, 0.f, 0.f, 0.f};
                    } else { const int pg = ai * 2 + wr - 1; const LAS f32x4* h2 = (const LAS f32x4*)(HX + ((pg * 2 + 0) * 128 + cl)); const LAS f32x4* h1 = (const LAS f32x4*)(HX + ((pg * 2 + 1) * 128 + cl));
                        B2a = h2[0]; B2b = h2[1]; B1a = h1[0]; B1b = h1[1]; }
                    R1pa = B1a; R1pb = B1b; R2pa = (fr == 0) ? B2a : B1a; R2pb = (fr == 0) ? B2b : B1b;
                }
                const f32x4 p1a = (fr >= 1) ? R1a : R1pa, p1b = (fr >= 1) ? R1b : R1pb, p2a = (fr >= 2) ? R2a : R2pa, p2b = (fr >= 2) ? R2b : R2pb;
                const f32x4 ca = cba + (w0a * p2a + w1a * p1a) + w2a * Pa, cbv = cbb + (w0b * p2b + w1b * p1b) + w2b * Pb;
                f32x4 oa, ob;
                { const f32x2 g0 = gelu_tanh2((f32x2){ca[0], ca[1]}) * (f32x2){Va[0], Va[1]}, g1 = gelu_tanh2((f32x2){ca[2], ca[3]}) * (f32x2){Va[2], Va[3]};
                  const f32x2 g2 = gelu_tanh2((f32x2){cbv[0], cbv[1]}) * (f32x2){Vb[0], Vb[1]}, g3 = gelu_tanh2((f32x2){cbv[2], cbv[3]}) * (f32x2){Vb[2], Vb[3]};
                  oa = (f32x4){g0.x, g0.y, g1.x, g1.y}; ob = (f32x4){g2.x, g2.y, g3.x, g3.y}; }
                v4u q; q.x = cvt_pk_bf16(oa[0], oa[1]); q.y = cvt_pk_bf16(oa[2], oa[3]); q.z = cvt_pk_bf16(ob[0], ob[1]); q.w = cvt_pk_bf16(ob[2], ob[3]);
                *(v4u*)(ACT + (size_t)row * DFF + f0) = q;
                if (m == 0 && ai == 0) { if (!SMP && pm >= 1 && wr == 0 && fr < 2) { float* dc = defc + ((size_t)pm * 2 + fr) * DFF + f0; float* dv = defv + ((size_t)pm * 2 + fr) * DFF + f0;
                        *(f32x4*)dc = ca; *(f32x4*)(dc + 4) = cbv; *(f32x4*)dv = Va; *(f32x4*)(dv + 4) = Vb; } }
                if ((m & 1) && SMP && fr >= 14) { float* fd = out + O_FS + (size_t)(((row - MP) >> 5) * 2 + (fr - 14)) * DFF + f0; *(f32x4*)fd = Pa; *(f32x4*)(fd + 4) = Pb; }
                R1pa = R1a; R1pb = R1b; R2pa = R2a; R2pb = R2b;
            }
        }
    }
    __device__ __forceinline__ void operator()(const f32x4 (&acc)[2][2][4][2], const pg8::Unit& u, int wr, int wc, int fr, int fq) const {
        if (u.pm >= MP / 256) body<true>(acc, u, wr, wc, fr, fq); else body<false>(acc, u, wr, wc, fr, fq);
    }
};
struct EpiBf {
    static constexpr bool PERM = true, AFTER_DRAIN = false;
    bf16* O; int ldc;
    __device__ __forceinline__ void operator()(const f32x4 (&acc)[2][2][4][2], const pg8::Unit& u, int wr, int wc, int fr, int fq) const {
        const int row0 = u.pm * 256 + wr * 64 + fr, col0 = u.pn * 256 + wc * 32 + 8 * fq;
#pragma unroll
        for (int ai = 0; ai < 2; ++ai)
#pragma unroll
            for (int m = 0; m < 4; ++m) { bf16* rowp = O + (size_t)(row0 + ai * 128 + m * 16) * ldc + col0;
#pragma unroll
                for (int bj = 0; bj < 2; ++bj) { const f32x4 v0 = acc[ai][bj][m][0], v1 = acc[ai][bj][m][1];
                    v4u w; w.x = cvt_pk_bf16(v0[0], v0[1]); w.y = cvt_pk_bf16(v0[2], v0[3]); w.z = cvt_pk_bf16(v1[0], v1[1]); w.w = cvt_pk_bf16(v1[2], v1[3]);
                    *(v4u*)(rowp + bj * 128) = w; } }
    }
};

constexpr int UC_LD = 196;
constexpr int UC_TEAM_BYTES = 64 * UC_LD * 4;
static_assert(2 * UC_TEAM_BYTES <= RING_BYTES, "lru lds");
__device__ __forceinline__ void team_bar(LAS unsigned* cnt, unsigned& phase, int lane) {
    asm volatile("s_waitcnt lgkmcnt(0)" ::: "memory");
    ++phase;
    if (lane == 0) __hip_atomic_fetch_add(cnt, 1u, __ATOMIC_RELAXED, __HIP_MEMORY_SCOPE_WORKGROUP);
    while (__hip_atomic_load(cnt, __ATOMIC_RELAXED, __HIP_MEMORY_SCOPE_WORKGROUP) < 4u * phase) __builtin_amdgcn_s_sleep(1);
    asm volatile("" ::: "memory");
}
__device__ __forceinline__ void lru_unit(Frame& F, int chunk, int blk, LAS unsigned* tcnt, unsigned& tphase) {
    const int lane = F.lane, w = F.wave, fr = lane & 15, fq = lane >> 4, team = w >> 2, ttid = F.tid & 255;
    LAS float* UC = (LAS float*)(F.lds + RING_OFF + team * UC_TEAM_BYTES);
    const bool smp = chunk >= 256;
    const int row0 = smp ? MP + 64 * (chunk - 256) : 64 * chunk;
    const int chb = 192 * blk;
    const int cg = w & 3, cwl = 48 * cg;
    team_bar(tcnt, tphase, lane);
    if (ttid < 192) {
        const int cgp = ttid % 24, tg = ttid / 24, ch = chb + 8 * cgp, tok0 = 8 * tg;
        float wv[4][8], bv[8], xw[3][8];
#pragma unroll
        for (int k = 0; k < 4; ++k) { const f32x4 a = *(const f32x4*)(F.cw() + k * DLRU + ch), b = *(const f32x4*)(F.cw() + k * DLRU + ch + 4);
            wv[k][0] = a[0]; wv[k][1] = a[1]; wv[k][2] = a[2]; wv[k][3] = a[3]; wv[k][4] = b[0]; wv[k][5] = b[1]; wv[k][6] = b[2]; wv[k][7] = b[3]; }
        { const f32x4 a = *(const f32x4*)(F.cb() + ch), b = *(const f32x4*)(F.cb() + ch + 4); bv[0] = a[0]; bv[1] = a[1]; bv[2] = a[2]; bv[3] = a[3]; bv[4] = b[0]; bv[5] = b[1]; bv[6] = b[2]; bv[7] = b[3]; }
        const int r0 = row0 + tok0;
        const bool from_state = smp && ((tok0 & 31) == 0), zero_prev = (!smp) && (r0 == 0);
#pragma unroll
        for (int d = 0; d < 3; ++d) {
            if (zero_prev) {
#pragma unroll
                for (int e = 0; e < 8; ++e) xw[d][e] = 0.f;
            } else if (from_state) { const int b = (r0 - MP) >> 5; const float* sp = F.st_conv() + (size_t)(b * 3 + d) * DLRU + ch; const f32x4 a = *(const f32x4*)sp, c = *(const f32x4*)(sp + 4);
                xw[d][0] = a[0]; xw[d][1] = a[1]; xw[d][2] = a[2]; xw[d][3] = a[3]; xw[d][4] = c[0]; xw[d][5] = c[1]; xw[d][6] = c[2]; xw[d][7] = c[3];
            } else { const v4u q = *(const v4u*)(F.U() + (size_t)(r0 - 3 + d) * DLRU + ch);
                xw[d][0] = bflo(q.x); xw[d][1] = bfhi(q.x); xw[d][2] = bflo(q.y); xw[d][3] = bfhi(q.y); xw[d][4] = bflo(q.z); xw[d][5] = bfhi(q.z); xw[d][6] = bflo(q.w); xw[d][7] = bfhi(q.w); }
        }
#pragma unroll
        for (int t = 0; t < 8; ++t) {
            const v4u q = *(const v4u*)(F.U() + (size_t)(r0 + t) * DLRU + ch);
            float xc[8]; xc[0] = bflo(q.x); xc[1] = bfhi(q.x); xc[2] = bflo(q.y); xc[3] = bfhi(q.y); xc[4] = bflo(q.z); xc[5] = bfhi(q.z); xc[6] = bflo(q.w); xc[7] = bfhi(q.w);
            float o[8];
#pragma unroll
            for (int e = 0; e < 8; ++e) o[e] = bv[e] + ((wv[0][e] * xw[0][e] + wv[1][e] * xw[1][e]) + (wv[2][e] * xw[2][e] + wv[3][e] * xc[e]));
            LAS f32x4* dst = (LAS f32x4*)(UC + (tok0 + t) * UC_LD + 8 * cgp);
            dst[0] = (f32x4){o[0], o[1], o[2], o[3]}; dst[1] = (f32x4){o[4], o[5], o[6], o[7]};
#pragma unroll
            for (int e = 0; e < 8; ++e) { xw[0][e] = xw[1][e]; xw[1][e] = xw[2][e]; xw[2][e] = xc[e]; }
        }
    }
    team_bar(tcnt, tphase, lane);
    f32x4 pba[3], pbx[3], pc8[3]; v2u gq[3];
#pragma unroll
    for (int ct = 0; ct < 3; ++ct) { const int chg = chb + cwl + 16 * ct + 4 * fq;
        pba[ct] = *(const f32x4*)(F.b_a() + chg); pbx[ct] = *(const f32x4*)(F.b_x() + chg); pc8[ct] = *(const f32x4*)(F.C8() + chg);
        gq[ct] = *(const v2u*)(F.Gt() + (size_t)(row0 + fr) * DLRU + chg); }
    f32x4 accA[4][3], accX[4][3];
#pragma unroll
    for (int tt = 0; tt < 4; ++tt)
#pragma unroll
        for (int ct = 0; ct < 3; ++ct) { accA[tt][ct] = (f32x4){0.f, 0.f, 0.f, 0.f}; accX[tt][ct] = (f32x4){0.f, 0.f, 0.f, 0.f}; }
    const bf16* wa_base = F.Wa_t() + (size_t)blk * BD * BD + (size_t)(48 * cg + fr) * BD + 8 * fq;
    const bf16* wx_base = F.Wx_t() + (size_t)blk * BD * BD + (size_t)(48 * cg + fr) * BD + 8 * fq;
#pragma unroll 1
    for (int kb = 0; kb < 3; ++kb) {
        bf16x8 fa[2][3], fx[2][3];
#pragma unroll
        for (int kk = 0; kk < 2; ++kk)
#pragma unroll
            for (int ct = 0; ct < 3; ++ct) {
                fa[kk][ct] = __builtin_bit_cast(bf16x8, *(const v4u*)(wa_base + (size_t)(16 * ct) * BD + 32 * (2 * kb + kk)));
                fx[kk][ct] = __builtin_bit_cast(bf16x8, *(const v4u*)(wx_base + (size_t)(16 * ct) * BD + 32 * (2 * kb + kk))); }
#pragma unroll
        for (int kk = 0; kk < 2; ++kk) {
            const int ks = 2 * kb + kk;
            bf16x8 uf[4];
#pragma unroll
            for (int tt = 0; tt < 4; ++tt) { const LAS f32x4* s = (const LAS f32x4*)(UC + (16 * tt + fr) * UC_LD + 32 * ks + 8 * fq); const f32x4 a = s[0], b = s[1];
                v4u p; p.x = cvt_pk_bf16(a[0], a[1]); p.y = cvt_pk_bf16(a[2], a[3]); p.z = cvt_pk_bf16(b[0], b[1]); p.w = cvt_pk_bf16(b[2], b[3]); uf[tt] = __builtin_bit_cast(bf16x8, p); }
#pragma unroll
            for (int ct = 0; ct < 3; ++ct)
#pragma unroll
                for (int tt = 0; tt < 4; ++tt) { accA[tt][ct] = __builtin_amdgcn_mfma_f32_16x16x32_bf16(fa[kk][ct], uf[tt], accA[tt][ct], 0, 0, 0);
                                                 accX[tt][ct] = __builtin_amdgcn_mfma_f32_16x16x32_bf16(fx[kk][ct], uf[tt], accX[tt][ct], 0, 0, 0); }
        }
    }
    f32x4 carry[3], acar[3];
#pragma unroll
    for (int ct = 0; ct < 3; ++ct) { acar[ct] = (f32x4){1.f, 1.f, 1.f, 1.f};
        carry[ct] = smp ? *(const f32x4*)(F.st_h() + (size_t)(2 * (chunk - 256)) * DLRU + chb + cwl + 16 * ct + 4 * fq) : (f32x4){0.f, 0.f, 0.f, 0.f}; }
#pragma unroll
    for (int tt = 0; tt < 4; ++tt) {
        if (smp && tt == 2) {
#pragma unroll
            for (int ct = 0; ct < 3; ++ct) { acar[ct] = (f32x4){1.f, 1.f, 1.f, 1.f}; carry[ct] = *(const f32x4*)(F.st_h() + (size_t)(2 * (chunk - 256) + 1) * DLRU + chb + cwl + 16 * ct + 4 * fq); } }
        const int row = row0 + 16 * tt + fr;
        v2u gqn[3];
#pragma unroll
        for (int ct = 0; ct < 3; ++ct) gqn[ct] = (tt < 3) ? *(const v2u*)(F.Gt() + (size_t)(row + 16) * DLRU + chb + cwl + 16 * ct + 4 * fq) : (v2u){0u, 0u};
#pragma unroll
        for (int ct = 0; ct < 3; ++ct) {
            const int chg = chb + cwl + 16 * ct + 4 * fq;
            const f32x4 ba = pba[ct], bx = pbx[ct], c8 = pc8[ct];
            const f32x4 uc = *(const LAS f32x4*)(UC + (16 * tt + fr) * UC_LD + cwl + 16 * ct + 4 * fq);
            f32x4 av, bv;
#pragma unroll
            for (int p = 0; p < 2; ++p) {
                const f32x2 rg = sigmoid2((f32x2){accA[tt][ct][2 * p], accA[tt][ct][2 * p + 1]} + (f32x2){ba[2 * p], ba[2 * p + 1]});
                const f32x2 ig = sigmoid2((f32x2){accX[tt][ct][2 * p], accX[tt][ct][2 * p + 1]} + (f32x2){bx[2 * p], bx[2 * p + 1]});
                const f32x2 la2 = (f32x2){c8[2 * p], c8[2 * p + 1]} * rg;
                f32x2 a; a.x = fexp2(la2.x); a.y = fexp2(la2.y);
                const f32x2 x = la2 * (2.0f * 0.6931471805599453f);
                f32x2 omp = (x * (-1.0f)) * (1.0f + x * (0.5f + x * (0.16666667f + x * (0.041666668f + x * (0.008333334f + x * 0.0013888889f))))), omq = 1.0f - a * a;
                asm("" : "+v"(omp), "+v"(omq));
                f32x2 sq; sq.x = __builtin_amdgcn_sqrtf(x.x > -0.25f ? omp.x : omq.x); sq.y = __builtin_amdgcn_sqrtf(x.y > -0.25f ? omp.y : omq.y);
                const f32x2 b = sq * ig * (f32x2){uc[2 * p], uc[2 * p + 1]};
                av[2 * p] = a.x; av[2 * p + 1] = a.y; bv[2 * p] = b.x; bv[2 * p + 1] = b.y;
            }
            row_scan_ab4(av, bv);
            const f32x4 h = bv + av * carry[ct];
            const f32x4 hA = av * acar[ct];
            f32x4 ge; { const f32x2 g0 = gelu_tanh2((f32x2){bflo(gq[ct].x), bfhi(gq[ct].x)}), g1 = gelu_tanh2((f32x2){bflo(gq[ct].y), bfhi(gq[ct].y)}); ge = (f32x4){g0.x, g0.y, g1.x, g1.y}; }
            const f32x4 y = h * ge;
            v2u o; o.x = cvt_pk_bf16(y[0], y[1]); o.y = cvt_pk_bf16(y[2], y[3]);
            *(v2u*)(F.Y() + (size_t)row * DM + chg) = o;
            if (!smp) { const f32x4 z = hA * ge; v2u oz; oz.x = cvt_pk_bf16(z[0], z[1]); oz.y = cvt_pk_bf16(z[2], z[3]); *(v2u*)(F.Z() + (size_t)row * DLRU + chg) = oz;
                if (tt == 3 && fr == 15) { *(f32x4*)(F.AggA() + (size_t)chunk * DLRU + chg) = hA; *(f32x4*)(F.AggB() + (size_t)chunk * DLRU + chg) = h; } }
            else if (((row - MP) & 31) == 31) *(f32x4*)(F.out() + O_HS + (size_t)((row - MP) >> 5) * DLRU + chg) = h;
#pragma unroll
            for (int r = 0; r < 4; ++r) { carry[ct][r] = __shfl(h[r], (lane & 48) | 15); acar[ct][r] = __shfl(hA[r], (lane & 48) | 15); }
        }
#pragma unroll
        for (int ct = 0; ct < 3; ++ct) gq[ct] = gqn[ct];
        __builtin_amdgcn_sched_barrier(0);
    }
}
__device__ __forceinline__ void lru_prefix(Frame& F) {
    const int gw = F.vcu * NWAVES + F.wave, NGW = F.G * NWAVES, fr = F.lane & 15, fq = F.lane >> 4;
    for (int item = gw; item < DLRU / 16; item += NGW) {
        const int chg = 16 * item + 4 * fq;
        f32x4 la[16], lb[16];
#pragma unroll
        for (int i = 0; i < 16; ++i) { la[i] = *(const f32x4*)(F.AggA() + (size_t)(16 * fr + i) * DLRU + chg); lb[i] = *(const f32x4*)(F.AggB() + (size_t)(16 * fr + i) * DLRU + chg); }
        f32x4 PA = la[0], PB = lb[0];
#pragma unroll
        for (int i = 1; i < 16; ++i) { PB = la[i] * PB + lb[i]; PA = la[i] * PA; }
        f32x4 h;
#pragma unroll
        for (int r = 0; r < 4; ++r) { float a = PA[r], b = PB[r]; row_scan_ab(a, b); h[r] = dpp_shr<1>(0.0f, b); }
#pragma unroll
        for (int i = 0; i < 16; ++i) { *(f32x4*)(F.Carry() + (size_t)(16 * fr + i) * DLRU + chg) = h; h = la[i] * h + lb[i]; }
        if (fr == 15) *(f32x4*)(F.out() + O_HP + chg) = h;
    }
}

constexpr int KS_LD = 272, KS_OFF = 0, VT_OFF = 128 * KS_LD, WM_OFF = 2 * 128 * KS_LD;
constexpr float ATT_SC = 0.12751743082459868f;
constexpr float ATT_STOP = -160.0f;
__device__ __forceinline__ int vt_pos(int k) { return (k & ~31) | (((k >> 2) & 3) << 3) | (((k >> 4) & 1) << 2) | (k & 3); }
__device__ __forceinline__ void vt_store(LAS unsigned char* VT, int key, int dc, const v4u q) {
    LAS unsigned short* vp = (LAS unsigned short*)(VT + (8 * dc) * KS_LD + 2 * vt_pos(key));
    vp[0 * (KS_LD / 2)] = (unsigned short)(q.x & 0xffffu); vp[1 * (KS_LD / 2)] = (unsigned short)(q.x >> 16); vp[2 * (KS_LD / 2)] = (unsigned short)(q.y & 0xffffu); vp[3 * (KS_LD / 2)] = (unsigned short)(q.y >> 16);
    vp[4 * (KS_LD / 2)] = (unsigned short)(q.z & 0xffffu); vp[5 * (KS_LD / 2)] = (unsigned short)(q.z >> 16); vp[6 * (KS_LD / 2)] = (unsigned short)(q.w & 0xffffu); vp[7 * (KS_LD / 2)] = (unsigned short)(q.w >> 16);
}
template <bool SMP> __device__ __forceinline__ void attn_unit(Frame& F, int ui) {
    const int tid = F.tid, lane = F.lane, w = F.wave, fr = lane & 15, fq = lane >> 4;
    LAS unsigned char* KS = F.lds + RING_OFF + KS_OFF; LAS unsigned char* VT = F.lds + RING_OFF + VT_OFF; LAS float* WM = (LAS float*)(F.lds + RING_OFF + WM_OFF);
    const int h = ui & 7;
    const int qt = ui >> 3, b = (ui - 1024) >> 3;
    const int qrow0 = SMP ? MP + 32 * b : 128 * qt;
    const int nkb = SMP ? 1 + PAST / 128 : qt + 1;
    const bool active = SMP ? (w < 2) : true;
    const int qi = 16 * w + fr;
    bf16x8 qf[4];
    if (active) {
#pragma unroll
        for (int ds = 0; ds < 4; ++ds) qf[ds] = __builtin_bit_cast(bf16x8, *(const v4u*)(F.Qn() + (size_t)(qrow0 + qi) * DSB + h * HD + 32 * ds + 8 * fq));
    } else {
#pragma unroll
        for (int ds = 0; ds < 4; ++ds) qf[ds] = (bf16x8){0, 0, 0, 0, 0, 0, 0, 0};
    }
    f32x4 o[8];
#pragma unroll
    for (int dt = 0; dt < 8; ++dt) o[dt] = (f32x4){0.f, 0.f, 0.f, 0.f};
    float carry = 0.f;
    v4u pk[4], pv[4];
    f32x4 fk[SMP ? 4 : 1][2], fv[SMP ? 4 : 1][2];
    if (!SMP) {
#pragma unroll
        for (int c = 0; c < 4; ++c) { const int id = tid + 512 * c; const int krow0 = 128 * qt;
            pk[c] = *(const v4u*)(F.Kn() + (size_t)(krow0 + (id >> 4)) * DSB + h * HD + 8 * (id & 15));
            pv[c] = *(const v4u*)(F.Vb() + (size_t)(krow0 + (id & 127)) * DSB + h * HD + 8 * (id >> 7)); }
    }
    for (int j = 0; j < nkb; ++j) {
        WG_BAR();
        if (!SMP) {
#pragma unroll
            for (int c = 0; c < 4; ++c) { const int id = tid + 512 * c; *(LAS v4u*)(KS + (id >> 4) * KS_LD + 16 * (id & 15)) = pk[c]; vt_store(VT, id & 127, id >> 7, pv[c]); }
        } else if (j == 0) {
#pragma unroll
            for (int c = 0; c < 4; ++c) { const int id = tid + 512 * c;
                { const int key = id >> 4, dc = id & 15; v4u q = (v4u){0u, 0u, 0u, 0u}; if (key < 32) q = *(const v4u*)(F.Kn() + (size_t)(qrow0 + key) * DSB + h * HD + 8 * dc);
                  *(LAS v4u*)(KS + key * KS_LD + 16 * dc) = q; }
                { const int key = id & 127, dc = id >> 7; v4u q = (v4u){0u, 0u, 0u, 0u}; if (key < 32) q = *(const v4u*)(F.Vb() + (size_t)(qrow0 + key) * DSB + h * HD + 8 * dc);
                  vt_store(VT, key, dc, q); }
            }
        } else {
#pragma unroll
            for (int c = 0; c < (SMP ? 4 : 1); ++c) { const int id = tid + 512 * c;
                { const f32x4 a = fk[c][0], bb = fk[c][1]; v4u q; q.x = cvt_pk_bf16(a[0], a[1]); q.y = cvt_pk_bf16(a[2], a[3]); q.z = cvt_pk_bf16(bb[0], bb[1]); q.w = cvt_pk_bf16(bb[2], bb[3]);
                  *(LAS v4u*)(KS + (id >> 4) * KS_LD + 16 * (id & 15)) = q; }
                { const f32x4 a = fv[c][0], bb = fv[c][1]; v4u q; q.x = cvt_pk_bf16(a[0], a[1]); q.y = cvt_pk_bf16(a[2], a[3]); q.z = cvt_pk_bf16(bb[0], bb[1]); q.w = cvt_pk_bf16(bb[2], bb[3]);
                  vt_store(VT, id & 127, id >> 7, q); }
            }
        }
        WG_BAR();
        if (SMP && j + 1 < nkb) {
            const int pos0 = PAST - 128 * (j + 1);
            const float* ck = F.cache_k() + ((size_t)b * PAST + pos0) * DSB + h * HD; const float* cv = F.cache_v() + ((size_t)b * PAST + pos0) * DSB + h * HD;
#pragma unroll
            for (int c = 0; c < (SMP ? 4 : 1); ++c) { const int id = tid + 512 * c;
                { const float* p = ck + (size_t)(id >> 4) * DSB + 8 * (id & 15); fk[c][0] = __builtin_nontemporal_load((const f32x4*)p); fk[c][1] = __builtin_nontemporal_load((const f32x4*)(p + 4)); }
                { const float* p = cv + (size_t)(id & 127) * DSB + 8 * (id >> 7); fv[c][0] = __builtin_nontemporal_load((const f32x4*)p); fv[c][1] = __builtin_nontemporal_load((const f32x4*)(p + 4)); } }
        }
        if (!SMP && j + 1 < nkb) {
#pragma unroll
            for (int c = 0; c < 4; ++c) { const int id = tid + 512 * c; const int krow0 = 128 * (qt - j - 1);
                pk[c] = *(const v4u*)(F.Kn() + (size_t)(krow0 + (id >> 4)) * DSB + h * HD + 8 * (id & 15));
                pv[c] = *(const v4u*)(F.Vb() + (size_t)(krow0 + (id & 127)) * DSB + h * HD + 8 * (id >> 7)); }
        }
        float wmax = -3.0e38f;
        if (active) {
            f32x4 s[8];
            const bool diag = (j == 0);
#pragma unroll
            for (int kt = 0; kt < 8; ++kt) { s[kt] = (f32x4){0.f, 0.f, 0.f, 0.f};
                if (!(diag && kt > w))
#pragma unroll
                for (int ds = 0; ds < 4; ++ds) { const bf16x8 kf = *(const LAS bf16x8*)(KS + (16 * kt + fr) * KS_LD + 2 * (32 * ds + 8 * fq)); s[kt] = __builtin_amdgcn_mfma_f32_16x16x32_bf16(kf, qf[ds], s[kt], 0, 0, 0); } }
            float Fq[8], TT[8];
#pragma unroll
            for (int kt = 0; kt < 8; ++kt) {
                if (diag && kt > w) { s[kt] = (f32x4){-1.0e30f, -1.0e30f, -1.0e30f, -1.0e30f}; Fq[kt] = 0.f; TT[kt] = 0.f; continue; }
                f32x4 z = s[kt] * ATT_SC;
                if (diag) {
#pragma unroll
                    for (int r = 0; r < 4; ++r) z[r] = ((16 * kt + 4 * fq + r) < qi) ? z[r] : -1.0e30f; }
                f32x4 e, l, mx;
#pragma unroll
                for (int r = 0; r < 4; ++r) { e[r] = fexp2(-fabsf(z[r])); mx[r] = fmaxf(z[r], 0.f); }
                const f32x4 d = e + 1.0f;
#pragma unroll
                for (int r = 0; r < 4; ++r) l[r] = flog2(d[r]);
                const f32x4 lbv = (mx + l) * (-1.0f);
                f32x4 xsv; xsv[3] = 0.f; xsv[2] = lbv[3]; xsv[1] = lbv[3] + lbv[2]; xsv[0] = xsv[1] + lbv[1];
                const float T = xsv[0] + lbv[0];
                s[kt] = (z + lbv) + xsv;
                const float t1 = __shfl_xor(T, 16), t2 = __shfl_xor(T, 32), t3 = __shfl_xor(T, 48);
                Fq[kt] = (((fq ^ 1) > fq) ? t1 : 0.f) + (((fq ^ 2) > fq) ? t2 : 0.f) + (((fq ^ 3) > fq) ? t3 : 0.f);
                TT[kt] = (T + t1) + (t2 + t3);
            }
            float run = carry; bf16x8 pf[4];
            unsigned pw[8][2];
#pragma unroll
            for (int kt = 7; kt >= 0; --kt) {
                if (diag && kt > w) { pw[kt][0] = 0u; pw[kt][1] = 0u; continue; }
                const f32x4 arg = s[kt] + (run + Fq[kt]);
                float wv[4];
#pragma unroll
                for (int r = 0; r < 4; ++r) wv[r] = fexp2(arg[r]);
                pw[kt][0] = cvt_pk_bf16(wv[0], wv[1]); pw[kt][1] = cvt_pk_bf16(wv[2], wv[3]);
                run += TT[kt];
            }
            carry = run;
#pragma unroll
            for (int sI = 0; sI < 4; ++sI) { v4u p; p.x = pw[2 * sI][0]; p.y = pw[2 * sI][1]; p.z = pw[2 * sI + 1][0]; p.w = pw[2 * sI + 1][1]; pf[sI] = __builtin_bit_cast(bf16x8, p); }
#pragma unroll
            for (int dt = 0; dt < 8; ++dt)
#pragma unroll
                for (int sI = 0; sI < 4; ++sI) { if (!(diag && 2 * sI > w)) { const bf16x8 vf = *(const LAS bf16x8*)(VT + (16 * dt + fr) * KS_LD + 2 * (32 * sI + 8 * fq)); o[dt] = __builtin_amdgcn_mfma_f32_16x16x32_bf16(vf, pf[sI], o[dt], 0, 0, 0); } }
            wmax = carry;
#pragma unroll
            for (int off = 1; off < 16; off <<= 1) wmax = fmaxf(wmax, __shfl_xor(wmax, off));
        }
        if (lane == 0) WM[w] = wmax;
        WG_BAR();
        float mx = WM[0];
#pragma unroll
        for (int k = 1; k < 8; ++k) mx = fmaxf(mx, WM[k]);
        if (mx < ATT_STOP) break;
    }
    if (active) {
        const int row = qrow0 + qi;
        float ss = 0.f;
#pragma unroll
        for (int dt = 0; dt < 8; ++dt) ss += (o[dt][0] * o[dt][0] + o[dt][1] * o[dt][1]) + (o[dt][2] * o[dt][2] + o[dt][3] * o[dt][3]);
        ss += __shfl_xor(ss, 16); ss += __shfl_xor(ss, 32);
        if (fq == 0) F.SsqS()[(size_t)row * 8 + h] = ss;
#pragma unroll
        for (int dt = 0; dt < 8; ++dt) { const int d = 16 * dt + 4 * fq; const f32x4 gv = *(const f32x4*)(F.g_sb() + h * HD + d); const f32x4 y = o[dt] * gv;
            v2u q; q.x = cvt_pk_bf16(y[0], y[1]); q.y = cvt_pk_bf16(y[2], y[3]); *(v2u*)(F.Y() + (size_t)row * DM + DLRU + h * HD + d) = q; }
    }
}

__device__ __forceinline__ void mix_row_plain(Frame& F, int m, int lane) {
    {
        GAS v4u* yr = (GAS v4u*)(F.Y() + (size_t)m * DM);
        float y[6][8]; float ss = 0.f;
#pragma unroll
        for (int j = 0; j < 6; ++j) { const int ci = lane + 64 * j; const v4u q = yr[ci];
            y[j][0] = bflo(q.x); y[j][1] = bfhi(q.x); y[j][2] = bflo(q.y); y[j][3] = bfhi(q.y); y[j][4] = bflo(q.z); y[j][5] = bfhi(q.z); y[j][6] = bflo(q.w); y[j][7] = bfhi(q.w);
            if (m < MP) { const v4u z = __builtin_nontemporal_load((const GAS v4u*)(F.Z() + (size_t)m * DLRU) + ci); const float* cp = F.Carry() + (size_t)(m >> 6) * DLRU + 8 * ci; const f32x4 c0 = *(const f32x4*)cp, c1 = *(const f32x4*)(cp + 4);
                y[j][0] += bflo(z.x) * c0[0]; y[j][1] += bfhi(z.x) * c0[1]; y[j][2] += bflo(z.y) * c0[2]; y[j][3] += bfhi(z.y) * c0[3]; y[j][4] += bflo(z.z) * c1[0]; y[j][5] += bfhi(z.z) * c1[1]; y[j][6] += bflo(z.w) * c1[2]; y[j][7] += bfhi(z.w) * c1[3]; }
#pragma unroll
            for (int e = 0; e < 8; ++e) ss += y[j][e] * y[j][e]; }
        const f32x4 b0 = *(const f32x4*)(F.SsqS() + (size_t)m * 8), b1 = *(const f32x4*)(F.SsqS() + (size_t)m * 8 + 4);
        const float ssb = 1.0f / sqrtf((((b0[0] + b0[1]) + (b0[2] + b0[3])) + ((b1[0] + b1[1]) + (b1[2] + b1[3]))) * (1.0f / DSB) + EPS);
        const float sl = 1.0f / sqrtf(wave_sum(ss) * (1.0f / DLRU) + EPS);
#pragma unroll
        for (int j = 0; j < 6; ++j) { const int ci = lane + 64 * j; v4u q; const f32x4 g0 = *(const f32x4*)(F.g_lru() + 8 * ci) * sl, g1 = *(const f32x4*)(F.g_lru() + 8 * ci + 4) * sl;
            q.x = cvt_pk_bf16(y[j][0] * g0[0], y[j][1] * g0[1]); q.y = cvt_pk_bf16(y[j][2] * g0[2], y[j][3] * g0[3]); q.z = cvt_pk_bf16(y[j][4] * g1[0], y[j][5] * g1[1]); q.w = cvt_pk_bf16(y[j][6] * g1[2], y[j][7] * g1[3]); yr[ci] = q; }
#pragma unroll
        for (int j = 6; j < 8; ++j) { const int ci = lane + 64 * j; v4u q = yr[ci];
            q.x = cvt_pk_bf16(bflo(q.x) * ssb, bfhi(q.x) * ssb); q.y = cvt_pk_bf16(bflo(q.y) * ssb, bfhi(q.y) * ssb); q.z = cvt_pk_bf16(bflo(q.z) * ssb, bfhi(q.z) * ssb); q.w = cvt_pk_bf16(bflo(q.w) * ssb, bfhi(q.w) * ssb); yr[ci] = q; }
    }
}
__device__ __forceinline__ void mix_rows(Frame& F) {
    const int gw = F.vcu * NWAVES + F.wave, NGW = F.G * NWAVES;
    for (int m = gw; m < M; m += NGW) mix_row_plain(F, m, F.lane);
}
__device__ __forceinline__ void mix_row_sample(Frame& F, int m, int lane) {
    GAS v4u* yr = (GAS v4u*)(F.Y() + (size_t)m * DM) + lane;
    v4u q[8]; f32x4 g[6][2];
#pragma unroll
    for (int j = 0; j < 8; ++j) q[j] = yr[64 * j];
    const f32x4 b0 = *(const f32x4*)(F.SsqS() + (size_t)m * 8), b1 = *(const f32x4*)(F.SsqS() + (size_t)m * 8 + 4);
#pragma unroll
    for (int j = 0; j < 6; ++j) { g[j][0] = *(const f32x4*)(F.g_lru() + 8 * (lane + 64 * j)); g[j][1] = *(const f32x4*)(F.g_lru() + 8 * (lane + 64 * j) + 4); }
    float ss = 0.f;
#pragma unroll
    for (int j = 0; j < 6; ++j) { const float a0 = bflo(q[j].x), a1 = bfhi(q[j].x), a2 = bflo(q[j].y), a3 = bfhi(q[j].y), a4 = bflo(q[j].z), a5 = bfhi(q[j].z), a6 = bflo(q[j].w), a7 = bfhi(q[j].w);
        ss += ((a0 * a0 + a1 * a1) + (a2 * a2 + a3 * a3)) + ((a4 * a4 + a5 * a5) + (a6 * a6 + a7 * a7)); }
    const float ssb = 1.0f / sqrtf((((b0[0] + b0[1]) + (b0[2] + b0[3])) + ((b1[0] + b1[1]) + (b1[2] + b1[3]))) * (1.0f / DSB) + EPS);
    const float sl = 1.0f / sqrtf(wave_sum(ss) * (1.0f / DLRU) + EPS);
#pragma unroll
    for (int j = 0; j < 6; ++j) { const f32x4 g0 = g[j][0] * sl, g1 = g[j][1] * sl; v4u o;
        o.x = cvt_pk_bf16(bflo(q[j].x) * g0[0], bfhi(q[j].x) * g0[1]); o.y = cvt_pk_bf16(bflo(q[j].y) * g0[2], bfhi(q[j].y) * g0[3]);
        o.z = cvt_pk_bf16(bflo(q[j].z) * g1[0], bfhi(q[j].z) * g1[1]); o.w = cvt_pk_bf16(bflo(q[j].w) * g1[2], bfhi(q[j].w) * g1[3]); yr[64 * j] = o; }
#pragma unroll
    for (int j = 6; j < 8; ++j) { v4u o = q[j];
        o.x = cvt_pk_bf16(bflo(o.x) * ssb, bfhi(o.x) * ssb); o.y = cvt_pk_bf16(bflo(o.y) * ssb, bfhi(o.y) * ssb); o.z = cvt_pk_bf16(bflo(o.z) * ssb, bfhi(o.z) * ssb); o.w = cvt_pk_bf16(bflo(o.w) * ssb, bfhi(o.w) * ssb); yr[64 * j] = o; }
}
__device__ __forceinline__ void mix_rows_chunk(Frame& F) {
    const int lane = F.lane, c = F.vcu;
    LAS f32x4* cl = (LAS f32x4*)(F.lds + RING_OFF);
    LAS f32x4* gl = cl + 768;
    int m = c * 64 + F.wave * 8;
    v4u ya[8], za[6], yb[8], zb[6]; f32x4 sa[2], sb[2];
#define MX_LOAD(YQ, ZQ, SQ, mm) do { const GAS v4u* _y = (const GAS v4u*)(F.Y() + (size_t)(mm) * DM) + lane; const GAS v4u* _z = (const GAS v4u*)(F.Z() + (size_t)(mm) * DLRU) + lane; \
        _Pragma("unroll") for (int j = 0; j < 8; ++j) YQ[j] = _y[64 * j]; _Pragma("unroll") for (int j = 0; j < 6; ++j) ZQ[j] = __builtin_nontemporal_load(_z + 64 * j); \
        SQ[0] = *(const GAS f32x4*)(F.SsqS() + (size_t)(mm) * 8); SQ[1] = *(const GAS f32x4*)(F.SsqS() + (size_t)(mm) * 8 + 4); } while (0)
#define MX_FIN(YQ, ZQ, SQ, mm) do { LAS f32x4* _c = cl + 2 * lane; LAS f32x4* _g = gl + 2 * lane; asm volatile("" : "+v"(_c), "+v"(_g)); \
        float yv[6][8]; float ss = 0.f; \
        _Pragma("unroll") for (int j = 0; j < 6; ++j) { const f32x4 c0 = _c[128 * j], c1 = _c[128 * j + 1]; \
            yv[j][0] = bflo(YQ[j].x) + bflo(ZQ[j].x) * c0[0]; yv[j][1] = bfhi(YQ[j].x) + bfhi(ZQ[j].x) * c0[1]; yv[j][2] = bflo(YQ[j].y) + bflo(ZQ[j].y) * c0[2]; yv[j][3] = bfhi(YQ[j].y) + bfhi(ZQ[j].y) * c0[3]; \
            yv[j][4] = bflo(YQ[j].z) + bflo(ZQ[j].z) * c1[0]; yv[j][5] = bfhi(YQ[j].z) + bfhi(ZQ[j].z) * c1[1]; yv[j][6] = bflo(YQ[j].w) + bflo(ZQ[j].w) * c1[2]; yv[j][7] = bfhi(YQ[j].w) + bfhi(ZQ[j].w) * c1[3]; \
            _Pragma("unroll") for (int e = 0; e < 8; ++e) ss += yv[j][e] * yv[j][e]; } \
        const float ssb = 1.0f / sqrtf((((SQ[0][0] + SQ[0][1]) + (SQ[0][2] + SQ[0][3])) + ((SQ[1][0] + SQ[1][1]) + (SQ[1][2] + SQ[1][3]))) * (1.0f / DSB) + EPS); \
        const float sl = 1.0f / sqrtf(wave_sum(ss) * (1.0f / DLRU) + EPS); \
        GAS v4u* _o = (GAS v4u*)(F.Y() + (size_t)(mm) * DM) + lane; \
        _Pragma("unroll") for (int j = 0; j < 6; ++j) { const f32x4 g0 = _g[128 * j] * sl, g1 = _g[128 * j + 1] * sl; v4u q; \
            q.x = cvt_pk_bf16(yv[j][0] * g0[0], yv[j][1] * g0[1]); q.y = cvt_pk_bf16(yv[j][2] * g0[2], yv[j][3] * g0[3]); q.z = cvt_pk_bf16(yv[j][4] * g1[0], yv[j][5] * g1[1]); q.w = cvt_pk_bf16(yv[j][6] * g1[2], yv[j][7] * g1[3]); _o[64 * j] = q; } \
        _Pragma("unroll") for (int j = 6; j < 8; ++j) { v4u q = YQ[j]; \
            q.x = cvt_pk_bf16(bflo(q.x) * ssb, bfhi(q.x) * ssb); q.y = cvt_pk_bf16(bflo(q.y) * ssb, bfhi(q.y) * ssb); q.z = cvt_pk_bf16(bflo(q.z) * ssb, bfhi(q.z) * ssb); q.w = cvt_pk_bf16(bflo(q.w) * ssb, bfhi(q.w) * ssb); _o[64 * j] = q; } } while (0)
    MX_LOAD(ya, za, sa, m); __builtin_amdgcn_sched_barrier(0);
    for (int i = F.tid; i < 768; i += NWAVES * 64) { cl[i] = ((const GAS f32x4*)(F.Carry() + (size_t)c * DLRU))[i]; gl[i] = ((const GAS f32x4*)F.g_lru())[i]; }
    WG_BAR();
    for (int k = 0; k < 3; ++k) { MX_LOAD(yb, zb, sb, m + 1); __builtin_amdgcn_sched_barrier(0); MX_FIN(ya, za, sa, m); __builtin_amdgcn_sched_barrier(0);
                                  MX_LOAD(ya, za, sa, m + 2); __builtin_amdgcn_sched_barrier(0); MX_FIN(yb, zb, sb, m + 1); __builtin_amdgcn_sched_barrier(0); m += 2; }
    MX_LOAD(yb, zb, sb, m + 1); __builtin_amdgcn_sched_barrier(0); MX_FIN(ya, za, sa, m); __builtin_amdgcn_sched_barrier(0); MX_FIN(yb, zb, sb, m + 1);
#undef MX_LOAD
#undef MX_FIN
    for (int ms = MP + F.wave * F.G + F.vcu; ms < M; ms += F.G * NWAVES) mix_row_sample(F, ms, lane);
}
__device__ __forceinline__ void act_pass(Frame& F, int hf) {
    const int gt = F.vcu * (NWAVES * 64) + F.tid, NGT = F.G * NWAVES * 64;
    constexpr int NFG = DFF / 2 / 8, NRB = M / 32;
    for (int it = gt; it < NFG * NRB; it += NGT) {
        const int fg = it % NFG, rb = it / NFG, pnl = fg >> 4, wi = (fg & 15) * 8, vcol = 256 * pnl + wi, f = (DFF / 2) * hf + 128 * pnl + wi, r0 = 32 * rb;
        float w0[8], w1[8], w2[8], cbv[8], p2[8], p1[8];
        { const f32x4 a = *(const f32x4*)(F.fcw() + f), b = *(const f32x4*)(F.fcw() + f + 4); w0[0] = a[0]; w0[1] = a[1]; w0[2] = a[2]; w0[3] = a[3]; w0[4] = b[0]; w0[5] = b[1]; w0[6] = b[2]; w0[7] = b[3]; }
        { const f32x4 a = *(const f32x4*)(F.fcw() + DFF + f), b = *(const f32x4*)(F.fcw() + DFF + f + 4); w1[0] = a[0]; w1[1] = a[1]; w1[2] = a[2]; w1[3] = a[3]; w1[4] = b[0]; w1[5] = b[1]; w1[6] = b[2]; w1[7] = b[3]; }
        { const f32x4 a = *(const f32x4*)(F.fcw() + 2 * DFF + f), b = *(const f32x4*)(F.fcw() + 2 * DFF + f + 4); w2[0] = a[0]; w2[1] = a[1]; w2[2] = a[2]; w2[3] = a[3]; w2[4] = b[0]; w2[5] = b[1]; w2[6] = b[2]; w2[7] = b[3]; }
        { const f32x4 a = *(const f32x4*)(F.fcb() + f), b = *(const f32x4*)(F.fcb() + f + 4); cbv[0] = a[0]; cbv[1] = a[1]; cbv[2] = a[2]; cbv[3] = a[3]; cbv[4] = b[0]; cbv[5] = b[1]; cbv[6] = b[2]; cbv[7] = b[3]; }
        if (r0 >= MP) { const int b = (r0 - MP) >> 5; const float* s0 = F.st_ffn() + (size_t)(b * 2) * DFF + f; const float* s1 = s0 + DFF;
            const f32x4 a = *(const f32x4*)s0, c = *(const f32x4*)(s0 + 4), d = *(const f32x4*)s1, e = *(const f32x4*)(s1 + 4);
            p2[0] = a[0]; p2[1] = a[1]; p2[2] = a[2]; p2[3] = a[3]; p2[4] = c[0]; p2[5] = c[1]; p2[6] = c[2]; p2[7] = c[3];
            p1[0] = d[0]; p1[1] = d[1]; p1[2] = d[2]; p1[3] = d[3]; p1[4] = e[0]; p1[5] = e[1]; p1[6] = e[2]; p1[7] = e[3];
        } else if (r0 == 0) {
#pragma unroll
            for (int e = 0; e < 8; ++e) { p2[e] = 0.f; p1[e] = 0.f; }
        } else { const v4u a = *(const v4u*)(F.VALPRE() + (size_t)(r0 - 2) * DFF + vcol + 128), b = *(const v4u*)(F.VALPRE() + (size_t)(r0 - 1) * DFF + vcol + 128);
            p2[0] = bflo(a.x); p2[1] = bfhi(a.x); p2[2] = bflo(a.y); p2[3] = bfhi(a.y); p2[4] = bflo(a.z); p2[5] = bfhi(a.z); p2[6] = bflo(a.w); p2[7] = bfhi(a.w);
            p1[0] = bflo(b.x); p1[1] = bfhi(b.x); p1[2] = bflo(b.y); p1[3] = bfhi(b.y); p1[4] = bflo(b.z); p1[5] = bfhi(b.z); p1[6] = bflo(b.w); p1[7] = bfhi(b.w); }
#pragma unroll 4
        for (int t = 0; t < 32; ++t) { const int row = r0 + t;
            const v4u pq = *(const v4u*)(F.VALPRE() + (size_t)row * DFF + vcol + 128), vq = *(const v4u*)(F.VALPRE() + (size_t)row * DFF + vcol);
            float pc[8], vv[8], o[8];
            pc[0] = bflo(pq.x); pc[1] = bfhi(pq.x); pc[2] = bflo(pq.y); pc[3] = bfhi(pq.y); pc[4] = bflo(pq.z); pc[5] = bfhi(pq.z); pc[6] = bflo(pq.w); pc[7] = bfhi(pq.w);
            vv[0] = bflo(vq.x); vv[1] = bfhi(vq.x); vv[2] = bflo(vq.y); vv[3] = bfhi(vq.y); vv[4] = bflo(vq.z); vv[5] = bfhi(vq.z); vv[6] = bflo(vq.w); vv[7] = bfhi(vq.w);
#pragma unroll
            for (int e = 0; e < 8; ++e) { const float c = cbv[e] + (w0[e] * p2[e] + w1[e] * p1[e]) + w2[e] * pc[e]; o[e] = gelu_tanh(c) * vv[e]; p2[e] = p1[e]; p1[e] = pc[e]; }
            v4u q; q.x = cvt_pk_bf16(o[0], o[1]); q.y = cvt_pk_bf16(o[2], o[3]); q.z = cvt_pk_bf16(o[4], o[5]); q.w = cvt_pk_bf16(o[6], o[7]);
            *(v4u*)(F.ACT() + (size_t)row * DFF + f) = q;
            float* fdst = nullptr;
            if (row < MP) { if (row >= MP - 2) fdst = F.out() + O_FP + (size_t)(row - (MP - 2)) * DFF + f; }
            else { const int tt = (row - MP) & 31; if (tt >= 30) fdst = F.out() + O_FS + (size_t)(((row - MP) >> 5) * 2 + (tt - 30)) * DFF + f; }
            if (fdst) { *(f32x4*)fdst = (f32x4){pc[0], pc[1], pc[2], pc[3]}; *(f32x4*)(fdst + 4) = (f32x4){pc[4], pc[5], pc[6], pc[7]}; }
        }
    }
}

__device__ __forceinline__ void ffn_fixup(Frame& F) {
    const int gt = F.vcu * (NWAVES * 64) + F.tid, NGT = F.G * NWAVES * 64;
    constexpr int NF4 = DFF / 4, NITEM = (MP / 256 - 1) * 2 * NF4;
    for (int it0 = gt; it0 < NITEM; it0 += 3 * NGT) {
        f32x4 c[3], v[3], H1[3], H0[3], w0[3], w1[3];
#pragma unroll
        for (int k = 0; k < 3; ++k) { const int it = min(it0 + k * NGT, NITEM - 1); const int f = 4 * (it % NF4), q = it / NF4, rr = q & 1, pm = 1 + (q >> 1);
            c[k] = *(const f32x4*)(F.DefC() + ((size_t)pm * 2 + rr) * DFF + f); v[k] = *(const f32x4*)(F.DefV() + ((size_t)pm * 2 + rr) * DFF + f);
            H1[k] = *(const f32x4*)(F.Halo() + ((size_t)(pm - 1) * 2 + 1) * DFF + f); H0[k] = *(const f32x4*)(F.Halo() + ((size_t)(pm - 1) * 2 + 0) * DFF + f);
            w0[k] = *(const f32x4*)(F.fcw() + f); w1[k] = *(const f32x4*)(F.fcw() + DFF + f); }
#pragma unroll
        for (int k = 0; k < 3; ++k) { const int it = it0 + k * NGT; if (it >= NITEM) break; const int f = 4 * (it % NF4), q = it / NF4, rr = q & 1, pm = 1 + (q >> 1);
            const f32x4 cc = rr == 0 ? c[k] + (w1[k] * H1[k] + w0[k] * H0[k]) : c[k] + w0[k] * H1[k];
            v2u o; o.x = cvt_pk_bf16(gelu_tanh(cc[0]) * v[k][0], gelu_tanh(cc[1]) * v[k][1]); o.y = cvt_pk_bf16(gelu_tanh(cc[2]) * v[k][2], gelu_tanh(cc[3]) * v[k][3]);
            *(v2u*)(F.ACT() + (size_t)(256 * pm + rr) * DFF + f) = o; }
    }
}

template <int RPW> __device__ __forceinline__ void sample_rows_norm(Frame& F) {
    const int lane = F.lane, w = F.wave;
    LAS float* xs = (LAS float*)(F.lds + RING_OFF + NWAVES * TR_WAVE_BYTES);
    f32x4 v[RPW][2];
#pragma unroll
    for (int rr = 0; rr < RPW; ++rr) { const int r = F.vcu * RPW + rr, c4 = w * 128 + lane;
        const GAS f32x4* bp = (const GAS f32x4*)(F.x_s() + (size_t)r * DM) + c4; f32x4 p[8][2];
        v[rr][0] = bp[0]; v[rr][1] = bp[64];
#pragma unroll
        for (int ks = 0; ks < 8; ++ks) { const GAS f32x4* pr = (const GAS f32x4*)(F.Part() + ((size_t)ks * MS + r) * DM) + c4; p[ks][0] = pr[0]; p[ks][1] = pr[64]; }
#pragma unroll
        for (int ks = 0; ks < 8; ++ks) { v[rr][0] = v[rr][0] + p[ks][0]; v[rr][1] = v[rr][1] + p[ks][1]; }
        GAS f32x4* dp = (GAS f32x4*)(F.out() + O_Y + (size_t)(MP + r) * DM) + c4; dp[0] = v[rr][0]; dp[64] = v[rr][1];
        float sq = 0.f;
#pragma unroll
        for (int j = 0; j < 2; ++j) sq += (v[rr][j].x * v[rr][j].x + v[rr][j].y * v[rr][j].y) + (v[rr][j].z * v[rr][j].z + v[rr][j].w * v[rr][j].w);
        sq = wave_sum(sq); if (lane == 0) xs[rr * 8 + w] = sq; }
    WG_BAR();
#pragma unroll
    for (int rr = 0; rr < RPW; ++rr) { const int r = F.vcu * RPW + rr, c4 = w * 128 + lane;
        float tot = 0.f;
#pragma unroll
        for (int k = 0; k < 8; ++k) tot += xs[rr * 8 + k];
        const float rsn = 1.0f / sqrtf(tot * (1.0f / DM) + EPS);
        const GAS f32x4* gr = (const GAS f32x4*)F.g_ffn() + c4; GAS v2u* o8 = (GAS v2u*)(F.BUFA() + (size_t)(MP + r) * DM) + c4;
#pragma unroll
        for (int j = 0; j < 2; ++j) { const f32x4 gv = gr[64 * j]; const f32x4 x = v[rr][j]; v2u o; o.x = cvt_pk_bf16(x.x * rsn * gv.x, x.y * rsn * gv.y); o.y = cvt_pk_bf16(x.z * rsn * gv.z, x.w * rsn * gv.w); o8[64 * j] = o; } }
}
__device__ __forceinline__ void sample_rows_final(Frame& F) {
    const int gw = F.vcu * NWAVES + F.wave, NGW = F.G * NWAVES;
    int lane = (int)threadIdx.x; asm volatile("" : "+v"(lane)); lane &= 63;
    for (int it = gw; it < MS * 4; it += NGW) {
        const int r = it >> 2, c4 = (it & 3) * 256 + lane;
        GAS f32x4* yr = (GAS f32x4*)(F.out() + O_Y + (size_t)(MP + r) * DM) + c4;
        f32x4 v[4], p[8][4];
#pragma unroll
        for (int j = 0; j < 4; ++j) v[j] = yr[64 * j];
#pragma unroll
        for (int ks = 0; ks < 8; ++ks) { const GAS f32x4* pr = (const GAS f32x4*)(F.Part() + ((size_t)ks * MS + r) * DM) + c4;
#pragma unroll
            for (int j = 0; j < 4; ++j) p[ks][j] = pr[64 * j]; }
#pragma unroll
        for (int ks = 0; ks < 8; ++ks)
#pragma unroll
            for (int j = 0; j < 4; ++j) v[j] = v[j] + p[ks][j];
#pragma unroll
        for (int j = 0; j < 4; ++j) yr[64 * j] = v[j];
    }
}

constexpr int NPH = 11;
__global__ void __launch_bounds__(NWAVES * 64, 2) hymba_fwd(Args args) {
    extern __shared__ __attribute__((aligned(16))) unsigned char lds[];
    Frame F;
    F.lds = (LAS unsigned char*)lds;
    F.MISC = (volatile LAS unsigned*)(F.lds + MISC_OFF);
    F.tid = threadIdx.x; F.lane = F.tid & 63; F.wave = __builtin_amdgcn_readfirstlane(F.tid >> 6);
    F.G = gridDim.x; { const int bx = blockIdx.x; F.vcu = (F.G % 8 == 0) ? (bx % 8) * (F.G / 8) + bx / 8 : bx; }
    F.a = &args;
    F.ctl = (gu32*)(args.ws + WS_CTL);
    for (int u = F.tid; u < (LDS_BYTES - LDSCTL_OFF) / 4; u += NWAVES * 64) ((LAS unsigned*)(F.lds + LDSCTL_OFF))[u] = 0u;
    __syncthreads();
    XcdBarrier bar; bar.bar = (unsigned*)(F.ctl + CW_BAR); bar.x = 0; bar.st = nullptr;
    if (!MK_PER_PHASE) bar = xcd_barrier_post((unsigned*)(F.ctl + CW_BAR), F.MISC + 8);
#define GRID_BAR(seam) do { if (MK_PER_PHASE) { if (F.tid == 0) __hip_atomic_store(F.ctl + CW_TMO, 0xBADBA0u | (unsigned)(seam), RLX_AGENT); } else { xcd_barrier(bar); } } while (0)
    const int lo = args.ph_lo, hi = args.ph_hi;
#ifndef PH_MASK
#define PH_MASK 0xFFFF
#endif
#define IN(k) (((PH_MASK >> (k)) & 1) && lo <= (k) && (k) < hi)
#define BOTH(k) (IN(k) && IN((k) + 1))
#ifndef REP_MASK
#define REP_MASK 0
#endif
#define REP2(k) if constexpr (((REP_MASK >> (k)) & 1) != 0)
    LAS float* EPI = (LAS float*)(F.lds + EPI_OFF);

    if (IN(0)) { p0_prologue(F); REP2(0) p0_prologue(F); if (BOTH(0)) GRID_BAR(0); }
    if (IN(1)) {
        const int nconv = (F.G >= 8 * NCONV) ? NCONV : 0, gc = F.G - nconv;
        if ((int)blockIdx.x < gc) {
            pg8::Gemm g{F.BUFA(), F.Win_t(), M, DIN, DM}; pg8::StaticOrder S; S.init(M, DIN, gc, (int)blockIdx.x, DM / 64);
            Epi1 E{F.U(), F.Gt(), F.Qn(), F.Kn(), F.Vb(), F.out(), F.qg(), F.kg(), EPI};
            pg8::gemm_phase<Epi1, pg8::StaticOrder, true, true>(F.lds + RING_OFF, g, S, E);
        }
        conv_queue<false>(F);
        if (BOTH(1)) GRID_BAR(1);
    }
    if (IN(2)) {
        { LAS unsigned* tcnt = (LAS unsigned*)(F.lds + LDSCTL_OFF) + 16 * (F.wave >> 2); unsigned tphase = 0;
          if (F.G == 256) {
              for (int u = F.vcu * 2 + (F.wave >> 2); u < 256 * 16; u += 2 * F.G) lru_unit(F, u >> 4, u & 15, tcnt, tphase);
              if ((F.vcu & 3) == 0) { const int u = 256 * 16 + (F.vcu >> 2) * 2 + (F.wave >> 2); lru_unit(F, u >> 4, u & 15, tcnt, tphase); }
          } else for (int u = F.vcu * 2 + (F.wave >> 2); u < 264 * 16; u += 2 * F.G) lru_unit(F, u >> 4, u & 15, tcnt, tphase); }
        WG_BAR();
        for (int u = F.vcu; u < 1024; u += F.G) attn_unit<false>(F, u);
        if (F.G == 256) { if ((F.vcu & 3) == 1 || (F.vcu & 3) == 2) attn_unit<true>(F, 1024 + (F.vcu >> 2) * 2 + (F.vcu & 3) - 1); }
        else if (F.G >= 192) { if (F.vcu >= 64 && F.vcu < 192) attn_unit<true>(F, 1024 + F.vcu - 64); }
        else for (int u = 1024 + F.vcu; u < 1152; u += F.G) attn_unit<true>(F, u);
        if (BOTH(2)) GRID_BAR(2);
    }
    if (IN(3)) { lru_prefix(F); if (BOTH(3)) GRID_BAR(3); }
    if (IN(4)) { if (F.G == MP / 64) mix_rows_chunk(F); else mix_rows(F); if (BOTH(4)) GRID_BAR(4); }
    if (IN(5)) {
        pg8::Gemm g{F.Y(), F.Wout_t(), M, DM, DM}; pg8::StaticOrder S; S.init(MP, DM, F.G, (int)blockIdx.x, DM / 64, 8);
        EpiRes<0> E{F.x_p(), F.X1(), F.out(), F.Part()};
        pg8::gemm_phase<EpiRes<0>, pg8::StaticOrder, true, true>(F.lds + RING_OFF, g, S, E);
        if (BOTH(5)) GRID_BAR(5);
    }
    if (IN(6)) {
        const int gw = F.vcu * NWAVES + F.wave, NGW = F.G * NWAVES;
        hn2_rows(F);
        if (F.G * 2 == MS) sample_rows_norm<2>(F);
        else for (int r = gw; r < MS; r += NGW) sample_row_reduce(F.x_s() + (size_t)r * DM, F.Part(), r, F.out() + O_Y + (size_t)(MP + r) * DM, F.g_ffn(), F.BUFA() + (size_t)(MP + r) * DM, F.lane);
        if (BOTH(6)) GRID_BAR(6);
    }
    if (IN(7)) {
        pg8::Gemm g{F.BUFA(), F.Wup_t(), M, 2 * DFF, DM}; pg8::StaticOrder S; S.init(M, 2 * DFF, F.G, (int)blockIdx.x, DM / 64);
        EpiUp E{F.ACT(), F.fcw(), F.fcb(), F.st_ffn(), F.out(), F.Halo(), F.DefC(), F.DefV(), EPI};
        pg8::gemm_phase<EpiUp, pg8::StaticOrder, true, true>(F.lds + RING_OFF, g, S, E);
        conv_queue<true>(F);
        if (BOTH(7)) GRID_BAR(7);
    }
    if (IN(8)) { ffn_fixup(F); if (BOTH(8)) GRID_BAR(8); }
    if (IN(9)) {
        pg8::Gemm g{F.ACT(), F.Wdown_t(), M, DM, DFF}; pg8::StaticOrder S; S.init(MP, DM, F.G, (int)blockIdx.x, DFF / 64, 8);
        EpiRes<1> E{F.x_p(), F.X1(), F.out(), F.Part()};
        pg8::gemm_phase<EpiRes<1>, pg8::StaticOrder, true, true>(F.lds + RING_OFF, g, S, E);
        if (BOTH(9)) GRID_BAR(9);
    }
    if (IN(10)) sample_rows_final(F);
#undef IN
#undef BOTH
}

extern "C" void kernel_launch(void* const* d_in, const int* in_sizes, int n_in, void* d_out, int out_size, void* d_ws, size_t ws_size, hipStream_t stream) {
    static int grid = 0;
    if (grid == 0) {
        if (n_in != 26 || out_size != (int)O_END || ws_size < WS_END) { fprintf(stderr, "kernel_launch: unexpected shapes (n_in %d, out %d, ws %zu); nothing launched\n", n_in, out_size, ws_size); grid = -1; return; }
        int dev = 0, cus = 0, per_cu = 0;
        if (hipGetDevice(&dev) != hipSuccess || hipDeviceGetAttribute(&cus, hipDeviceAttributeMultiprocessorCount, dev) != hipSuccess) { grid = -1; return; }
        if (hipFuncSetAttribute((const void*)hymba_fwd, hipFuncAttributeMaxDynamicSharedMemorySize, LDS_BYTES) != hipSuccess) { fprintf(stderr, "kernel_launch: hipFuncSetAttribute failed\n"); grid = -1; return; }
        if (hipOccupancyMaxActiveBlocksPerMultiprocessor(&per_cu, (const void*)hymba_fwd, NWAVES * 64, LDS_BYTES) != hipSuccess || per_cu < 1) { fprintf(stderr, "kernel_launch: occupancy query reports %d blocks per CU\n", per_cu); }
        (void)hipGetLastError();
        grid = cus;
        if (MK_GRID) grid = MK_GRID;
    }
    if (grid < 0) return;
    if (hipMemsetAsync((char*)d_ws + WS_CTL, 0, CTL_ZERO_BYTES, stream) != hipSuccess) return;
    Args a{};
    for (int i = 0; i < 26; ++i) a.in[i] = (const float*)d_in[i];
    a.out = (float*)d_out; a.ws = (unsigned char*)d_ws;
    const int nl = MK_PER_PHASE ? NPH : 1;
    for (int li = 0; li < nl; ++li) {
        a.ph_lo = MK_PER_PHASE ? li : 0; a.ph_hi = MK_PER_PHASE ? li + 1 : NPH; a.li = li;
        hipLaunchKernelGGL(hymba_fwd, dim3(grid), dim3(NWAVES * 64), LDS_BYTES, stream, a);
        const hipError_t le = hipPeekAtLastError();
        if (le != hipSuccess) { fprintf(stderr, "kernel_launch: launch %d failed: %s\n", li, hipGetErrorName(le)); break; }
    }
}
```

```cpp
#include <hip/hip_runtime.h>
#include <cstdio>
#include <cstdint>
#define MK_PER_PHASE 0
namespace pg8 {
#define PG8_LAS __attribute__((address_space(3)))
typedef unsigned short bf16_t;
typedef short bf16x8 __attribute__((ext_vector_type(8)));
typedef float f32x4 __attribute__((ext_vector_type(4)));
typedef unsigned u32x4 __attribute__((ext_vector_type(4)));
constexpr int BM = 256, BK = 64, HALF = 128, HTB = HALF * BK * 2  , STAGE_BYTES = 8 * HTB, NXCD = 8, WGM = 8;

__host__ __device__ __forceinline__ int lds_byte(int r, int c) { const int st = (r >> 4) * 2 + (c >> 5), rr = r & 15, cc = c & 31, ob = rr * 64 + cc * 2; return st * 1024 + (ob ^ (((ob >> 9) & 1) << 5)); }
__host__ __device__ __forceinline__ void stage_rc(int b, int& R, int& C) { const int st = b / 1024, sb = b % 1024, swz = sb ^ (((sb >> 9) & 1) << 5); R = (st >> 1) * 16 + swz / 64; C = (st & 1) * 32 + (swz % 64) / 2; }
__host__ __device__ __forceinline__ int perm32(int rho) { const int n = rho >> 4, i = rho & 15; return 8 * (i >> 2) + 4 * n + (i & 3); }

struct Unit { int pm, pn, k0, nt, ks; };
struct Gemm { const bf16_t* A; const bf16_t* Bt; int M, N, K; };

struct StaticOrder {
    int nM, nN, nwg, G, c, ntK, nsplit;
    __host__ __device__ void init(int M, int N, int G_, int c_, int ntK_, int nsplit_ = 0) { nM = M / BM; nN = N / BM; nwg = nM * nN; G = G_; c = c_; ntK = ntK_; nsplit = nsplit_; }
    __host__ __device__ __forceinline__ bool next(int i, Unit& u) const {
        int ii = i;
        if (nsplit > 0 && (nwg % G) == 0 && 2 * nN * nsplit == G && (c & 7) < 4) { const int nmain = nwg / G; ii = (i == 0) ? nmain : (i <= nmain ? i - 1 : i); }
        const long L = (long)ii * G + c;
        int pm, pn, k0 = 0, nt = ntK, ks = -1; bool ok = true;
        if (L >= nwg) {
            const int s = (int)(L - nwg); ok = (nsplit != 0) && (s < 2 * nN * nsplit);
            const int nsp = nsplit > 0 ? nsplit : 1, tile = s / nsp; ks = s - tile * nsp; pm = nM + tile / nN; pn = tile % nN; nt = ntK / nsp; k0 = ks * nt;
        } else {
            int wgid = (int)L; { const int q = nwg / NXCD, r = nwg % NXCD, xcd = wgid % NXCD, off = wgid / NXCD; wgid = (xcd < r ? xcd * (q + 1) : r * (q + 1) + (xcd - r) * q) + off; }
            const int nig = WGM * nN, gid = wgid / nig, fm = gid * WGM, gsz = (nM - fm) < WGM ? (nM - fm) : WGM;
            pm = fm + ((wgid % nig) % gsz); pn = (wgid % nig) / gsz;
        }
        u.pm = pm; u.pn = pn; u.k0 = k0; u.nt = nt; u.ks = ks; return ok;
    }
    __device__ __forceinline__ void a_ready(const Unit&) const {}
    __device__ __forceinline__ void done(const Unit&) const {}
};

typedef float f32x2c __attribute__((ext_vector_type(2)));
typedef __bf16 bf16x2c __attribute__((ext_vector_type(2)));
__device__ __forceinline__ unsigned cvt_pk_bf16(float lo, float hi) { const f32x2c v = {lo, hi}; return __builtin_bit_cast(unsigned, __builtin_convertvector(v, bf16x2c)); }
typedef float f32x2 __attribute__((ext_vector_type(2)));
template <class Epi, class Sched, bool ALIGN_EPI = false, bool SP2 = false>
__device__ __forceinline__ void gemm_phase(PG8_LAS unsigned char* lds, const Gemm g, const Sched& S, const Epi& E) {
    const int tid = threadIdx.x, wid = __builtin_amdgcn_readfirstlane(tid >> 6), lane = tid & 63, wr = wid >> 2, wc = wid & 3, fr = lane & 15, fq = lane >> 4;
    const int K = g.K;
    unsigned voffA[2], voffB[2];
#pragma unroll
    for (int i = 0; i < 2; ++i) { int R, C; stage_rc(tid * 16 + i * 8192, R, C); const int Rb = Epi::PERM ? ((R & ~31) + perm32(R & 31)) : R;
        voffA[i] = (unsigned)(R * K + C) * 2u; voffB[i] = (unsigned)(Rb * K + C) * 2u; }
    const size_t kstep = (size_t)(BK * 2);
    const size_t hstep = (size_t)HALF * K * 2;
    const size_t tstep = 2 * hstep;
    const unsigned ldsw = (unsigned)wid * 1024u;
    const int aoff = lds_byte(wr * 64 + fr, fq * 8), boff = lds_byte(wc * 32 + fr, fq * 8);
#define PG8_SA(b, h) (((b) * 2 + (h)) * HTB)
#define PG8_SB(b, h) ((4 + (b) * 2 + (h)) * HTB)
#define PG8_STAGE(bufoff, gbase, voff) do { _Pragma("unroll") for (int _i = 0; _i < 2; ++_i) \
        __builtin_amdgcn_global_load_lds((const unsigned*)((const char*)(gbase) + (voff)[_i]), (PG8_LAS unsigned*)(lds + (bufoff) + ldsw + _i * 8192), 16, 0, 0); } while (0)
#define PG8_LDA(dst, b, h) do { _Pragma("unroll") for (int m = 0; m < 4; ++m) _Pragma("unroll") for (int k = 0; k < 2; ++k) dst[m][k] = *(const PG8_LAS bf16x8*)(lds + PG8_SA(b, h) + aoff + m * 2048 + k * 1024); } while (0)
#define PG8_LDB(dst, b, h) do { _Pragma("unroll") for (int n = 0; n < 2; ++n) _Pragma("unroll") for (int k = 0; k < 2; ++k) dst[n][k] = *(const PG8_LAS bf16x8*)(lds + PG8_SB(b, h) + boff + n * 2048 + k * 1024); } while (0)
#define PG8_MMA(ai, bj, At, Bt) do { __builtin_amdgcn_s_setprio(1); _Pragma("unroll") for (int m = 0; m < 4; ++m) _Pragma("unroll") for (int n = 0; n < 2; ++n) _Pragma("unroll") for (int k = 0; k < 2; ++k) \
        acc[ai][bj][m][n] = __builtin_amdgcn_mfma_f32_16x16x32_bf16(Bt[n][k], At[m][k], acc[ai][bj][m][n], 0, 0, 0); __builtin_amdgcn_s_setprio(0); } while (0)
#define PG8_WAIT_V(n) asm volatile("s_waitcnt vmcnt(" #n ")" ::: "memory")
#define PG8_WAIT_L(n) asm volatile("s_waitcnt lgkmcnt(" #n ")" ::: "memory")
#define PG8_BAR __builtin_amdgcn_s_barrier()
#define PG8_SCHED __builtin_amdgcn_sched_barrier(0)
    Unit cur, nxt; int ui = 0;
    if (!S.next(0, cur)) return;
    f32x4 acc[2][2][4][2];
#pragma unroll
    for (int a = 0; a < 2; ++a)
#pragma unroll
        for (int b = 0; b < 2; ++b)
#pragma unroll
            for (int m = 0; m < 4; ++m)
#pragma unroll
                for (int n = 0; n < 2; ++n) acc[a][b][m][n] = (f32x4){0.f, 0.f, 0.f, 0.f};
    bf16x8 At[4][2], B0[2][2], B1[2][2];
    const char* cA = (const char*)g.A + (size_t)cur.pm * tstep + (size_t)cur.k0 * kstep; const char* cB = (const char*)g.Bt + (size_t)cur.pn * tstep + (size_t)cur.k0 * kstep;
    S.a_ready(cur);
    if constexpr (SP2) {
        PG8_STAGE(PG8_SB(0, 0), cB, voffB); PG8_STAGE(PG8_SB(0, 1), cB + hstep, voffB); PG8_STAGE(PG8_SA(0, 0), cA, voffA); PG8_STAGE(PG8_SA(0, 1), cA + hstep, voffA);
        if (wr == 1) PG8_BAR;
        PG8_WAIT_V(2); PG8_BAR;
        PG8_STAGE(PG8_SB(1, 0), cB + kstep, voffB); PG8_STAGE(PG8_SA(1, 0), cA + kstep, voffA); PG8_STAGE(PG8_SB(1, 1), cB + hstep + kstep, voffB);
        PG8_WAIT_V(6); PG8_BAR;
    } else {
        PG8_STAGE(PG8_SB(0, 0), cB, voffB); PG8_STAGE(PG8_SA(0, 0), cA, voffA); PG8_STAGE(PG8_SB(0, 1), cB + hstep, voffB); PG8_STAGE(PG8_SA(0, 1), cA + hstep, voffA);
        if (wr == 1) PG8_BAR;
        PG8_WAIT_V(4); PG8_BAR;
        PG8_STAGE(PG8_SB(1, 0), cB + kstep, voffB); PG8_STAGE(PG8_SA(1, 0), cA + kstep, voffA); PG8_STAGE(PG8_SB(1, 1), cB + hstep + kstep, voffB);
        PG8_WAIT_V(6); PG8_BAR;
    }
    for (;;) {
        const bool has_next = S.next(ui + 1, nxt);
        const char* nA = has_next ? (const char*)g.A + (size_t)nxt.pm * tstep + (size_t)nxt.k0 * kstep : cA; const char* nB = has_next ? (const char*)g.Bt + (size_t)nxt.pn * tstep + (size_t)nxt.k0 * kstep : cB;
        const int nt = cur.nt;
        for (int t = 0; t < nt; t += 2) {
            const bool last = (t == nt - 2);
            const char* a1 = cA + (size_t)(t + 1) * kstep;
            const char* a2 = last ? nA : cA + (size_t)(t + 2) * kstep; const char* b2 = last ? nB : cB + (size_t)(t + 2) * kstep;
            const char* a3 = a2 + kstep; const char* b3 = b2 + kstep;
            if (last && has_next) S.a_ready(nxt);
            if constexpr (SP2) {
            PG8_LDB(B0, 0, 0); PG8_LDB(B1, 0, 1); PG8_SCHED; PG8_LDA(At, 0, 0); PG8_STAGE(PG8_SA(1, 1), a1 + hstep, voffA);
            PG8_WAIT_V(8); PG8_WAIT_L(0); PG8_BAR; PG8_MMA(0, 0, At, B0); PG8_MMA(0, 1, At, B1); PG8_BAR; PG8_SCHED;
            PG8_LDA(At, 0, 1); PG8_STAGE(PG8_SB(0, 0), b2, voffB); PG8_STAGE(PG8_SB(0, 1), b2 + hstep, voffB); PG8_STAGE(PG8_SA(0, 0), a2, voffA);
            PG8_WAIT_V(8); PG8_WAIT_L(0); PG8_BAR; PG8_MMA(1, 0, At, B0); PG8_MMA(1, 1, At, B1); PG8_BAR; PG8_SCHED;
            PG8_LDB(B0, 1, 0); PG8_LDB(B1, 1, 1); PG8_SCHED; PG8_LDA(At, 1, 0); PG8_STAGE(PG8_SA(0, 1), a2 + hstep, voffA);
            PG8_WAIT_V(8); PG8_WAIT_L(0); PG8_BAR; PG8_MMA(0, 0, At, B0); PG8_MMA(0, 1, At, B1); PG8_BAR; PG8_SCHED;
            PG8_LDA(At, 1, 1); PG8_STAGE(PG8_SB(1, 0), b3, voffB); PG8_STAGE(PG8_SB(1, 1), b3 + hstep, voffB); PG8_STAGE(PG8_SA(1, 0), a3, voffA);
            PG8_WAIT_V(8); PG8_WAIT_L(0); PG8_BAR; PG8_MMA(1, 0, At, B0); PG8_MMA(1, 1, At, B1); PG8_BAR; PG8_SCHED;
            } else {
            PG8_LDB(B0, 0, 0); PG8_SCHED; PG8_LDA(At, 0, 0); PG8_STAGE(PG8_SA(1, 1), a1 + hstep, voffA);
            PG8_WAIT_L(8); PG8_BAR; PG8_WAIT_L(0); PG8_MMA(0, 0, At, B0); PG8_BAR; PG8_SCHED;
            PG8_LDB(B1, 0, 1); PG8_STAGE(PG8_SB(0, 0), b2, voffB);
            PG8_BAR; PG8_WAIT_L(0); PG8_MMA(0, 1, At, B1); PG8_BAR;
            PG8_LDA(At, 0, 1); PG8_STAGE(PG8_SA(0, 0), a2, voffA);
            PG8_BAR; PG8_WAIT_L(0); PG8_MMA(1, 0, At, B0); PG8_BAR; PG8_SCHED;
            PG8_STAGE(PG8_SB(0, 1), b2 + hstep, voffB);
            PG8_WAIT_V(6); PG8_BAR; PG8_MMA(1, 1, At, B1); PG8_BAR;
            PG8_LDB(B0, 1, 0); PG8_SCHED; PG8_LDA(At, 1, 0); PG8_STAGE(PG8_SA(0, 1), a2 + hstep, voffA);
            PG8_WAIT_L(8); PG8_BAR; PG8_WAIT_L(0); PG8_MMA(0, 0, At, B0); PG8_BAR; PG8_SCHED;
            PG8_LDB(B1, 1, 1); PG8_STAGE(PG8_SB(1, 0), b3, voffB);
            PG8_BAR; PG8_WAIT_L(0); PG8_MMA(0, 1, At, B1); PG8_BAR;
            PG8_LDA(At, 1, 1); PG8_STAGE(PG8_SA(1, 0), a3, voffA);
            PG8_BAR; PG8_WAIT_L(0); PG8_MMA(1, 0, At, B0); PG8_BAR; PG8_SCHED;
            PG8_STAGE(PG8_SB(1, 1), b3 + hstep, voffB);
            PG8_WAIT_V(6); PG8_BAR; PG8_MMA(1, 1, At, B1); PG8_BAR;
            }
        }
        if constexpr (ALIGN_EPI) { if (wr == 0) PG8_BAR; }
        if constexpr (!Epi::AFTER_DRAIN) { E(acc, cur, wr, wc, fr, fq); S.done(cur); }
        if (!has_next) break;
#pragma unroll
        for (int a = 0; a < 2; ++a)
#pragma unroll
            for (int b = 0; b < 2; ++b)
#pragma unroll
                for (int m = 0; m < 4; ++m)
#pragma unroll
                    for (int n = 0; n < 2; ++n) acc[a][b][m][n] = (f32x4){0.f, 0.f, 0.f, 0.f};
        cur = nxt; cA = nA; cB = nB; ++ui;
        if constexpr (ALIGN_EPI) { if (wr == 1) PG8_BAR; }
    }
    PG8_WAIT_V(0);
    if constexpr (!ALIGN_EPI) { if (wr == 0) PG8_BAR; }
    PG8_BAR;
    if constexpr (Epi::AFTER_DRAIN) { E.fused(acc, cur, wr, wc, fr, fq, lds, wid, lane); S.done(cur); }
#undef PG8_SA
#undef PG8_SB
#undef PG8_STAGE
#undef PG8_LDA
#undef PG8_LDB
#undef PG8_MMA
#undef PG8_WAIT_V
#undef PG8_WAIT_L
#undef PG8_BAR
#undef PG8_SCHED
}
}

constexpr int DM = 4096, SEQ = 16384, DBATCH = 16, DSEQ = 32, PAST = 4096, HD = 128, NH = 8, DSB = 1024, DLRU = 3072, NBLK = 16, BD = 192, DIN = 9216, DFF = 12288;
constexpr int MP = SEQ, MS = DBATCH * DSEQ, M = MP + MS;
constexpr float EPS = 1e-6f;
constexpr int NWAVES = 8;
#ifndef MK_PER_PHASE
#define MK_PER_PHASE 0
#endif
#ifndef MK_GRID
#define MK_GRID 0
#endif

constexpr size_t O_Y = 0, O_KP = (size_t)M * DM, O_VP = O_KP + (size_t)MP * DSB, O_HP = O_VP + (size_t)MP * DSB, O_CP = O_HP + DLRU, O_FP = O_CP + 3 * DLRU,
                 O_KS = O_FP + 2 * DFF, O_VS = O_KS + (size_t)MS * DSB, O_HS = O_VS + (size_t)MS * DSB, O_CS = O_HS + (size_t)DBATCH * DLRU, O_FS = O_CS + (size_t)DBATCH * 3 * DLRU,
                 O_END = O_FS + (size_t)DBATCH * 2 * DFF;
static_assert(O_END == 104435712, "d_out size");

constexpr size_t MiB = 1u << 20;
constexpr size_t WS_CTL = 0, CTL_ZERO_BYTES = 1 * MiB;
constexpr size_t WS_WA = 1 * MiB, WS_WX = WS_WA + (size_t)NBLK * BD * BD * 2;
constexpr size_t WS_AGGA = 4 * MiB, WS_AGGB = 7 * MiB;
constexpr size_t WS_C8 = 10 * MiB, WS_SSQ2 = 1292 * MiB, WS_S2 = 10 * MiB + 65536, WS_SSQS = 11 * MiB, WS_CARRY = 12 * MiB;
constexpr size_t WS_DUMP = 15 * MiB;
constexpr size_t WS_HALO = 832 * MiB, WS_DEFC = 840 * MiB, WS_DEFV = 848 * MiB;
constexpr size_t WS_Z = 970 * MiB;
constexpr size_t WS_WDOWN = 16 * MiB, WS_WUP = 112 * MiB, WS_BUFA = 304 * MiB, WS_ACT = 436 * MiB, WS_VALPRE = 832 * MiB, WS_PART = 1228 * MiB, WS_END = 1294 * MiB;
constexpr size_t WS_WIN = 436 * MiB, WS_WOUT = 508 * MiB, WS_U = 540 * MiB, WS_G = 639 * MiB, WS_QN = 738 * MiB, WS_KN = 771 * MiB, WS_VB = 804 * MiB, WS_Y = 837 * MiB;
static_assert(WS_SSQ2 + (size_t)M * 16 * 4 <= 1294 * MiB && WS_WX + (size_t)NBLK * BD * BD * 2 <= WS_AGGA && WS_SSQS + (size_t)M * 8 * 4 <= WS_CARRY && WS_CARRY + (size_t)256 * DLRU * 4 <= WS_WDOWN, "ws map (small)");
static_assert(WS_Z >= WS_Y + (size_t)M * DM * 2 && WS_Z + (size_t)MP * DLRU * 2 <= WS_PART, "ws map (Z)");
static_assert(WS_WDOWN + (size_t)DM * DFF * 2 <= WS_WUP && WS_WUP + (size_t)2 * DFF * DM * 2 <= WS_BUFA && WS_BUFA + (size_t)M * DM * 2 <= WS_ACT, "ws map (weights)");
static_assert(WS_ACT + (size_t)M * DFF * 2 <= WS_VALPRE && WS_VALPRE + (size_t)M * DFF * 2 <= WS_PART && WS_PART + (size_t)8 * MS * DM * 4 <= WS_SSQ2, "ws map (ffn)");
static_assert(WS_WIN + (size_t)DIN * DM * 2 <= WS_WOUT && WS_WOUT + (size_t)DM * DM * 2 <= WS_U && WS_U + (size_t)M * DLRU * 2 <= WS_G && WS_G + (size_t)M * DLRU * 2 <= WS_QN, "ws map (early 1)");
static_assert(WS_QN + (size_t)M * DSB * 2 <= WS_KN && WS_KN + (size_t)M * DSB * 2 <= WS_VB && WS_VB + (size_t)M * DSB * 2 <= WS_Y && WS_Y + (size_t)M * DM * 2 <= WS_PART, "ws map (early 2)");
constexpr int CW_TMO = 0, CW_CODE = 1, CW_Q1 = 64, CW_Q2 = 128, CW_DONE = 192, CW_BAR = 4096;

constexpr int RING_OFF = 0, RING_BYTES = 131072;
constexpr int EPI_OFF = RING_BYTES, EPI_BYTES = 8192;
constexpr int LDSCTL_OFF = EPI_OFF + EPI_BYTES, MISC_OFF = LDSCTL_OFF + 320;
constexpr int LDS_BYTES = 147456;
static_assert(MISC_OFF + 128 <= LDS_BYTES, "LDS map");

#define GAS __attribute__((address_space(1)))
#define LAS __attribute__((address_space(3)))
typedef unsigned short bf16;
typedef unsigned v4u __attribute__((ext_vector_type(4)));
typedef unsigned v2u __attribute__((ext_vector_type(2)));
typedef float f32x4 __attribute__((ext_vector_type(4)));
typedef short bf16x8 __attribute__((ext_vector_type(8)));
typedef GAS unsigned gu32;
#define RLX_AGENT __ATOMIC_RELAXED, __HIP_MEMORY_SCOPE_AGENT
#define LDS_WAIT() asm volatile("s_waitcnt lgkmcnt(0)" ::: "memory")
#define VM_WAIT() asm volatile("s_waitcnt vmcnt(0)" ::: "memory")
#define WG_BAR() do { asm volatile("s_waitcnt lgkmcnt(0)" ::: "memory"); __builtin_amdgcn_s_barrier(); asm volatile("" ::: "memory"); } while (0)
using pg8::cvt_pk_bf16;
__device__ __forceinline__ float bflo(unsigned w) { return __builtin_bit_cast(float, w << 16); }
__device__ __forceinline__ float bfhi(unsigned w) { return __builtin_bit_cast(float, w & 0xffff0000u); }
__device__ __forceinline__ float fexp2(float x) { return __builtin_amdgcn_exp2f(x); }
__device__ __forceinline__ float flog2(float x) { return __builtin_amdgcn_logf(x); }
__device__ __forceinline__ float frcp(float x) { return __builtin_amdgcn_rcpf(x); }
__device__ __forceinline__ float sigmoidf_(float x) { return frcp(1.0f + fexp2(-1.4426950408889634f * x)); }
__device__ __forceinline__ float gelu_tanh(float x) { const float u = x * (1.0f + 0.044715f * x * x); return x * frcp(1.0f + fexp2(-2.302208198f * u)); }
typedef float f32x2 __attribute__((ext_vector_type(2)));
__device__ __forceinline__ f32x2 gelu_tanh2(f32x2 x) {
    const f32x2 t = (x * x) * (-2.302208198f * 0.044715f) + (-2.302208198f), a = x * t;
    f32x2 e; e.x = fexp2(a.x); e.y = fexp2(a.y);
    const f32x2 d = e + 1.0f;
    f32x2 r; r.x = frcp(d.x); r.y = frcp(d.y);
    return x * r;
}
__device__ __forceinline__ f32x2 sigmoid2(f32x2 x) { const f32x2 a = x * (-1.4426950408889634f); f32x2 e; e.x = fexp2(a.x); e.y = fexp2(a.y); const f32x2 d = e + 1.0f; f32x2 r; r.x = frcp(d.x); r.y = frcp(d.y); return r; }
__device__ __forceinline__ float wave_sum(float v) {
#pragma unroll
    for (int o = 1; o < 64; o <<= 1) v += __shfl_xor(v, o);
    return v;
}
template <int S> __device__ __forceinline__ float dpp_ror(float v) {
    return __builtin_bit_cast(float, __builtin_amdgcn_update_dpp(0, __builtin_bit_cast(int, v), 0x120 + S, 0xF, 0xF, true));
}
template <int S> __device__ __forceinline__ float dpp_shr(float oldv, float v) {
    return __builtin_bit_cast(float, __builtin_amdgcn_update_dpp(__builtin_bit_cast(int, oldv), __builtin_bit_cast(int, v), 0x110 + S, 0xF, 0xF, false));
}
__device__ __forceinline__ void row_scan_ab(float& a, float& b) {
    { const float ap = dpp_shr<1>(1.0f, a), bp = dpp_shr<1>(0.0f, b); b = a * bp + b; a = a * ap; }
    { const float ap = dpp_shr<2>(1.0f, a), bp = dpp_shr<2>(0.0f, b); b = a * bp + b; a = a * ap; }
    { const float ap = dpp_shr<4>(1.0f, a), bp = dpp_shr<4>(0.0f, b); b = a * bp + b; a = a * ap; }
    { const float ap = dpp_shr<8>(1.0f, a), bp = dpp_shr<8>(0.0f, b); b = a * bp + b; a = a * ap; }
}

#define SCAN_STEP_(S) \
    "v_fmac_f32_dpp %0, %0, %4 row_shr:" #S " row_mask:0xf bank_mask:0xf\n\t" "v_fmac_f32_dpp %1, %1, %5 row_shr:" #S " row_mask:0xf bank_mask:0xf\n\t" \
    "v_fmac_f32_dpp %2, %2, %6 row_shr:" #S " row_mask:0xf bank_mask:0xf\n\t" "v_fmac_f32_dpp %3, %3, %7 row_shr:" #S " row_mask:0xf bank_mask:0xf\n\t" \
    "v_mul_f32_dpp %4, %4, %4 row_shr:" #S " row_mask:0xf bank_mask:0xf\n\t" "v_mul_f32_dpp %5, %5, %5 row_shr:" #S " row_mask:0xf bank_mask:0xf\n\t" \
    "v_mul_f32_dpp %6, %6, %6 row_shr:" #S " row_mask:0xf bank_mask:0xf\n\t" "v_mul_f32_dpp %7, %7, %7 row_shr:" #S " row_mask:0xf bank_mask:0xf\n\t"
__device__ __forceinline__ void row_scan_ab4(f32x4& a, f32x4& b) {
    float a0 = a[0], a1 = a[1], a2 = a[2], a3 = a[3], b0 = b[0], b1 = b[1], b2 = b[2], b3 = b[3];
    asm volatile("s_nop 1\n\t" SCAN_STEP_(1) SCAN_STEP_(2) SCAN_STEP_(4) SCAN_STEP_(8) "s_nop 0"
                 : "+v"(b0), "+v"(b1), "+v"(b2), "+v"(b3), "+v"(a0), "+v"(a1), "+v"(a2), "+v"(a3));
    a = (f32x4){a0, a1, a2, a3}; b = (f32x4){b0, b1, b2, b3};
}

#define XB_TMO      128
#define XB_XCNT(j)  (256  + 64 * (j))
#define XB_XSUB(j)  (1280 + 64 * (j))
#define XB_XGEN(j)  (2304 + 64 * (j))
#define XB_TOP      3328
#define XB_TOPGEN   3392
#define XCD_BAR_WORDS 3456
#define XB_SPIN_CAP (1u << 18)

__device__ __forceinline__ unsigned xb_ld(unsigned* p)              { return __hip_atomic_load(p, __ATOMIC_RELAXED, __HIP_MEMORY_SCOPE_AGENT); }
__device__ __forceinline__ unsigned xb_add(unsigned* p, unsigned v) { return __hip_atomic_fetch_add(p, v, __ATOMIC_RELAXED, __HIP_MEMORY_SCOPE_AGENT); }
__device__ __forceinline__ unsigned xb_xcc_id() { return (unsigned)__builtin_amdgcn_s_getreg((3 << 11) | 20) & 0xFu; }
#define XB_SPIN(cond, bar) do { unsigned _sp = 0; while (cond) { __builtin_amdgcn_s_sleep(1); \
    if ((++_sp & 255u) == 0u) { if (xb_ld(&(bar)[XB_TMO])) break; if (_sp > XB_SPIN_CAP) { atomicAdd(&(bar)[XB_TMO], 1u); break; } } } } while (0)

struct XcdBarrier {
    unsigned* bar; unsigned x;
    volatile LAS unsigned* st;
};

__device__ __forceinline__ XcdBarrier xcd_barrier_post(unsigned* bar, volatile LAS unsigned* st) {
    XcdBarrier b; b.bar = bar; b.x = xb_xcc_id(); b.st = st;
    if (threadIdx.x == 0) (void)xb_add(&bar[XB_XCNT(b.x)], 1u);
    return b;
}
__device__ __forceinline__ void xcd_barrier_complete(unsigned* bar, unsigned x, unsigned& nloc, unsigned& nx) {
    const unsigned G = gridDim.x * gridDim.y * gridDim.z;
    unsigned sum, cnt, mine, sp = 0u;
    for (;;) {
        sum = 0u; cnt = 0u; mine = 0u;
#pragma unroll
        for (unsigned j = 0; j < 16; ++j) { const unsigned c = xb_ld(&bar[XB_XCNT(j)]); sum += c; cnt += (c > 0u) ? 1u : 0u; mine = (j == x) ? c : mine; }
        if (sum == G) break;
        __builtin_amdgcn_s_sleep(1);
        if ((++sp & 255u) == 0u) { if (xb_ld(&bar[XB_TMO])) break; if (sp > XB_SPIN_CAP) { atomicAdd(&bar[XB_TMO], 1u); break; } }
    }
    nloc = mine > 0u ? mine : 1u; nx = cnt > 0u ? cnt : 1u;
}

__device__ __forceinline__ void xcd_barrier(const XcdBarrier& b) {
    asm volatile("s_waitcnt vmcnt(0)" ::: "memory");
    __syncthreads();
    if (threadIdx.x == 0) {
        unsigned* bar = b.bar;
        __builtin_amdgcn_s_waitcnt(0);
        unsigned nloc = b.st[0], nx = b.st[1];
        if (nloc == 0u) { xcd_barrier_complete(bar, b.x, nloc, nx); b.st[0] = nloc; b.st[1] = nx; }
        const unsigned old = xb_add(&bar[XB_XSUB(b.x)], 1u);
        const unsigned gen = old / nloc;
        if (old + 1u == (gen + 1u) * nloc) {
            __builtin_amdgcn_fence(__ATOMIC_RELEASE, "agent");
            asm volatile("s_waitcnt vmcnt(0)" ::: "memory");
            const unsigned og = xb_add(&bar[XB_TOP], 1u);
            const unsigned tg = og / nx;
            if (og + 1u == (tg + 1u) * nx) xb_add(&bar[XB_TOPGEN], 1u);
            else XB_SPIN(xb_ld(&bar[XB_TOPGEN]) == tg, bar);
            __builtin_amdgcn_fence(__ATOMIC_ACQUIRE, "agent");
            xb_add(&bar[XB_XGEN(b.x)], 1u);
            asm volatile("s_waitcnt vmcnt(0)" ::: "memory");
        } else {
            XB_SPIN(xb_ld(&bar[XB_XGEN(b.x)]) == gen, bar);
            __builtin_amdgcn_fence(__ATOMIC_ACQUIRE, "agent");
            asm volatile("s_waitcnt vmcnt(0)" ::: "memory");
        }
    }
    __syncthreads();
}
constexpr size_t WS_X1 = WS_Z;
static_assert(WS_X1 >= WS_Y + (size_t)M * DM * 2 && WS_X1 + (size_t)MP * DM * 2 <= WS_PART, "ws map (X1)");

struct Args { const float* in[26]; float* out; unsigned char* ws; int ph_lo, ph_hi, li, pad; };
struct Frame {
    LAS unsigned char* lds;
    volatile LAS unsigned* MISC;
    gu32* ctl;
    int tid, lane, wave, vcu, G;
    const Args* a;
    __device__ __forceinline__ const float* x_p() const { return a->in[0]; }
    __device__ __forceinline__ const float* x_s() const { return a->in[1]; }
    __device__ __forceinline__ const float* cache_k() const { return a->in[2]; }
    __device__ __forceinline__ const float* cache_v() const { return a->in[3]; }
    __device__ __forceinline__ const float* st_h() const { return a->in[4]; }
    __device__ __forceinline__ const float* st_conv() const { return a->in[5]; }
    __device__ __forceinline__ const float* st_ffn() const { return a->in[6]; }
    __device__ __forceinline__ const float* g_mix() const { return a->in[7]; }
    __device__ __forceinline__ const float* w_in() const { return a->in[8]; }
    __device__ __forceinline__ const float* cw() const { return a->in[9]; }
    __device__ __forceinline__ const float* cb() const { return a->in[10]; }
    __device__ __forceinline__ const float* w_a() const { return a->in[11]; }
    __device__ __forceinline__ const float* b_a() const { return a->in[12]; }
    __device__ __forceinline__ const float* w_x() const { return a->in[13]; }
    __device__ __forceinline__ const float* b_x() const { return a->in[14]; }
    __device__ __forceinline__ const float* lam() const { return a->in[15]; }
    __device__ __forceinline__ const float* qg() const { return a->in[16]; }
    __device__ __forceinline__ const float* kg() const { return a->in[17]; }
    __device__ __forceinline__ const float* g_lru() const { return a->in[18]; }
    __device__ __forceinline__ const float* g_sb() const { return a->in[19]; }
    __device__ __forceinline__ const float* w_out() const { return a->in[20]; }
    __device__ __forceinline__ const float* g_ffn() const { return a->in[21]; }
    __device__ __forceinline__ const float* w_up() const { return a->in[22]; }
    __device__ __forceinline__ const float* fcw() const { return a->in[23]; }
    __device__ __forceinline__ const float* fcb() const { return a->in[24]; }
    __device__ __forceinline__ const float* w_down() const { return a->in[25]; }
    __device__ __forceinline__ float* out() const { return a->out; }
    __device__ __forceinline__ bf16* Wa_t() const { return (bf16*)(a->ws + WS_WA); }
    __device__ __forceinline__ bf16* Wx_t() const { return (bf16*)(a->ws + WS_WX); }
    __device__ __forceinline__ bf16* Win_t() const { return (bf16*)(a->ws + WS_WIN); }
    __device__ __forceinline__ bf16* Wout_t() const { return (bf16*)(a->ws + WS_WOUT); }
    __device__ __forceinline__ bf16* Wup_t() const { return (bf16*)(a->ws + WS_WUP); }
    __device__ __forceinline__ bf16* Wdown_t() const { return (bf16*)(a->ws + WS_WDOWN); }
    __device__ __forceinline__ bf16* BUFA() const { return (bf16*)(a->ws + WS_BUFA); }
    __device__ __forceinline__ bf16* ACT() const { return (bf16*)(a->ws + WS_ACT); }
    __device__ __forceinline__ bf16* VALPRE() const { return (bf16*)(a->ws + WS_VALPRE); }
    __device__ __forceinline__ bf16* U() const { return (bf16*)(a->ws + WS_U); }
    __device__ __forceinline__ bf16* Gt() const { return (bf16*)(a->ws + WS_G); }
    __device__ __forceinline__ bf16* Qn() const { return (bf16*)(a->ws + WS_QN); }
    __device__ __forceinline__ bf16* Kn() const { return (bf16*)(a->ws + WS_KN); }
    __device__ __forceinline__ bf16* Vb() const { return (bf16*)(a->ws + WS_VB); }
    __device__ __forceinline__ bf16* Y() const { return (bf16*)(a->ws + WS_Y); }
    __device__ __forceinline__ float* AggA() const { return (float*)(a->ws + WS_AGGA); }
    __device__ __forceinline__ float* AggB() const { return (float*)(a->ws + WS_AGGB); }
    __device__ __forceinline__ float* C8() const { return (float*)(a->ws + WS_C8); }
    __device__ __forceinline__ float* Carry() const { return (float*)(a->ws + WS_CARRY); }
    __device__ __forceinline__ bf16* Z() const { return (bf16*)(a->ws + WS_Z); }
    __device__ __forceinline__ float* Part() const { return (float*)(a->ws + WS_PART); }
    __device__ __forceinline__ bf16* X1() const { return (bf16*)(a->ws + WS_X1); }
    __device__ __forceinline__ float* Halo() const { return (float*)(a->ws + WS_HALO); }
    __device__ __forceinline__ float* DefC() const { return (float*)(a->ws + WS_DEFC); }
    __device__ __forceinline__ float* DefV() const { return (float*)(a->ws + WS_DEFV); }
    __device__ __forceinline__ float* SsqS() const { return (float*)(a->ws + WS_SSQS); }
};

constexpr int TR_WAVE_BYTES = 64 * 65 * 4;
static_assert(NWAVES * TR_WAVE_BYTES <= RING_BYTES + EPI_BYTES, "transposer scratch");
template <bool NT = false> __device__ __forceinline__ void p0_transpose_item(const float* W, int K, int N, bf16* WT, int k0, int n0, int drow, LAS float* scr, int lane) {
    float tv[64];
#pragma unroll
    for (int i = 0; i < 64; ++i) tv[i] = __builtin_nontemporal_load(W + (size_t)(k0 + i) * N + n0 + lane);
#pragma unroll
    for (int i = 0; i < 64; ++i) scr[i * 65 + lane] = tv[i];
    LDS_WAIT(); asm volatile("" ::: "memory");
    const int c = lane & 7;
#pragma unroll
    for (int j = 0; j < 8; ++j) { const int n = (lane >> 3) + 8 * j; const LAS float* s = scr + (8 * c) * 65 + n;
        v4u o; o.x = cvt_pk_bf16(s[0 * 65], s[1 * 65]); o.y = cvt_pk_bf16(s[2 * 65], s[3 * 65]); o.z = cvt_pk_bf16(s[4 * 65], s[5 * 65]); o.w = cvt_pk_bf16(s[6 * 65], s[7 * 65]);
        if (NT) __builtin_nontemporal_store(o, (GAS v4u*)(WT + (size_t)(drow + n) * K + k0 + 8 * c)); else *(GAS v4u*)(WT + (size_t)(drow + n) * K + k0 + 8 * c) = o; }
    LDS_WAIT(); asm volatile("" ::: "memory");
}
#define TR_LOAD(tv, W, N, k0, n0) do { const float* _w = (W) + (size_t)(k0) * (N) + (n0) + lane; _Pragma("unroll") for (int i = 0; i < 64; ++i) tv[i] = __builtin_nontemporal_load(_w + (size_t)i * (N)); } while (0)
#define TR_FIN(tv, WT, K, k0, drow, NT) do { _Pragma("unroll") for (int i = 0; i < 64; ++i) scr[i * 65 + lane] = tv[i]; \
        LDS_WAIT(); asm volatile("" ::: "memory"); const int _c = lane & 7; \
        _Pragma("unroll") for (int j = 0; j < 8; ++j) { const int n = (lane >> 3) + 8 * j; const LAS float* sp = scr + (8 * _c) * 65 + n; \
            v4u o; o.x = cvt_pk_bf16(sp[0 * 65], sp[1 * 65]); o.y = cvt_pk_bf16(sp[2 * 65], sp[3 * 65]); o.z = cvt_pk_bf16(sp[4 * 65], sp[5 * 65]); o.w = cvt_pk_bf16(sp[6 * 65], sp[7 * 65]); \
            if (NT) __builtin_nontemporal_store(o, (GAS v4u*)((WT) + (size_t)((drow) + n) * (K) + (k0) + 8 * _c)); else *(GAS v4u*)((WT) + (size_t)((drow) + n) * (K) + (k0) + 8 * _c) = o; } \
        LDS_WAIT(); asm volatile("" ::: "memory"); } while (0)
#define TR_SB __builtin_amdgcn_sched_barrier(0)
__device__ __forceinline__ void rms_row_to_bf16(const float* xrow, const float* g, bf16* orow, int lane) {
    const GAS f32x4* xr = (const GAS f32x4*)xrow + lane;
    f32x4 v[16]; float s = 0.f;
#pragma unroll
    for (int j = 0; j < 16; ++j) { v[j] = __builtin_nontemporal_load(xr + 64 * j); s += (v[j].x * v[j].x + v[j].y * v[j].y) + (v[j].z * v[j].z + v[j].w * v[j].w); }
    const float rs = 1.0f / sqrtf(wave_sum(s) * (1.0f / DM) + EPS);
    const GAS f32x4* gr = (const GAS f32x4*)g + lane;
    GAS v2u* o8 = (GAS v2u*)orow + lane;
#pragma unroll
    for (int j = 0; j < 16; ++j) { const f32x4 gv = gr[64 * j]; v2u o; o.x = cvt_pk_bf16(v[j].x * rs * gv.x, v[j].y * rs * gv.y); o.y = cvt_pk_bf16(v[j].z * rs * gv.z, v[j].w * rs * gv.w); o8[64 * j] = o; }
}
__device__ __forceinline__ void rms_row_bf16_to_bf16(const bf16* xrow, const float* g, bf16* orow, int lane) {
    const GAS v4u* xr = (const GAS v4u*)xrow + lane;
    v4u v[8]; float s = 0.f;
#pragma unroll
    for (int j = 0; j < 8; ++j) { v[j] = __builtin_nontemporal_load(xr + 64 * j);
        const float a0 = bflo(v[j].x), a1 = bfhi(v[j].x), a2 = bflo(v[j].y), a3 = bfhi(v[j].y), a4 = bflo(v[j].z), a5 = bfhi(v[j].z), a6 = bflo(v[j].w), a7 = bfhi(v[j].w);
        s += ((a0 * a0 + a1 * a1) + (a2 * a2 + a3 * a3)) + ((a4 * a4 + a5 * a5) + (a6 * a6 + a7 * a7)); }
    const float rs = 1.0f / sqrtf(wave_sum(s) * (1.0f / DM) + EPS);
    const GAS f32x4* gr = (const GAS f32x4*)g + 2 * lane;
    GAS v4u* o8 = (GAS v4u*)orow + lane;
#pragma unroll
    for (int j = 0; j < 8; ++j) { const f32x4 g0 = gr[128 * j], g1 = gr[128 * j + 1]; v4u o;
        o.x = cvt_pk_bf16(bflo(v[j].x) * rs * g0.x, bfhi(v[j].x) * rs * g0.y); o.y = cvt_pk_bf16(bflo(v[j].y) * rs * g0.z, bfhi(v[j].y) * rs * g0.w);
        o.z = cvt_pk_bf16(bflo(v[j].z) * rs * g1.x, bfhi(v[j].z) * rs * g1.y); o.w = cvt_pk_bf16(bflo(v[j].w) * rs * g1.z, bfhi(v[j].w) * rs * g1.w); o8[64 * j] = o; }
}
__device__ __forceinline__ void sample_row_reduce(const float* base, const float* part, int rs, float* dst, const float* g, bf16* orow, int lane) {
    f32x4 v[16]; float s = 0.f;
#pragma unroll
    for (int j = 0; j < 16; ++j) v[j] = ((const GAS f32x4*)base)[lane + 64 * j];
#pragma unroll 2
    for (int ks = 0; ks < 8; ++ks) { const GAS f32x4* pr = (const GAS f32x4*)(part + ((size_t)ks * MS + rs) * DM) + lane;
#pragma unroll
        for (int j = 0; j < 16; ++j) v[j] = v[j] + pr[64 * j]; }
#pragma unroll
    for (int j = 0; j < 16; ++j) { ((GAS f32x4*)dst)[lane + 64 * j] = v[j]; s += (v[j].x * v[j].x + v[j].y * v[j].y) + (v[j].z * v[j].z + v[j].w * v[j].w); }
    if (orow) {
        const float rsn = 1.0f / sqrtf(wave_sum(s) * (1.0f / DM) + EPS);
        const GAS f32x4* gr = (const GAS f32x4*)g + lane; GAS v2u* o8 = (GAS v2u*)orow + lane;
#pragma unroll
        for (int j = 0; j < 16; ++j) { const f32x4 gv = gr[64 * j]; v2u o; o.x = cvt_pk_bf16(v[j].x * rsn * gv.x, v[j].y * rsn * gv.y); o.y = cvt_pk_bf16(v[j].z * rsn * gv.z, v[j].w * rsn * gv.w); o8[64 * j] = o; }
    }
}
__device__ __forceinline__ void hn_rows(Frame& F) {
    const int gw = F.vcu * NWAVES + F.wave, NGW = F.G * NWAVES, lane = F.lane, nfull = M / NGW;
    int m = gw;
    if (nfull >= 2 && (nfull & 1) == 0) {
        f32x4 va[16], vb[16];
        LAS f32x4* gl = (LAS f32x4*)(F.lds + RING_OFF + F.wave * TR_WAVE_BYTES) + lane;
#define HN_LOAD(v, mm) do { const int _m = (mm); const GAS f32x4* _x = (const GAS f32x4*)(_m < MP ? F.x_p() + (size_t)_m * DM : F.x_s() + (size_t)(_m - MP) * DM) + lane; \
        _Pragma("unroll") for (int j = 0; j < 16; ++j) v[j] = __builtin_nontemporal_load(_x + 64 * j); } while (0)
#define HN_FIN(v, mm) do { float _s = 0.f; _Pragma("unroll") for (int j = 0; j < 16; ++j) _s += (v[j].x * v[j].x + v[j].y * v[j].y) + (v[j].z * v[j].z + v[j].w * v[j].w); \
        const float _rs = 1.0f / sqrtf(wave_sum(_s) * (1.0f / DM) + EPS); GAS v2u* _o = (GAS v2u*)(F.BUFA() + (size_t)(mm) * DM) + lane; \
        LAS f32x4* _g = gl; asm volatile("" : "+v"(_g));     \
        _Pragma("unroll") for (int j = 0; j < 16; ++j) { const f32x4 g = _g[64 * j]; v2u o; o.x = cvt_pk_bf16(v[j].x * _rs * g.x, v[j].y * _rs * g.y); o.y = cvt_pk_bf16(v[j].z * _rs * g.z, v[j].w * _rs * g.w); _o[64 * j] = o; } } while (0)
        HN_LOAD(va, m); __builtin_amdgcn_sched_barrier(0);
        { const GAS f32x4* gr = (const GAS f32x4*)F.g_mix() + lane;
#pragma unroll
          for (int j = 0; j < 16; ++j) gl[64 * j] = gr[64 * j]; }
        LDS_WAIT(); asm volatile("" ::: "memory");
        for (int k = 0; k + 2 < nfull; k += 2) { HN_LOAD(vb, m + NGW); __builtin_amdgcn_sched_barrier(0); HN_FIN(va, m); __builtin_amdgcn_sched_barrier(0); HN_LOAD(va, m + 2 * NGW); __builtin_amdgcn_sched_barrier(0); HN_FIN(vb, m + NGW); __builtin_amdgcn_sched_barrier(0); m += 2 * NGW; }
        HN_LOAD(vb, m + NGW); __builtin_amdgcn_sched_barrier(0); HN_FIN(va, m); __builtin_amdgcn_sched_barrier(0); HN_FIN(vb, m + NGW); m += 2 * NGW;
#undef HN_LOAD
#undef HN_FIN
    }
    if (NGW == 2048 && m == nfull * NGW + gw) m = (F.wave < 2) ? nfull * NGW + F.wave * F.G + F.vcu : M;
    for (; m < M; m += NGW) rms_row_to_bf16(m < MP ? F.x_p() + (size_t)m * DM : F.x_s() + (size_t)(m - MP) * DM, F.g_mix(), F.BUFA() + (size_t)m * DM, lane);
}
__device__ __forceinline__ void hn2_rows(Frame& F) {
    const int gw = F.vcu * NWAVES + F.wave, NGW = F.G * NWAVES, lane = F.lane, nfull = MP / NGW;
    int m = gw;
    if (nfull >= 2 && (nfull & 1) == 0) {
        v4u va[8], vb[8];
        LAS f32x4* gl = (LAS f32x4*)(F.lds + RING_OFF + F.wave * TR_WAVE_BYTES);

#define H2_LOAD(v, mm) do { const GAS v4u* _x = (const GAS v4u*)(F.X1() + (size_t)(mm) * DM) + lane; _Pragma("unroll") for (int j = 0; j < 8; ++j) v[j] = __builtin_nontemporal_load(_x + 64 * j); } while (0)
#define H2_FIN(v, mm) do { float _s = 0.f; _Pragma("unroll") for (int j = 0; j < 8; ++j) { \
            const float a0 = bflo(v[j].x), a1 = bfhi(v[j].x), a2 = bflo(v[j].y), a3 = bfhi(v[j].y), a4 = bflo(v[j].z), a5 = bfhi(v[j].z), a6 = bflo(v[j].w), a7 = bfhi(v[j].w); \
            _s += ((a0 * a0 + a1 * a1) + (a2 * a2 + a3 * a3)) + ((a4 * a4 + a5 * a5) + (a6 * a6 + a7 * a7)); } \
        const float _rs = 1.0f / sqrtf(wave_sum(_s) * (1.0f / DM) + EPS); GAS v4u* _o = (GAS v4u*)(F.BUFA() + (size_t)(mm) * DM) + lane; \
        LAS f32x4* _g = gl; asm volatile("" : "+v"(_g)); \
        _Pragma("unroll") for (int j = 0; j < 8; ++j) { const f32x4 g0 = _g[128 * j], g1 = _g[128 * j + 1]; v4u o; \
            o.x = cvt_pk_bf16(bflo(v[j].x) * _rs * g0.x, bfhi(v[j].x) * _rs * g0.y); o.y = cvt_pk_bf16(bflo(v[j].y) * _rs * g0.z, bfhi(v[j].y) * _rs * g0.w); \
            o.z = cvt_pk_bf16(bflo(v[j].z) * _rs * g1.x, bfhi(v[j].z) * _rs * g1.y); o.w = cvt_pk_bf16(bflo(v[j].w) * _rs * g1.z, bfhi(v[j].w) * _rs * g1.w); _o[64 * j] = o; } } while (0)
        H2_LOAD(va, m); __builtin_amdgcn_sched_barrier(0);
        { const GAS f32x4* gr = (const GAS f32x4*)F.g_ffn() + lane;
#pragma unroll
          for (int j = 0; j < 16; ++j) gl[lane + 64 * j] = gr[64 * j]; }
        LDS_WAIT(); asm volatile("" ::: "memory");
        gl += 2 * lane;
        for (int k = 0; k + 2 < nfull; k += 2) { H2_LOAD(vb, m + NGW); __builtin_amdgcn_sched_barrier(0); H2_FIN(va, m); __builtin_amdgcn_sched_barrier(0); H2_LOAD(va, m + 2 * NGW); __builtin_amdgcn_sched_barrier(0); H2_FIN(vb, m + NGW); __builtin_amdgcn_sched_barrier(0); m += 2 * NGW; }
        H2_LOAD(vb, m + NGW); __builtin_amdgcn_sched_barrier(0); H2_FIN(va, m); __builtin_amdgcn_sched_barrier(0); H2_FIN(vb, m + NGW); m += 2 * NGW;
#undef H2_LOAD
#undef H2_FIN
    }
    for (; m < MP; m += NGW) rms_row_bf16_to_bf16(F.X1() + (size_t)m * DM, F.g_ffn(), F.BUFA() + (size_t)m * DM, lane);
}
__device__ __forceinline__ void p0_prologue(Frame& F) {
    LAS float* scr = (LAS float*)(F.lds + RING_OFF + F.wave * TR_WAVE_BYTES);
    const int gw = F.vcu * NWAVES + F.wave, NGW = F.G * NWAVES;
    constexpr int I_IN = (DM / 64) * (DIN / 64), I_G = NBLK * 3 * 3;
    constexpr int NITEMS = I_IN + 2 * I_G;
    int it0 = gw;
    if (4 * NGW <= I_IN) {
        const int lane = F.lane; constexpr int nb = DIN / 64; float ta[64], tb[64];
        const int i0 = gw, i1 = gw + NGW, i2 = gw + 2 * NGW, i3 = gw + 3 * NGW;
        TR_LOAD(ta, F.w_in(), DIN, 64 * (i0 / nb), 64 * (i0 % nb)); TR_SB;
        TR_LOAD(tb, F.w_in(), DIN, 64 * (i1 / nb), 64 * (i1 % nb)); TR_SB; TR_FIN(ta, F.Win_t(), DM, 64 * (i0 / nb), 64 * (i0 % nb), false); TR_SB;
        TR_LOAD(ta, F.w_in(), DIN, 64 * (i2 / nb), 64 * (i2 % nb)); TR_SB; TR_FIN(tb, F.Win_t(), DM, 64 * (i1 / nb), 64 * (i1 % nb), false); TR_SB;
        TR_LOAD(tb, F.w_in(), DIN, 64 * (i3 / nb), 64 * (i3 % nb)); TR_SB; TR_FIN(ta, F.Win_t(), DM, 64 * (i2 / nb), 64 * (i2 % nb), false); TR_SB;
        TR_FIN(tb, F.Win_t(), DM, 64 * (i3 / nb), 64 * (i3 % nb), false);
        it0 = gw + 4 * NGW;
    }
    if (4 * NGW <= I_IN && NGW == 2048 && NITEMS - 4 * NGW <= 6 * F.G) { const int j = (F.wave - 2) * F.G + F.vcu; it0 = (F.wave >= 2 && j < NITEMS - 4 * NGW) ? 4 * NGW + j : NITEMS; }
    for (int it = it0; it < NITEMS; it += NGW) {
        int r = it;
        if (r < I_IN) { const int nb = DIN / 64, kb = r / nb, n0 = 64 * (r % nb); p0_transpose_item(F.w_in(), DM, DIN, F.Win_t(), 64 * kb, n0, n0, scr, F.lane); continue; } r -= I_IN;
        { const int which = r / I_G; r -= which * I_G; const int blk = r / 9, q = r % 9, kb = q / 3, n0 = 64 * (q % 3);
          p0_transpose_item((which ? F.w_x() : F.w_a()) + (size_t)blk * BD * BD, BD, BD, (which ? F.Wx_t() : F.Wa_t()) + (size_t)blk * BD * BD, 64 * kb, n0, n0, scr, F.lane); }
    }
    if (gw < DLRU / 64) { const int ch = gw * 64 + F.lane; const float l = F.lam()[ch]; F.C8()[ch] = 8.0f * 1.4426950408889634f * (fminf(l, 0.f) - log1pf(expf(-fabsf(l)))); }
    hn_rows(F);
}

constexpr int NCONV = 16;
template <bool SECOND> __device__ __forceinline__ void conv_queue(Frame& F) {
    LAS float* scr = (LAS float*)(F.lds + RING_OFF + F.wave * TR_WAVE_BYTES);
    constexpr int I_OUT = (DM / 64) * (DM / 64), I_DN = (DFF / 64) * (DM / 64), I_UP = (DM / 64) * (2 * DFF / 64), I_DN1 = I_DN / 3, NIT = SECOND ? I_DN - I_DN1 : I_OUT + I_UP + I_DN1;
    for (;;) {
        int base = 0;
        if (F.lane == 0) base = (int)__hip_atomic_fetch_add((unsigned*)(F.ctl + (SECOND ? CW_Q2 : CW_Q1)), 4u, __ATOMIC_RELAXED, __HIP_MEMORY_SCOPE_AGENT);
        base = __builtin_amdgcn_readfirstlane(base);
        if (base >= NIT) break;
        for (int it = base; it < base + 4 && it < NIT; ++it) {
            int r = it;
            if (SECOND || r >= I_OUT + I_UP) { r = SECOND ? r + I_DN1 : r - (I_OUT + I_UP); const int nb = DM / 64, kb = r / nb, n0 = 64 * (r % nb); p0_transpose_item<true>(F.w_down(), DFF, DM, F.Wdown_t(), 64 * kb, n0, n0, scr, F.lane); continue; }
            if (r < I_OUT) { const int nb = DM / 64, kb = r / nb, n0 = 64 * (r % nb); p0_transpose_item<true>(F.w_out(), DM, DM, F.Wout_t(), 64 * kb, n0, n0, scr, F.lane); continue; } r -= I_OUT;
            { const int nb = 2 * DFF / 64, kb = r / nb, n0 = 64 * (r % nb);
              const int f = n0 < DFF ? n0 : n0 - DFF; const int drow = 256 * (f >> 7) + (n0 < DFF ? 0 : 128) + (f & 127);
              p0_transpose_item<true>(F.w_up(), DM, 2 * DFF, F.Wup_t(), 64 * kb, n0, drow, scr, F.lane); }
        }
    }
}

struct Epi1 {
    static constexpr bool PERM = true, AFTER_DRAIN = false;
    bf16 *U, *G, *Qn, *Kn, *Vb; float* out; const float *qg, *kg; LAS float* P;
    __device__ __forceinline__ void operator()(const f32x4 (&acc)[2][2][4][2], const pg8::Unit& u, int wr, int wc, int fr, int fq) const {
        const int pn = u.pn, row0 = u.pm * 256 + wr * 64 + fr, cw8 = wc * 32 + 8 * fq;
        if (pn < 24) {
            bf16* base = pn < 12 ? U : G; const int col0 = (pn < 12 ? pn : pn - 12) * 256 + cw8;
#pragma unroll
            for (int ai = 0; ai < 2; ++ai)
#pragma unroll
                for (int m = 0; m < 4; ++m) { const int row = row0 + ai * 128 + m * 16; bf16* rowp = base + (size_t)row * DLRU + col0;
#pragma unroll
                    for (int bj = 0; bj < 2; ++bj) { const f32x4 v0 = acc[ai][bj][m][0], v1 = acc[ai][bj][m][1];
                        v4u w; w.x = cvt_pk_bf16(v0[0], v0[1]); w.y = cvt_pk_bf16(v0[2], v0[3]); w.z = cvt_pk_bf16(v1[0], v1[1]); w.w = cvt_pk_bf16(v1[2], v1[3]);
                        *(v4u*)(rowp + bj * 128) = w; }
                    if (pn < 12) {
                        float* cdst = nullptr;
                        if (row < MP) { if (row >= MP - 3) cdst = out + O_CP + (size_t)(row - (MP - 3)) * DLRU; }
                        else { const int t = (row - MP) & 31, b = (row - MP) >> 5; if (t >= 29) cdst = out + O_CS + (size_t)(b * 3 + (t - 29)) * DLRU; }
                        if (cdst) {
#pragma unroll
                            for (int bj = 0; bj < 2; ++bj) { *(f32x4*)(cdst + col0 + bj * 128) = acc[ai][bj][m][0]; *(f32x4*)(cdst + col0 + bj * 128 + 4) = acc[ai][bj][m][1]; } }
                    } }
        } else if (pn < 32) {
            const bool isk = pn >= 28; const float* gp = isk ? kg : qg;
#pragma unroll
            for (int ai = 0; ai < 2; ++ai)
#pragma unroll
                for (int m = 0; m < 4; ++m)
#pragma unroll
                    for (int bj = 0; bj < 2; ++bj) { const f32x4 v0 = acc[ai][bj][m][0], v1 = acc[ai][bj][m][1];
                        float s = (v0[0] * v0[0] + v0[1] * v0[1]) + (v0[2] * v0[2] + v0[3] * v0[3]) + (v1[0] * v1[0] + v1[1] * v1[1]) + (v1[2] * v1[2] + v1[3] * v1[3]);
                        s += __shfl_xor(s, 16); s += __shfl_xor(s, 32);
                        if (fq == 0) P[((ai * 128 + wr * 64 + m * 16 + fr) * 2 + bj) * 4 + wc] = s; }
            WG_BAR();
            const f32x4 g0 = *(const f32x4*)(gp + cw8), g1 = *(const f32x4*)(gp + cw8 + 4);
            bf16* base = isk ? Kn : Qn; const int col0 = (pn - (isk ? 28 : 24)) * 256 + cw8;
#pragma unroll
            for (int ai = 0; ai < 2; ++ai)
#pragma unroll
                for (int m = 0; m < 4; ++m) { const int row = row0 + ai * 128 + m * 16; bf16* rowp = base + (size_t)row * DSB + col0;
                    float* kdst = isk ? (row < MP ? out + O_KP + (size_t)row * DSB : out + O_KS + (size_t)(row - MP) * DSB) + col0 : nullptr;
#pragma unroll
                    for (int bj = 0; bj < 2; ++bj) { const f32x4 p = *(const LAS f32x4*)(P + ((ai * 128 + wr * 64 + m * 16 + fr) * 2 + bj) * 4);
                        const float sc = 1.0f / sqrtf(((p[0] + p[1]) + (p[2] + p[3])) * (1.0f / HD) + EPS);
                        const f32x4 v0 = acc[ai][bj][m][0] * sc * g0, v1 = acc[ai][bj][m][1] * sc * g1;
                        v4u w; w.x = cvt_pk_bf16(v0[0], v0[1]); w.y = cvt_pk_bf16(v0[2], v0[3]); w.z = cvt_pk_bf16(v1[0], v1[1]); w.w = cvt_pk_bf16(v1[2], v1[3]);
                        *(v4u*)(rowp + bj * 128) = w;
                        if (isk) { __builtin_nontemporal_store(v0, (f32x4*)(kdst + bj * 128)); __builtin_nontemporal_store(v1, (f32x4*)(kdst + bj * 128 + 4)); } } }
        } else {
            const int col0 = (pn - 32) * 256 + cw8;
#pragma unroll
            for (int ai = 0; ai < 2; ++ai)
#pragma unroll
                for (int m = 0; m < 4; ++m) { const int row = row0 + ai * 128 + m * 16; bf16* rowp = Vb + (size_t)row * DSB + col0;
                    float* vdst = (row < MP ? out + O_VP + (size_t)row * DSB : out + O_VS + (size_t)(row - MP) * DSB) + col0;
#pragma unroll
                    for (int bj = 0; bj < 2; ++bj) { const f32x4 v0 = acc[ai][bj][m][0], v1 = acc[ai][bj][m][1];
                        v4u w; w.x = cvt_pk_bf16(v0[0], v0[1]); w.y = cvt_pk_bf16(v0[2], v0[3]); w.z = cvt_pk_bf16(v1[0], v1[1]); w.w = cvt_pk_bf16(v1[2], v1[3]);
                        *(v4u*)(rowp + bj * 128) = w; __builtin_nontemporal_store(v0, (f32x4*)(vdst + bj * 128)); __builtin_nontemporal_store(v1, (f32x4*)(vdst + bj * 128 + 4)); } }
        }
    }
};
template <int SECOND>
struct EpiRes {
    static constexpr bool PERM = true, AFTER_DRAIN = false;
    const float* xp; bf16* x1; float* out; float* part;
    __device__ __forceinline__ void operator()(const f32x4 (&acc)[2][2][4][2], const pg8::Unit& u, int wr, int wc, int fr, int fq) const {
        const int row0 = u.pm * 256 + wr * 64 + fr, col0 = u.pn * 256 + wc * 32 + 8 * fq;
        if (u.ks >= 0) {
#pragma unroll
            for (int ai = 0; ai < 2; ++ai)
#pragma unroll
                for (int m = 0; m < 4; ++m) { const int row = row0 + ai * 128 + m * 16; float* op = part + ((size_t)u.ks * MS + (row - MP)) * DM + col0;
#pragma unroll
                    for (int bj = 0; bj < 2; ++bj)
#pragma unroll
                        for (int n = 0; n < 2; ++n) *(f32x4*)(op + bj * 128 + n * 4) = acc[ai][bj][m][n]; }
            return;
        }
        if constexpr (SECOND == 0) {
#pragma unroll
            for (int ai = 0; ai < 2; ++ai) {
                f32x4 b[4][2][2];
#pragma unroll
                for (int m = 0; m < 4; ++m) { const float* bp = xp + (size_t)(row0 + ai * 128 + m * 16) * DM + col0;
#pragma unroll
                    for (int bj = 0; bj < 2; ++bj)
#pragma unroll
                        for (int n = 0; n < 2; ++n) b[m][bj][n] = *(const f32x4*)(bp + bj * 128 + n * 4); }
#pragma unroll
                for (int m = 0; m < 4; ++m) { bf16* op = x1 + (size_t)(row0 + ai * 128 + m * 16) * DM + col0;
#pragma unroll
                    for (int bj = 0; bj < 2; ++bj) { const f32x4 lo = b[m][bj][0] + acc[ai][bj][m][0], hi = b[m][bj][1] + acc[ai][bj][m][1];
                        v4u o; o.x = cvt_pk_bf16(lo.x, lo.y); o.y = cvt_pk_bf16(lo.z, lo.w); o.z = cvt_pk_bf16(hi.x, hi.y); o.w = cvt_pk_bf16(hi.z, hi.w); *(v4u*)(op + bj * 128) = o; } }
            }
        } else {
            v4u b[2][4][2];
#pragma unroll
            for (int ai = 0; ai < 2; ++ai)
#pragma unroll
                for (int m = 0; m < 4; ++m) { const bf16* bp = x1 + (size_t)(row0 + ai * 128 + m * 16) * DM + col0;
#pragma unroll
                    for (int bj = 0; bj < 2; ++bj) b[ai][m][bj] = __builtin_nontemporal_load((const v4u*)(bp + bj * 128)); }
#pragma unroll
            for (int ai = 0; ai < 2; ++ai)
#pragma unroll
                for (int m = 0; m < 4; ++m) { float* op = out + O_Y + (size_t)(row0 + ai * 128 + m * 16) * DM + col0;
#pragma unroll
                    for (int bj = 0; bj < 2; ++bj) { const v4u w = b[ai][m][bj];
                        const f32x4 lo = {bflo(w.x), bfhi(w.x), bflo(w.y), bfhi(w.y)}, hi = {bflo(w.z), bfhi(w.z), bflo(w.w), bfhi(w.w)};
                        *(f32x4*)(op + bj * 128) = lo + acc[ai][bj][m][0]; *(f32x4*)(op + bj * 128 + 4) = hi + acc[ai][bj][m][1]; } }
        }
    }
};
struct EpiUp {
    static constexpr bool PERM = true, AFTER_DRAIN = false;
    bf16* ACT; const float *fcw, *fcb, *st_ffn; float* out; float *halo, *defc, *defv; LAS float* HX;
    template <bool SMP> __device__ __forceinline__ void body(const f32x4 (&acc)[2][2][4][2], const pg8::Unit& u, int wr, int wc, int fr, int fq) const {
        const int pm = u.pm, cl = wc * 32 + 8 * fq, f0 = u.pn * 128 + cl;
        const f32x4 w0a = *(const f32x4*)(fcw + f0), w0b = *(const f32x4*)(fcw + f0 + 4), w1a = *(const f32x4*)(fcw + DFF + f0), w1b = *(const f32x4*)(fcw + DFF + f0 + 4);
        const f32x4 w2a = *(const f32x4*)(fcw + 2 * DFF + f0), w2b = *(const f32x4*)(fcw + 2 * DFF + f0 + 4), cba = *(const f32x4*)(fcb + f0), cbb = *(const f32x4*)(fcb + f0 + 4);
        if (!SMP && fr >= 14) {
#pragma unroll
            for (int ai = 0; ai < 2; ++ai) { LAS f32x4* hp = (LAS f32x4*)(HX + (((ai * 2 + wr) * 2 + (fr - 14)) * 128 + cl)); hp[0] = acc[ai][1][3][0]; hp[1] = acc[ai][1][3][1]; }
            if (wr == 1) { float* hd = (pm == MP / 256 - 1) ? out + O_FP + (size_t)(fr - 14) * DFF + f0 : halo + ((size_t)pm * 2 + (fr - 14)) * DFF + f0;
                *(f32x4*)hd = acc[1][1][3][0]; *(f32x4*)(hd + 4) = acc[1][1][3][1]; }
        }
        if (!SMP) WG_BAR();
        f32x4 R1pa, R1pb, R2pa, R2pb;
#pragma unroll
        for (int ai = 0; ai < 2; ++ai) {
#pragma unroll
            for (int m = 0; m < 4; ++m) {
                const int row = pm * 256 + ai * 128 + wr * 64 + m * 16 + fr;
                const f32x4 Pa = acc[ai][1][m][0], Pb = acc[ai][1][m][1], Va = acc[ai][0][m][0], Vb = acc[ai][0][m][1];
                f32x4 R1a, R1b, R2a, R2b;
#pragma unroll
                for (int j = 0; j < 4; ++j) { R1a[j] = dpp_ror<1>(Pa[j]); R1b[j] = dpp_ror<1>(Pb[j]); R2a[j] = dpp_ror<2>(Pa[j]); R2b[j] = dpp_ror<2>(Pb[j]); }
                if (m == 0 || (SMP && m == 2)) {
                    f32x4 B1a, B1b, B2a, B2b;
                    if (SMP) { const int b = (row - MP) >> 5; const float* s0 = st_ffn + (size_t)(b * 2) * DFF + f0; const float* s1 = s0 + DFF;
                        B2a = *(const f32x4*)s0; B2b = *(const f32x4*)(s0 + 4); B1a = *(const f32x4*)s1; B1b = *(const f32x4*)(s1 + 4);
                    } else if (ai == 0 && wr == 0) { B1a = B1b = B2a = B2b = (f32x4){0.f, 0.f, 0.f, 0.f};
                    } else { const int pg = ai * 2 + wr - 1; const LAS f32x4* h2 = (const LAS f32x4*)(HX + ((pg * 2 + 0) * 128 + cl)); const LAS f32x4* h1 = (const LAS f32x4*)(HX + ((pg * 2 + 1) * 128 + cl));
                        B2a = h2[0]; B2b = h2[1]; B1a = h1[0]; B1b = h1[1]; }
                    R1pa = B1a; R1pb = B1b; R2pa = (fr == 0) ? B2a : B1a; R2pb = (fr == 0) ? B2b : B1b;
                }
                const f32x4 p1a = (fr >= 1) ? R1a : R1pa, p1b = (fr >= 1) ? R1b : R1pb, p2a = (fr >= 2) ? R2a : R2pa, p2b = (fr >= 2) ? R2b : R2pb;
                const f32x4 ca = cba + (w0a * p2a + w1a * p1a) + w2a * Pa, cbv = cbb + (w0b * p2b + w1b * p1b) + w2b * Pb;
                f32x4 oa, ob;
                { const f32x2 g0 = gelu_tanh2((f32x2){ca[0], ca[1]}) * (f32x2){Va[0], Va[1]}, g1 = gelu_tanh2((f32x2){ca[2], ca[3]}) * (f32x2){Va[2], Va[3]};
                  const f32x2 g2 = gelu_tanh2((f32x2){cbv[0], cbv[1]}) * (f32x2){Vb[0], Vb[1]}, g3 = gelu_tanh2((f32x2){cbv[2], cbv[3]}) * (f32x2){Vb[2], Vb[3]};
                  oa = (f32x4){g0.x, g0.y, g1.x, g1.y}; ob = (f32x4){g2.x, g2.y, g3.x, g3.y}; }
                v4u q; q.x = cvt_pk_bf16(oa[0], oa[1]); q.y = cvt_pk_bf16(oa[2], oa[3]); q.z = cvt_pk_bf16(ob[0], ob[1]); q.w = cvt_pk_bf16(ob[2], ob[3]);
                *(v4u*)(ACT + (size_t)row * DFF + f0) = q;
                if (m == 0 && ai == 0) { if (!SMP && pm >= 1 && wr == 0 && fr < 2) { float* dc = defc + ((size_t)pm * 2 + fr) * DFF + f0; float* dv = defv + ((size_t)pm * 2 + fr) * DFF + f0;
                        *(f32x4*)dc = ca; *(f32x4*)(dc + 4) = cbv; *(f32x4*)dv = Va; *(f32x4*)(dv + 4) = Vb; } }
                if ((m & 1) && SMP && fr >= 14) { float* fd = out + O_FS + (size_t)(((row - MP) >> 5) * 2 + (fr - 14)) * DFF + f0; *(f32x4*)fd = Pa; *(f32x4*)(fd + 4) = Pb; }
                R1pa = R1a; R1pb = R1b; R2pa = R2a; R2pb = R2b;
            }
        }
    }
    __device__ __forceinline__ void operator()(const f32x4 (&acc)[2][2][4][2], const pg8::Unit& u, int wr, int wc, int fr, int fq) const {
        if (u.pm >= MP / 256) body<true>(acc, u, wr, wc, fr, fq); else body<false>(acc, u, wr, wc, fr, fq);
    }
};
struct EpiBf {
    static constexpr bool PERM = true, AFTER_DRAIN = false;
    bf16* O; int ldc;
    __device__ __forceinline__ void operator()(const f32x4 (&acc)[2][2][4][2], const pg8::Unit& u, int wr, int wc, int fr, int fq) const {
        const int row0 = u.pm * 256 + wr * 64 + fr, col0 = u.pn * 256 + wc * 32 + 8 * fq;
#pragma unroll
        for (int ai = 0; ai < 2; ++ai)
#pragma unroll
            for (int m = 0; m < 4; ++m) { bf16* rowp = O + (size_t)(row0 + ai * 128 + m * 16) * ldc + col0;
#pragma unroll
                for (int bj = 0; bj < 2; ++bj) { const f32x4 v0 = acc[ai][bj][m][0], v1 = acc[ai][bj][m][1];
                    v4u w; w.x = cvt_pk_bf16(v0[0], v0[1]); w.y = cvt_pk_bf16(v0[2], v0[3]); w.z = cvt_pk_bf16(v1[0], v1[1]); w.w = cvt_pk_bf16(v1[2], v1[3]);
                    *(v4u*)(rowp + bj * 128) = w; } }
    }
};

constexpr int UC_LD = 196;
constexpr int UC_TEAM_BYTES = 64 * UC_LD * 4;
static_assert(2 * UC_TEAM_BYTES <= RING_BYTES, "lru lds");
__device__ __forceinline__ void team_bar(LAS unsigned* cnt, unsigned& phase, int lane) {
    asm volatile("s_waitcnt lgkmcnt(0)" ::: "memory");
    ++phase;
    if (lane == 0) __hip_atomic_fetch_add(cnt, 1u, __ATOMIC_RELAXED, __HIP_MEMORY_SCOPE_WORKGROUP);
    while (__hip_atomic_load(cnt, __ATOMIC_RELAXED, __HIP_MEMORY_SCOPE_WORKGROUP) < 4u * phase) __builtin_amdgcn_s_sleep(1);
    asm volatile("" ::: "memory");
}
__device__ __forceinline__ void lru_unit(Frame& F, int chunk, int blk, LAS unsigned* tcnt, unsigned& tphase) {
    const int lane = F.lane, w = F.wave, fr = lane & 15, fq = lane >> 4, team = w >> 2, ttid = F.tid & 255;
    LAS float* UC = (LAS float*)(F.lds + RING_OFF + team * UC_TEAM_BYTES);
    const bool smp = chunk >= 256;
    const int row0 = smp ? MP + 64 * (chunk - 256) : 64 * chunk;
    const int chb = 192 * blk;
    const int cg = w & 3, cwl = 48 * cg;
    team_bar(tcnt, tphase, lane);
    if (ttid < 192) {
        const int cgp = ttid % 24, tg = ttid / 24, ch = chb + 8 * cgp, tok0 = 8 * tg;
        float wv[4][8], bv[8], xw[3][8];
#pragma unroll
        for (int k = 0; k < 4; ++k) { const f32x4 a = *(const f32x4*)(F.cw() + k * DLRU + ch), b = *(const f32x4*)(F.cw() + k * DLRU + ch + 4);
            wv[k][0] = a[0]; wv[k][1] = a[1]; wv[k][2] = a[2]; wv[k][3] = a[3]; wv[k][4] = b[0]; wv[k][5] = b[1]; wv[k][6] = b[2]; wv[k][7] = b[3]; }
        { const f32x4 a = *(const f32x4*)(F.cb() + ch), b = *(const f32x4*)(F.cb() + ch + 4); bv[0] = a[0]; bv[1] = a[1]; bv[2] = a[2]; bv[3] = a[3]; bv[4] = b[0]; bv[5] = b[1]; bv[6] = b[2]; bv[7] = b[3]; }
        const int r0 = row0 + tok0;
        const bool from_state = smp && ((tok0 & 31) == 0), zero_prev = (!smp) && (r0 == 0);
#pragma unroll
        for (int d = 0; d < 3; ++d) {
            if (zero_prev) {
#pragma unroll
                for (int e = 0; e < 8; ++e) xw[d][e] = 0.f;
            } else if (from_state) { const int b = (r0 - MP) >> 5; const float* sp = F.st_conv() + (size_t)(b * 3 + d) * DLRU + ch; const f32x4 a = *(const f32x4*)sp, c = *(const f32x4*)(sp + 4);
                xw[d][0] = a[0]; xw[d][1] = a[1]; xw[d][2] = a[2]; xw[d][3] = a[3]; xw[d][4] = c[0]; xw[d][5] = c[1]; xw[d][6] = c[2]; xw[d][7] = c[3];
            } else { const v4u q = *(const v4u*)(F.U() + (size_t)(r0 - 3 + d) * DLRU + ch);
                xw[d][0] = bflo(q.x); xw[d][1] = bfhi(q.x); xw[d][2] = bflo(q.y); xw[d][3] = bfhi(q.y); xw[d][4] = bflo(q.z); xw[d][5] = bfhi(q.z); xw[d][6] = bflo(q.w); xw[d][7] = bfhi(q.w); }
        }
#pragma unroll
        for (int t = 0; t < 8; ++t) {
            const v4u q = *(const v4u*)(F.U() + (size_t)(r0 + t) * DLRU + ch);
            float xc[8]; xc[0] = bflo(q.x); xc[1] = bfhi(q.x); xc[2] = bflo(q.y); xc[3] = bfhi(q.y); xc[4] = bflo(q.z); xc[5] = bfhi(q.z); xc[6] = bflo(q.w); xc[7] = bfhi(q.w);
            float o[8];
#pragma unroll
            for (int e = 0; e < 8; ++e) o[e] = bv[e] + ((wv[0][e] * xw[0][e] + wv[1][e] * xw[1][e]) + (wv[2][e] * xw[2][e] + wv[3][e] * xc[e]));
            LAS f32x4* dst = (LAS f32x4*)(UC + (tok0 + t) * UC_LD + 8 * cgp);
            dst[0] = (f32x4){o[0], o[1], o[2], o[3]}; dst[1] = (f32x4){o[4], o[5], o[6], o[7]};
#pragma unroll
            for (int e = 0; e < 8; ++e) { xw[0][e] = xw[1][e]; xw[1][e] = xw[2][e]; xw[2][e] = xc[e]; }
        }
    }
    team_bar(tcnt, tphase, lane);
    f32x4 pba[3], pbx[3], pc8[3]; v2u gq[3];
#pragma unroll
    for (int ct = 0; ct < 3; ++ct) { const int chg = chb + cwl + 16 * ct + 4 * fq;
        pba[ct] = *(const f32x4*)(F.b_a() + chg); pbx[ct] = *(const f32x4*)(F.b_x() + chg); pc8[ct] = *(const f32x4*)(F.C8() + chg);
        gq[ct] = *(const v2u*)(F.Gt() + (size_t)(row0 + fr) * DLRU + chg); }
    f32x4 accA[4][3], accX[4][3];
#pragma unroll
    for (int tt = 0; tt < 4; ++tt)
#pragma unroll
        for (int ct = 0; ct < 3; ++ct) { accA[tt][ct] = (f32x4){0.f, 0.f, 0.f, 0.f}; accX[tt][ct] = (f32x4){0.f, 0.f, 0.f, 0.f}; }
    const bf16* wa_base = F.Wa_t() + (size_t)blk * BD * BD + (size_t)(48 * cg + fr) * BD + 8 * fq;
    const bf16* wx_base = F.Wx_t() + (size_t)blk * BD * BD + (size_t)(48 * cg + fr) * BD + 8 * fq;
#pragma unroll 1
    for (int kb = 0; kb < 3; ++kb) {
        bf16x8 fa[2][3], fx[2][3];
#pragma unroll
        for (int kk = 0; kk < 2; ++kk)
#pragma unroll
            for (int ct = 0; ct < 3; ++ct) {
                fa[kk][ct] = __builtin_bit_cast(bf16x8, *(const v4u*)(wa_base + (size_t)(16 * ct) * BD + 32 * (2 * kb + kk)));
                fx[kk][ct] = __builtin_bit_cast(bf16x8, *(const v4u*)(wx_base + (size_t)(16 * ct) * BD + 32 * (2 * kb + kk))); }
#pragma unroll
        for (int kk = 0; kk < 2; ++kk) {
            const int ks = 2 * kb + kk;
            bf16x8 uf[4];
#pragma unroll
            for (int tt = 0; tt < 4; ++tt) { const LAS f32x4* s = (const LAS f32x4*)(UC + (16 * tt + fr) * UC_LD + 32 * ks + 8 * fq); const f32x4 a = s[0], b = s[1];
                v4u p; p.x = cvt_pk_bf16(a[0], a[1]); p.y = cvt_pk_bf16(a[2], a[3]); p.z = cvt_pk_bf16(b[0], b[1]); p.w = cvt_pk_bf16(b[2], b[3]); uf[tt] = __builtin_bit_cast(bf16x8, p); }
#pragma unroll
            for (int ct = 0; ct < 3; ++ct)
#pragma unroll
                for (int tt = 0; tt < 4; ++tt) { accA[tt][ct] = __builtin_amdgcn_mfma_f32_16x16x32_bf16(fa[kk][ct], uf[tt], accA[tt][ct], 0, 0, 0);
                                                 accX[tt][ct] = __builtin_amdgcn_mfma_f32_16x16x32_bf16(fx[kk][ct], uf[tt], accX[tt][ct], 0, 0, 0); }
        }
    }
    f32x4 carry[3], acar[3];
#pragma unroll
    for (int ct = 0; ct < 3; ++ct) { acar[ct] = (f32x4){1.f, 1.f, 1.f, 1.f};
        carry[ct] = smp ? *(const f32x4*)(F.st_h() + (size_t)(2 * (chunk - 256)) * DLRU + chb + cwl + 16 * ct + 4 * fq) : (f32x4){0.f, 0.f, 0.f, 0.f}; }
#pragma unroll
    for (int tt = 0; tt < 4; ++tt) {
        if (smp && tt == 2) {
#pragma unroll
            for (int ct = 0; ct < 3; ++ct) { acar[ct] = (f32x4){1.f, 1.f, 1.f, 1.f}; carry[ct] = *(const f32x4*)(F.st_h() + (size_t)(2 * (chunk - 256) + 1) * DLRU + chb + cwl + 16 * ct + 4 * fq); } }
        const int row = row0 + 16 * tt + fr;
        v2u gqn[3];
#pragma unroll
        for (int ct = 0; ct < 3; ++ct) gqn[ct] = (tt < 3) ? *(const v2u*)(F.Gt() + (size_t)(row + 16) * DLRU + chb + cwl + 16 * ct + 4 * fq) : (v2u){0u, 0u};
#pragma unroll
        for (int ct = 0; ct < 3; ++ct) {
            const int chg = chb + cwl + 16 * ct + 4 * fq;
            const f32x4 ba = pba[ct], bx = pbx[ct], c8 = pc8[ct];
            const f32x4 uc = *(const LAS f32x4*)(UC + (16 * tt + fr) * UC_LD + cwl + 16 * ct + 4 * fq);
            f32x4 av, bv;
#pragma unroll
            for (int p = 0; p < 2; ++p) {
                const f32x2 rg = sigmoid2((f32x2){accA[tt][ct][2 * p], accA[tt][ct][2 * p + 1]} + (f32x2){ba[2 * p], ba[2 * p + 1]});
                const f32x2 ig = sigmoid2((f32x2){accX[tt][ct][2 * p], accX[tt][ct][2 * p + 1]} + (f32x2){bx[2 * p], bx[2 * p + 1]});
                const f32x2 la2 = (f32x2){c8[2 * p], c8[2 * p + 1]} * rg;
                f32x2 a; a.x = fexp2(la2.x); a.y = fexp2(la2.y);
                const f32x2 x = la2 * (2.0f * 0.6931471805599453f);
                f32x2 omp = (x * (-1.0f)) * (1.0f + x * (0.5f + x * (0.16666667f + x * (0.041666668f + x * (0.008333334f + x * 0.0013888889f))))), omq = 1.0f - a * a;
                asm("" : "+v"(omp), "+v"(omq));
                f32x2 sq; sq.x = __builtin_amdgcn_sqrtf(x.x > -0.25f ? omp.x : omq.x); sq.y = __builtin_amdgcn_sqrtf(x.y > -0.25f ? omp.y : omq.y);
                const f32x2 b = sq * ig * (f32x2){uc[2 * p], uc[2 * p + 1]};
                av[2 * p] = a.x; av[2 * p + 1] = a.y; bv[2 * p] = b.x; bv[2 * p + 1] = b.y;
            }
            row_scan_ab4(av, bv);
            const f32x4 h = bv + av * carry[ct];
            const f32x4 hA = av * acar[ct];
            f32x4 ge; { const f32x2 g0 = gelu_tanh2((f32x2){bflo(gq[ct].x), bfhi(gq[ct].x)}), g1 = gelu_tanh2((f32x2){bflo(gq[ct].y), bfhi(gq[ct].y)}); ge = (f32x4){g0.x, g0.y, g1.x, g1.y}; }
            const f32x4 y = h * ge;
            v2u o; o.x = cvt_pk_bf16(y[0], y[1]); o.y = cvt_pk_bf16(y[2], y[3]);
            *(v2u*)(F.Y() + (size_t)row * DM + chg) = o;
            if (!smp) { const f32x4 z = hA * ge; v2u oz; oz.x = cvt_pk_bf16(z[0], z[1]); oz.y = cvt_pk_bf16(z[2], z[3]); *(v2u*)(F.Z() + (size_t)row * DLRU + chg) = oz;
                if (tt == 3 && fr == 15) { *(f32x4*)(F.AggA() + (size_t)chunk * DLRU + chg) = hA; *(f32x4*)(F.AggB() + (size_t)chunk * DLRU + chg) = h; } }
            else if (((row - MP) & 31) == 31) *(f32x4*)(F.out() + O_HS + (size_t)((row - MP) >> 5) * DLRU + chg) = h;
#pragma unroll
            for (int r = 0; r < 4; ++r) { carry[ct][r] = __shfl(h[r], (lane & 48) | 15); acar[ct][r] = __shfl(hA[r], (lane & 48) | 15); }
        }
#pragma unroll
        for (int ct = 0; ct < 3; ++ct) gq[ct] = gqn[ct];
        __builtin_amdgcn_sched_barrier(0);
    }
}
__device__ __forceinline__ void lru_prefix(Frame& F) {
    const int gw = F.vcu * NWAVES + F.wave, NGW = F.G * NWAVES, fr = F.lane & 15, fq = F.lane >> 4;
    for (int item = gw; item < DLRU / 16; item += NGW) {
        const int chg = 16 * item + 4 * fq;
        f32x4 la[16], lb[16];
#pragma unroll
        for (int i = 0; i < 16; ++i) { la[i] = *(const f32x4*)(F.AggA() + (size_t)(16 * fr + i) * DLRU + chg); lb[i] = *(const f32x4*)(F.AggB() + (size_t)(16 * fr + i) * DLRU + chg); }
        f32x4 PA = la[0], PB = lb[0];
#pragma unroll
        for (int i = 1; i < 16; ++i) { PB = la[i] * PB + lb[i]; PA = la[i] * PA; }
        f32x4 h;
#pragma unroll
        for (int r = 0; r < 4; ++r) { float a = PA[r], b = PB[r]; row_scan_ab(a, b); h[r] = dpp_shr<1>(0.0f, b); }
#pragma unroll
        for (int i = 0; i < 16; ++i) { *(f32x4*)(F.Carry() + (size_t)(16 * fr + i) * DLRU + chg) = h; h = la[i] * h + lb[i]; }
        if (fr == 15) *(f32x4*)(F.out() + O_HP + chg) = h;
    }
}

constexpr int KS_LD = 272, KS_OFF = 0, VT_OFF = 128 * KS_LD, WM_OFF = 2 * 128 * KS_LD;
constexpr float ATT_SC = 0.12751743082459868f;
constexpr float ATT_STOP = -160.0f;
__device__ __forceinline__ int vt_pos(int k) { return (k & ~31) | (((k >> 2) & 3) << 3) | (((k >> 4) & 1) << 2) | (k & 3); }
__device__ __forceinline__ void vt_store(LAS unsigned char* VT, int key, int dc, const v4u q) {
    LAS unsigned short* vp = (LAS unsigned short*)(VT + (8 * dc) * KS_LD + 2 * vt_pos(key));
    vp[0 * (KS_LD / 2)] = (unsigned short)(q.x & 0xffffu); vp[1 * (KS_LD / 2)] = (unsigned short)(q.x >> 16); vp[2 * (KS_LD / 2)] = (unsigned short)(q.y & 0xffffu); vp[3 * (KS_LD / 2)] = (unsigned short)(q.y >> 16);
    vp[4 * (KS_LD / 2)] = (unsigned short)(q.z & 0xffffu); vp[5 * (KS_LD / 2)] = (unsigned short)(q.z >> 16); vp[6 * (KS_LD / 2)] = (unsigned short)(q.w & 0xffffu); vp[7 * (KS_LD / 2)] = (unsigned short)(q.w >> 16);
}
template <bool SMP> __device__ __forceinline__ void attn_unit(Frame& F, int ui) {
    const int tid = F.tid, lane = F.lane, w = F.wave, fr = lane & 15, fq = lane >> 4;
    LAS unsigned char* KS = F.lds + RING_OFF + KS_OFF; LAS unsigned char* VT = F.lds + RING_OFF + VT_OFF; LAS float* WM = (LAS float*)(F.lds + RING_OFF + WM_OFF);
    const int h = ui & 7;
    const int qt = ui >> 3, b = (ui - 1024) >> 3;
    const int qrow0 = SMP ? MP + 32 * b : 128 * qt;
    const int nkb = SMP ? 1 + PAST / 128 : qt + 1;
    const bool active = SMP ? (w < 2) : true;
    const int qi = 16 * w + fr;
    bf16x8 qf[4];
    if (active) {
#pragma unroll
        for (int ds = 0; ds < 4; ++ds) qf[ds] = __builtin_bit_cast(bf16x8, *(const v4u*)(F.Qn() + (size_t)(qrow0 + qi) * DSB + h * HD + 32 * ds + 8 * fq));
    } else {
#pragma unroll
        for (int ds = 0; ds < 4; ++ds) qf[ds] = (bf16x8){0, 0, 0, 0, 0, 0, 0, 0};
    }
    f32x4 o[8];
#pragma unroll
    for (int dt = 0; dt < 8; ++dt) o[dt] = (f32x4){0.f, 0.f, 0.f, 0.f};
    float carry = 0.f;
    v4u pk[4], pv[4];
    f32x4 fk[SMP ? 4 : 1][2], fv[SMP ? 4 : 1][2];
    if (!SMP) {
#pragma unroll
        for (int c = 0; c < 4; ++c) { const int id = tid + 512 * c; const int krow0 = 128 * qt;
            pk[c] = *(const v4u*)(F.Kn() + (size_t)(krow0 + (id >> 4)) * DSB + h * HD + 8 * (id & 15));
            pv[c] = *(const v4u*)(F.Vb() + (size_t)(krow0 + (id & 127)) * DSB + h * HD + 8 * (id >> 7)); }
    }
    for (int j = 0; j < nkb; ++j) {
        WG_BAR();
        if (!SMP) {
#pragma unroll
            for (int c = 0; c < 4; ++c) { const int id = tid + 512 * c; *(LAS v4u*)(KS + (id >> 4) * KS_LD + 16 * (id & 15)) = pk[c]; vt_store(VT, id & 127, id >> 7, pv[c]); }
        } else if (j == 0) {
#pragma unroll
            for (int c = 0; c < 4; ++c) { const int id = tid + 512 * c;
                { const int key = id >> 4, dc = id & 15; v4u q = (v4u){0u, 0u, 0u, 0u}; if (key < 32) q = *(const v4u*)(F.Kn() + (size_t)(qrow0 + key) * DSB + h * HD + 8 * dc);
                  *(LAS v4u*)(KS + key * KS_LD + 16 * dc) = q; }
                { const int key = id & 127, dc = id >> 7; v4u q = (v4u){0u, 0u, 0u, 0u}; if (key < 32) q = *(const v4u*)(F.Vb() + (size_t)(qrow0 + key) * DSB + h * HD + 8 * dc);
                  vt_store(VT, key, dc, q); }
            }
        } else {
#pragma unroll
            for (int c = 0; c < (SMP ? 4 : 1); ++c) { const int id = tid + 512 * c;
                { const f32x4 a = fk[c][0], bb = fk[c][1]; v4u q; q.x = cvt_pk_bf16(a[0], a[1]); q.y = cvt_pk_bf16(a[2], a[3]); q.z = cvt_pk_bf16(bb[0], bb[1]); q.w = cvt_pk_bf16(bb[2], bb[3]);
                  *(LAS v4u*)(KS + (id >> 4) * KS_LD + 16 * (id & 15)) = q; }
                { const f32x4 a = fv[c][0], bb = fv[c][1]; v4u q; q.x = cvt_pk_bf16(a[0], a[1]); q.y = cvt_pk_bf16(a[2], a[3]); q.z = cvt_pk_bf16(bb[0], bb[1]); q.w = cvt_pk_bf16(bb[2], bb[3]);
                  vt_store(VT, id & 127, id >> 7, q); }
            }
        }
        WG_BAR();
        if (SMP && j + 1 < nkb) {
            const int pos0 = PAST - 128 * (j + 1);
            const float* ck = F.cache_k() + ((size_t)b * PAST + pos0) * DSB + h * HD; const float* cv = F.cache_v() + ((size_t)b * PAST + pos0) * DSB + h * HD;
#pragma unroll
            for (int c = 0; c < (SMP ? 4 : 1); ++c) { const int id = tid + 512 * c;
                { const float* p = ck + (size_t)(id >> 4) * DSB + 8 * (id & 15); fk[c][0] = __builtin_nontemporal_load((const f32x4*)p); fk[c][1] = __builtin_nontemporal_load((const f32x4*)(p + 4)); }
                { const float* p = cv + (size_t)(id & 127) * DSB + 8 * (id >> 7); fv[c][0] = __builtin_nontemporal_load((const f32x4*)p); fv[c][1] = __builtin_nontemporal_load((const f32x4*)(p + 4)); } }
        }
        if (!SMP && j + 1 < nkb) {
#pragma unroll
            for (int c = 0; c < 4; ++c) { const int id = tid + 512 * c; const int krow0 = 128 * (qt - j - 1);
                pk[c] = *(const v4u*)(F.Kn() + (size_t)(krow0 + (id >> 4)) * DSB + h * HD + 8 * (id & 15));
                pv[c] = *(const v4u*)(F.Vb() + (size_t)(krow0 + (id & 127)) * DSB + h * HD + 8 * (id >> 7)); }
        }
        float wmax = -3.0e38f;
        if (active) {
            f32x4 s[8];
            const bool diag = (j == 0);
#pragma unroll
            for (int kt = 0; kt < 8; ++kt) { s[kt] = (f32x4){0.f, 0.f, 0.f, 0.f};
                if (!(diag && kt > w))
#pragma unroll
                for (int ds = 0; ds < 4; ++ds) { const bf16x8 kf = *(const LAS bf16x8*)(KS + (16 * kt + fr) * KS_LD + 2 * (32 * ds + 8 * fq)); s[kt] = __builtin_amdgcn_mfma_f32_16x16x32_bf16(kf, qf[ds], s[kt], 0, 0, 0); } }
            float Fq[8], TT[8];
#pragma unroll
            for (int kt = 0; kt < 8; ++kt) {
                if (diag && kt > w) { s[kt] = (f32x4){-1.0e30f, -1.0e30f, -1.0e30f, -1.0e30f}; Fq[kt] = 0.f; TT[kt] = 0.f; continue; }
                f32x4 z = s[kt] * ATT_SC;
                if (diag) {
#pragma unroll
                    for (int r = 0; r < 4; ++r) z[r] = ((16 * kt + 4 * fq + r) < qi) ? z[r] : -1.0e30f; }
                f32x4 e, l, mx;
#pragma unroll
                for (int r = 0; r < 4; ++r) { e[r] = fexp2(-fabsf(z[r])); mx[r] = fmaxf(z[r], 0.f); }
                const f32x4 d = e + 1.0f;
#pragma unroll
                for (int r = 0; r < 4; ++r) l[r] = flog2(d[r]);
                const f32x4 lbv = (mx + l) * (-1.0f);
                f32x4 xsv; xsv[3] = 0.f; xsv[2] = lbv[3]; xsv[1] = lbv[3] + lbv[2]; xsv[0] = xsv[1] + lbv[1];
                const float T = xsv[0] + lbv[0];
                s[kt] = (z + lbv) + xsv;
                const float t1 = __shfl_xor(T, 16), t2 = __shfl_xor(T, 32), t3 = __shfl_xor(T, 48);
                Fq[kt] = (((fq ^ 1) > fq) ? t1 : 0.f) + (((fq ^ 2) > fq) ? t2 : 0.f) + (((fq ^ 3) > fq) ? t3 : 0.f);
                TT[kt] = (T + t1) + (t2 + t3);
            }
            float run = carry; bf16x8 pf[4];
            unsigned pw[8][2];
#pragma unroll
            for (int kt = 7; kt >= 0; --kt) {
                if (diag && kt > w) { pw[kt][0] = 0u; pw[kt][1] = 0u; continue; }
                const f32x4 arg = s[kt] + (run + Fq[kt]);
                float wv[4];
#pragma unroll
                for (int r = 0; r < 4; ++r) wv[r] = fexp2(arg[r]);
                pw[kt][0] = cvt_pk_bf16(wv[0], wv[1]); pw[kt][1] = cvt_pk_bf16(wv[2], wv[3]);
                run += TT[kt];
            }
            carry = run;
#pragma unroll
            for (int sI = 0; sI < 4; ++sI) { v4u p; p.x = pw[2 * sI][0]; p.y = pw[2 * sI][1]; p.z = pw[2 * sI + 1][0]; p.w = pw[2 * sI + 1][1]; pf[sI] = __builtin_bit_cast(bf16x8, p); }
#pragma unroll
            for (int dt = 0; dt < 8; ++dt)
#pragma unroll
                for (int sI = 0; sI < 4; ++sI) { if (!(diag && 2 * sI > w)) { const bf16x8 vf = *(const LAS bf16x8*)(VT + (16 * dt + fr) * KS_LD + 2 * (32 * sI + 8 * fq)); o[dt] = __builtin_amdgcn_mfma_f32_16x16x32_bf16(vf, pf[sI], o[dt], 0, 0, 0); } }
            wmax = carry;
#pragma unroll
            for (int off = 1; off < 16; off <<= 1) wmax = fmaxf(wmax, __shfl_xor(wmax, off));
        }
        if (lane == 0) WM[w] = wmax;
        WG_BAR();
        float mx = WM[0];
#pragma unroll
        for (int k = 1; k < 8; ++k) mx = fmaxf(mx, WM[k]);
        if (mx < ATT_STOP) break;
    }
    if (active) {
        const int row = qrow0 + qi;
        float ss = 0.f;
#pragma unroll
        for (int dt = 0; dt < 8; ++dt) ss += (o[dt][0] * o[dt][0] + o[dt][1] * o[dt][1]) + (o[dt][2] * o[dt][2] + o[dt][3] * o[dt][3]);
        ss += __shfl_xor(ss, 16); ss += __shfl_xor(ss, 32);
        if (fq == 0) F.SsqS()[(size_t)row * 8 + h] = ss;
#pragma unroll
        for (int dt = 0; dt < 8; ++dt) { const int d = 16 * dt + 4 * fq; const f32x4 gv = *(const f32x4*)(F.g_sb() + h * HD + d); const f32x4 y = o[dt] * gv;
            v2u q; q.x = cvt_pk_bf16(y[0], y[1]); q.y = cvt_pk_bf16(y[2], y[3]); *(v2u*)(F.Y() + (size_t)row * DM + DLRU + h * HD + d) = q; }
    }
}

__device__ __forceinline__ void mix_row_plain(Frame& F, int m, int lane) {
    {
        GAS v4u* yr = (GAS v4u*)(F.Y() + (size_t)m * DM);
        float y[6][8]; float ss = 0.f;
#pragma unroll
        for (int j = 0; j < 6; ++j) { const int ci = lane + 64 * j; const v4u q = yr[ci];
            y[j][0] = bflo(q.x); y[j][1] = bfhi(q.x); y[j][2] = bflo(q.y); y[j][3] = bfhi(q.y); y[j][4] = bflo(q.z); y[j][5] = bfhi(q.z); y[j][6] = bflo(q.w); y[j][7] = bfhi(q.w);
            if (m < MP) { const v4u z = __builtin_nontemporal_load((const GAS v4u*)(F.Z() + (size_t)m * DLRU) + ci); const float* cp = F.Carry() + (size_t)(m >> 6) * DLRU + 8 * ci; const f32x4 c0 = *(const f32x4*)cp, c1 = *(const f32x4*)(cp + 4);
                y[j][0] += bflo(z.x) * c0[0]; y[j][1] += bfhi(z.x) * c0[1]; y[j][2] += bflo(z.y) * c0[2]; y[j][3] += bfhi(z.y) * c0[3]; y[j][4] += bflo(z.z) * c1[0]; y[j][5] += bfhi(z.z) * c1[1]; y[j][6] += bflo(z.w) * c1[2]; y[j][7] += bfhi(z.w) * c1[3]; }
#pragma unroll
            for (int e = 0; e < 8; ++e) ss += y[j][e] * y[j][e]; }
        const f32x4 b0 = *(const f32x4*)(F.SsqS() + (size_t)m * 8), b1 = *(const f32x4*)(F.SsqS() + (size_t)m * 8 + 4);
        const float ssb = 1.0f / sqrtf((((b0[0] + b0[1]) + (b0[2] + b0[3])) + ((b1[0] + b1[1]) + (b1[2] + b1[3]))) * (1.0f / DSB) + EPS);
        const float sl = 1.0f / sqrtf(wave_sum(ss) * (1.0f / DLRU) + EPS);
#pragma unroll
        for (int j = 0; j < 6; ++j) { const int ci = lane + 64 * j; v4u q; const f32x4 g0 = *(const f32x4*)(F.g_lru() + 8 * ci) * sl, g1 = *(const f32x4*)(F.g_lru() + 8 * ci + 4) * sl;
            q.x = cvt_pk_bf16(y[j][0] * g0[0], y[j][1] * g0[1]); q.y = cvt_pk_bf16(y[j][2] * g0[2], y[j][3] * g0[3]); q.z = cvt_pk_bf16(y[j][4] * g1[0], y[j][5] * g1[1]); q.w = cvt_pk_bf16(y[j][6] * g1[2], y[j][7] * g1[3]); yr[ci] = q; }
#pragma unroll
        for (int j = 6; j < 8; ++j) { const int ci = lane + 64 * j; v4u q = yr[ci];
            q.x = cvt_pk_bf16(bflo(q.x) * ssb, bfhi(q.x) * ssb); q.y = cvt_pk_bf16(bflo(q.y) * ssb, bfhi(q.y) * ssb); q.z = cvt_pk_bf16(bflo(q.z) * ssb, bfhi(q.z) * ssb); q.w = cvt_pk_bf16(bflo(q.w) * ssb, bfhi(q.w) * ssb); yr[ci] = q; }
    }
}
__device__ __forceinline__ void mix_rows(Frame& F) {
    const int gw = F.vcu * NWAVES + F.wave, NGW = F.G * NWAVES;
    for (int m = gw; m < M; m += NGW) mix_row_plain(F, m, F.lane);
}
__device__ __forceinline__ void mix_row_sample(Frame& F, int m, int lane) {
    GAS v4u* yr = (GAS v4u*)(F.Y() + (size_t)m * DM) + lane;
    v4u q[8]; f32x4 g[6][2];
#pragma unroll
    for (int j = 0; j < 8; ++j) q[j] = yr[64 * j];
    const f32x4 b0 = *(const f32x4*)(F.SsqS() + (size_t)m * 8), b1 = *(const f32x4*)(F.SsqS() + (size_t)m * 8 + 4);
#pragma unroll
    for (int j = 0; j < 6; ++j) { g[j][0] = *(const f32x4*)(F.g_lru() + 8 * (lane + 64 * j)); g[j][1] = *(const f32x4*)(F.g_lru() + 8 * (lane + 64 * j) + 4); }
    float ss = 0.f;
#pragma unroll
    for (int j = 0; j < 6; ++j) { const float a0 = bflo(q[j].x), a1 = bfhi(q[j].x), a2 = bflo(q[j].y), a3 = bfhi(q[j].y), a4 = bflo(q[j].z), a5 = bfhi(q[j].z), a6 = bflo(q[j].w), a7 = bfhi(q[j].w);
        ss += ((a0 * a0 + a1 * a1) + (a2 * a2 + a3 * a3)) + ((a4 * a4 + a5 * a5) + (a6 * a6 + a7 * a7)); }
    const float ssb = 1.0f / sqrtf((((b0[0] + b0[1]) + (b0[2] + b0[3])) + ((b1[0] + b1[1]) + (b1[2] + b1[3]))) * (1.0f / DSB) + EPS);
    const float sl = 1.0f / sqrtf(wave_sum(ss) * (1.0f / DLRU) + EPS);
#pragma unroll
    for (int j = 0; j < 6; ++j) { const f32x4 g0 = g[j][0] * sl, g1 = g[j][1] * sl; v4u o;
        o.x = cvt_pk_bf16(bflo(q[j].x) * g0[0], bfhi(q[j].x) * g0[1]); o.y = cvt_pk_bf16(bflo(q[j].y) * g0[2], bfhi(q[j].y) * g0[3]);
        o.z = cvt_pk_bf16(bflo(q[j].z) * g1[0], bfhi(q[j].z) * g1[1]); o.w = cvt_pk_bf16(bflo(q[j].w) * g1[2], bfhi(q[j].w) * g1[3]); yr[64 * j] = o; }
#pragma unroll
    for (int j = 6; j < 8; ++j) { v4u o = q[j];
        o.x = cvt_pk_bf16(bflo(o.x) * ssb, bfhi(o.x) * ssb); o.y = cvt_pk_bf16(bflo(o.y) * ssb, bfhi(o.y) * ssb); o.z = cvt_pk_bf16(bflo(o.z) * ssb, bfhi(o.z) * ssb); o.w = cvt_pk_bf16(bflo(o.w) * ssb, bfhi(o.w) * ssb); yr[64 * j] = o; }
}
__device__ __forceinline__ void mix_rows_chunk(Frame& F) {
    const int lane = F.lane, c = F.vcu;
    LAS f32x4* cl = (LAS f32x4*)(F.lds + RING_OFF);
    LAS f32x4* gl = cl + 768;
    int m = c * 64 + F.wave * 8;
    v4u ya[8], za[6], yb[8], zb[6]; f32x4 sa[2], sb[2];
#define MX_LOAD(YQ, ZQ, SQ, mm) do { const GAS v4u* _y = (const GAS v4u*)(F.Y() + (size_t)(mm) * DM) + lane; const GAS v4u* _z = (const GAS v4u*)(F.Z() + (size_t)(mm) * DLRU) + lane; \
        _Pragma("unroll") for (int j = 0; j < 8; ++j) YQ[j] = _y[64 * j]; _Pragma("unroll") for (int j = 0; j < 6; ++j) ZQ[j] = __builtin_nontemporal_load(_z + 64 * j); \
        SQ[0] = *(const GAS f32x4*)(F.SsqS() + (size_t)(mm) * 8); SQ[1] = *(const GAS f32x4*)(F.SsqS() + (size_t)(mm) * 8 + 4); } while (0)
#define MX_FIN(YQ, ZQ, SQ, mm) do { LAS f32x4* _c = cl + 2 * lane; LAS f32x4* _g = gl + 2 * lane; asm volatile("" : "+v"(_c), "+v"(_g)); \
        float yv[6][8]; float ss = 0.f; \
        _Pragma("unroll") for (int j = 0; j < 6; ++j) { const f32x4 c0 = _c[128 * j], c1 = _c[128 * j + 1]; \
            yv[j][0] = bflo(YQ[j].x) + bflo(ZQ[j].x) * c0[0]; yv[j][1] = bfhi(YQ[j].x) + bfhi(ZQ[j].x) * c0[1]; yv[j][2] = bflo(YQ[j].y) + bflo(ZQ[j].y) * c0[2]; yv[j][3] = bfhi(YQ[j].y) + bfhi(ZQ[j].y) * c0[3]; \
            yv[j][4] = bflo(YQ[j].z) + bflo(ZQ[j].z) * c1[0]; yv[j][5] = bfhi(YQ[j].z) + bfhi(ZQ[j].z) * c1[1]; yv[j][6] = bflo(YQ[j].w) + bflo(ZQ[j].w) * c1[2]; yv[j][7] = bfhi(YQ[j].w) + bfhi(ZQ[j].w) * c1[3]; \
            _Pragma("unroll") for (int e = 0; e < 8; ++e) ss += yv[j][e] * yv[j][e]; } \
        const float ssb = 1.0f / sqrtf((((SQ[0][0] + SQ[0][1]) + (SQ[0][2] + SQ[0][3])) + ((SQ[1][0] + SQ[1][1]) + (SQ[1][2] + SQ[1][3]))) * (1.0f / DSB) + EPS); \
        const float sl = 1.0f / sqrtf(wave_sum(ss) * (1.0f / DLRU) + EPS); \
        GAS v4u* _o = (GAS v4u*)(F.Y() + (size_t)(mm) * DM) + lane; \
        _Pragma("unroll") for (int j = 0; j < 6; ++j) { const f32x4 g0 = _g[128 * j] * sl, g1 = _g[128 * j + 1] * sl; v4u q; \
            q.x = cvt_pk_bf16(yv[j][0] * g0[0], yv[j][1] * g0[1]); q.y = cvt_pk_bf16(yv[j][2] * g0[2], yv[j][3] * g0[3]); q.z = cvt_pk_bf16(yv[j][4] * g1[0], yv[j][5] * g1[1]); q.w = cvt_pk_bf16(yv[j][6] * g1[2], yv[j][7] * g1[3]); _o[64 * j] = q; } \
        _Pragma("unroll") for (int j = 6; j < 8; ++j) { v4u q = YQ[j]; \
            q.x = cvt_pk_bf16(bflo(q.x) * ssb, bfhi(q.x) * ssb); q.y = cvt_pk_bf16(bflo(q.y) * ssb, bfhi(q.y) * ssb); q.z = cvt_pk_bf16(bflo(q.z) * ssb, bfhi(q.z) * ssb); q.w = cvt_pk_bf16(bflo(q.w) * ssb, bfhi(q.w) * ssb); _o[64 * j] = q; } } while (0)
    MX_LOAD(ya, za, sa, m); __builtin_amdgcn_sched_barrier(0);
    for (int i = F.tid; i < 768; i += NWAVES * 64) { cl[i] = ((const GAS f32x4*)(F.Carry() + (size_t)c * DLRU))[i]; gl[i] = ((const GAS f32x4*)F.g_lru())[i]; }
    WG_BAR();
    for (int k = 0; k < 3; ++k) { MX_LOAD(yb, zb, sb, m + 1); __builtin_amdgcn_sched_barrier(0); MX_FIN(ya, za, sa, m); __builtin_amdgcn_sched_barrier(0);
                                  MX_LOAD(ya, za, sa, m + 2); __builtin_amdgcn_sched_barrier(0); MX_FIN(yb, zb, sb, m + 1); __builtin_amdgcn_sched_barrier(0); m += 2; }
    MX_LOAD(yb, zb, sb, m + 1); __builtin_amdgcn_sched_barrier(0); MX_FIN(ya, za, sa, m); __builtin_amdgcn_sched_barrier(0); MX_FIN(yb, zb, sb, m + 1);
#undef MX_LOAD
#undef MX_FIN
    for (int ms = MP + F.wave * F.G + F.vcu; ms < M; ms += F.G * NWAVES) mix_row_sample(F, ms, lane);
}
__device__ __forceinline__ void act_pass(Frame& F, int hf) {
    const int gt = F.vcu * (NWAVES * 64) + F.tid, NGT = F.G * NWAVES * 64;
    constexpr int NFG = DFF / 2 / 8, NRB = M / 32;
    for (int it = gt; it < NFG * NRB; it += NGT) {
        const int fg = it % NFG, rb = it / NFG, pnl = fg >> 4, wi = (fg & 15) * 8, vcol = 256 * pnl + wi, f = (DFF / 2) * hf + 128 * pnl + wi, r0 = 32 * rb;
        float w0[8], w1[8], w2[8], cbv[8], p2[8], p1[8];
        { const f32x4 a = *(const f32x4*)(F.fcw() + f), b = *(const f32x4*)(F.fcw() + f + 4); w0[0] = a[0]; w0[1] = a[1]; w0[2] = a[2]; w0[3] = a[3]; w0[4] = b[0]; w0[5] = b[1]; w0[6] = b[2]; w0[7] = b[3]; }
        { const f32x4 a = *(const f32x4*)(F.fcw() + DFF + f), b = *(const f32x4*)(F.fcw() + DFF + f + 4); w1[0] = a[0]; w1[1] = a[1]; w1[2] = a[2]; w1[3] = a[3]; w1[4] = b[0]; w1[5] = b[1]; w1[6] = b[2]; w1[7] = b[3]; }
        { const f32x4 a = *(const f32x4*)(F.fcw() + 2 * DFF + f), b = *(const f32x4*)(F.fcw() + 2 * DFF + f + 4); w2[0] = a[0]; w2[1] = a[1]; w2[2] = a[2]; w2[3] = a[3]; w2[4] = b[0]; w2[5] = b[1]; w2[6] = b[2]; w2[7] = b[3]; }
        { const f32x4 a = *(const f32x4*)(F.fcb() + f), b = *(const f32x4*)(F.fcb() + f + 4); cbv[0] = a[0]; cbv[1] = a[1]; cbv[2] = a[2]; cbv[3] = a[3]; cbv[4] = b[0]; cbv[5] = b[1]; cbv[6] = b[2]; cbv[7] = b[3]; }
        if (r0 >= MP) { const int b = (r0 - MP) >> 5; const float* s0 = F.st_ffn() + (size_t)(b * 2) * DFF + f; const float* s1 = s0 + DFF;
            const f32x4 a = *(const f32x4*)s0, c = *(const f32x4*)(s0 + 4), d = *(const f32x4*)s1, e = *(const f32x4*)(s1 + 4);
            p2[0] = a[0]; p2[1] = a[1]; p2[2] = a[2]; p2[3] = a[3]; p2[4] = c[0]; p2[5] = c[1]; p2[6] = c[2]; p2[7] = c[3];
            p1[0] = d[0]; p1[1] = d[1]; p1[2] = d[2]; p1[3] = d[3]; p1[4] = e[0]; p1[5] = e[1]; p1[6] = e[2]; p1[7] = e[3];
        } else if (r0 == 0) {
#pragma unroll
            for (int e = 0; e < 8; ++e) { p2[e] = 0.f; p1[e] = 0.f; }
        } else { const v4u a = *(const v4u*)(F.VALPRE() + (size_t)(r0 - 2) * DFF + vcol + 128), b = *(const v4u*)(F.VALPRE() + (size_t)(r0 - 1) * DFF + vcol + 128);
            p2[0] = bflo(a.x); p2[1] = bfhi(a.x); p2[2] = bflo(a.y); p2[3] = bfhi(a.y); p2[4] = bflo(a.z); p2[5] = bfhi(a.z); p2[6] = bflo(a.w); p2[7] = bfhi(a.w);
            p1[0] = bflo(b.x); p1[1] = bfhi(b.x); p1[2] = bflo(b.y); p1[3] = bfhi(b.y); p1[4] = bflo(b.z); p1[5] = bfhi(b.z); p1[6] = bflo(b.w); p1[7] = bfhi(b.w); }
#pragma unroll 4
        for (int t = 0; t < 32; ++t) { const int row = r0 + t;
            const v4u pq = *(const v4u*)(F.VALPRE() + (size_t)row * DFF + vcol + 128), vq = *(const v4u*)(F.VALPRE() + (size_t)row * DFF + vcol);
            float pc[8], vv[8], o[8];
            pc[0] = bflo(pq.x); pc[1] = bfhi(pq.x); pc[2] = bflo(pq.y); pc[3] = bfhi(pq.y); pc[4] = bflo(pq.z); pc[5] = bfhi(pq.z); pc[6] = bflo(pq.w); pc[7] = bfhi(pq.w);
            vv[0] = bflo(vq.x); vv[1] = bfhi(vq.x); vv[2] = bflo(vq.y); vv[3] = bfhi(vq.y); vv[4] = bflo(vq.z); vv[5] = bfhi(vq.z); vv[6] = bflo(vq.w); vv[7] = bfhi(vq.w);
#pragma unroll
            for (int e = 0; e < 8; ++e) { const float c = cbv[e] + (w0[e] * p2[e] + w1[e] * p1[e]) + w2[e] * pc[e]; o[e] = gelu_tanh(c) * vv[e]; p2[e] = p1[e]; p1[e] = pc[e]; }
            v4u q; q.x = cvt_pk_bf16(o[0], o[1]); q.y = cvt_pk_bf16(o[2], o[3]); q.z = cvt_pk_bf16(o[4], o[5]); q.w = cvt_pk_bf16(o[6], o[7]);
            *(v4u*)(F.ACT() + (size_t)row * DFF + f) = q;
            float* fdst = nullptr;
            if (row < MP) { if (row >= MP - 2) fdst = F.out() + O_FP + (size_t)(row - (MP - 2)) * DFF + f; }
            else { const int tt = (row - MP) & 31; if (tt >= 30) fdst = F.out() + O_FS + (size_t)(((row - MP) >> 5) * 2 + (tt - 30)) * DFF + f; }
            if (fdst) { *(f32x4*)fdst = (f32x4){pc[0], pc[1], pc[2], pc[3]}; *(f32x4*)(fdst + 4) = (f32x4){pc[4], pc[5], pc[6], pc[7]}; }
        }
    }
}

__device__ __forceinline__ void ffn_fixup(Frame& F) {
    const int gt = F.vcu * (NWAVES * 64) + F.tid, NGT = F.G * NWAVES * 64;
    constexpr int NF4 = DFF / 4, NITEM = (MP / 256 - 1) * 2 * NF4;
    for (int it0 = gt; it0 < NITEM; it0 += 3 * NGT) {
        f32x4 c[3], v[3], H1[3], H0[3], w0[3], w1[3];
#pragma unroll
        for (int k = 0; k < 3; ++k) { const int it = min(it0 + k * NGT, NITEM - 1); const int f = 4 * (it % NF4), q = it / NF4, rr = q & 1, pm = 1 + (q >> 1);
            c[k] = *(const f32x4*)(F.DefC() + ((size_t)pm * 2 + rr) * DFF + f); v[k] = *(const f32x4*)(F.DefV() + ((size_t)pm * 2 + rr) * DFF + f);
            H1[k] = *(const f32x4*)(F.Halo() + ((size_t)(pm - 1) * 2 + 1) * DFF + f); H0[k] = *(const f32x4*)(F.Halo() + ((size_t)(pm - 1) * 2 + 0) * DFF + f);
            w0[k] = *(const f32x4*)(F.fcw() + f); w1[k] = *(const f32x4*)(F.fcw() + DFF + f); }
#pragma unroll
        for (int k = 0; k < 3; ++k) { const int it = it0 + k * NGT; if (it >= NITEM) break; const int f = 4 * (it % NF4), q = it / NF4, rr = q & 1, pm = 1 + (q >> 1);
            const f32x4 cc = rr == 0 ? c[k] + (w1[k] * H1[k] + w0[k] * H0[k]) : c[k] + w0[k] * H1[k];
            v2u o; o.x = cvt_pk_bf16(gelu_tanh(cc[0]) * v[k][0], gelu_tanh(cc[1]) * v[k][1]); o.y = cvt_pk_bf16(gelu_tanh(cc[2]) * v[k][2], gelu_tanh(cc[3]) * v[k][3]);
            *(v2u*)(F.ACT() + (size_t)(256 * pm + rr) * DFF + f) = o; }
    }
}

template <int RPW> __device__ __forceinline__ void sample_rows_norm(Frame& F) {
    const int lane = F.lane, w = F.wave;
    LAS float* xs = (LAS float*)(F.lds + RING_OFF + NWAVES * TR_WAVE_BYTES);
    f32x4 v[RPW][2];
#pragma unroll
    for (int rr = 0; rr < RPW; ++rr) { const int r = F.vcu * RPW + rr, c4 = w * 128 + lane;
        const GAS f32x4* bp = (const GAS f32x4*)(F.x_s() + (size_t)r * DM) + c4; f32x4 p[8][2];
        v[rr][0] = bp[0]; v[rr][1] = bp[64];
#pragma unroll
        for (int ks = 0; ks < 8; ++ks) { const GAS f32x4* pr = (const GAS f32x4*)(F.Part() + ((size_t)ks * MS + r) * DM) + c4; p[ks][0] = pr[0]; p[ks][1] = pr[64]; }
#pragma unroll
        for (int ks = 0; ks < 8; ++ks) { v[rr][0] = v[rr][0] + p[ks][0]; v[rr][1] = v[rr][1] + p[ks][1]; }
        GAS f32x4* dp = (GAS f32x4*)(F.out() + O_Y + (size_t)(MP + r) * DM) + c4; dp[0] = v[rr][0]; dp[64] = v[rr][1];
        float sq = 0.f;
#pragma unroll
        for (int j = 0; j < 2; ++j) sq += (v[rr][j].x * v[rr][j].x + v[rr][j].y * v[rr][j].y) + (v[rr][j].z * v[rr][j].z + v[rr][j].w * v[rr][j].w);
        sq = wave_sum(sq); if (lane == 0) xs[rr * 8 + w] = sq; }
    WG_BAR();
#pragma unroll
    for (int rr = 0; rr < RPW; ++rr) { const int r = F.vcu * RPW + rr, c4 = w * 128 + lane;
        float tot = 0.f;
#pragma unroll
        for (int k = 0; k < 8; ++k) tot += xs[rr * 8 + k];
        const float rsn = 1.0f / sqrtf(tot * (1.0f / DM) + EPS);
        const GAS f32x4* gr = (const GAS f32x4*)F.g_ffn() + c4; GAS v2u* o8 = (GAS v2u*)(F.BUFA() + (size_t)(MP + r) * DM) + c4;
#pragma unroll
        for (int j = 0; j < 2; ++j) { const f32x4 gv = gr[64 * j]; const f32x4 x = v[rr][j]; v2u o; o.x = cvt_pk_bf16(x.x * rsn * gv.x, x.y * rsn * gv.y); o.y = cvt_pk_bf16(x.z * rsn * gv.z, x.w * rsn * gv.w); o8[64 * j] = o; } }
}
__device__ __forceinline__ void sample_rows_final(Frame& F) {
    const int gw = F.vcu * NWAVES + F.wave, NGW = F.G * NWAVES;
    int lane = (int)threadIdx.x; asm volatile("" : "+v"(lane)); lane &= 63;
    for (int it = gw; it < MS * 4; it += NGW) {
        const int r = it >> 2, c4 = (it & 3) * 256 + lane;
        GAS f32x4* yr = (GAS f32x4*)(F.out() + O_Y + (size_t)(MP + r) * DM) + c4;
        f32x4 v[4], p[8][4];
#pragma unroll
        for (int j = 0; j < 4; ++j) v[j] = yr[64 * j];
#pragma unroll
        for (int ks = 0; ks < 8; ++ks) { const GAS f32x4* pr = (const GAS f32x4*)(F.Part() + ((size_t)ks * MS + r) * DM) + c4;
#pragma unroll
            for (int j = 0; j < 4; ++j) p[ks][j] = pr[64 * j]; }
#pragma unroll
        for (int ks = 0; ks < 8; ++ks)
#pragma unroll
            for (int j = 0; j < 4; ++j) v[j] = v[j] + p[ks][j];
#pragma unroll
        for (int j = 0; j < 4; ++j) yr[64 * j] = v[j];
    }
}

constexpr int NPH = 11;
__global__ void __launch_bounds__(NWAVES * 64, 2) hymba_fwd(Args args) {
    extern __shared__ __attribute__((aligned(16))) unsigned char lds[];
    Frame F;
    F.lds = (LAS unsigned char*)lds;
    F.MISC = (volatile LAS unsigned*)(F.lds + MISC_OFF);
    F.tid = threadIdx.x; F.lane = F.tid & 63; F.wave = __builtin_amdgcn_readfirstlane(F.tid >> 6);
    F.G = gridDim.x; { const int bx = blockIdx.x; F.vcu = (F.G % 8 == 0) ? (bx % 8) * (F.G / 8) + bx / 8 : bx; }
    F.a = &args;
    F.ctl = (gu32*)(args.ws + WS_CTL);
    for (int u = F.tid; u < (LDS_BYTES - LDSCTL_OFF) / 4; u += NWAVES * 64) ((LAS unsigned*)(F.lds + LDSCTL_OFF))[u] = 0u;
    __syncthreads();
    XcdBarrier bar; bar.bar = (unsigned*)(F.ctl + CW_BAR); bar.x = 0; bar.st = nullptr;
    if (!MK_PER_PHASE) bar = xcd_barrier_post((unsigned*)(F.ctl + CW_BAR), F.MISC + 8);
#define GRID_BAR(seam) do { if (MK_PER_PHASE) { if (F.tid == 0) __hip_atomic_store(F.ctl + CW_TMO, 0xBADBA0u | (unsigned)(seam), RLX_AGENT); } else { xcd_barrier(bar); } } while (0)
    const int lo = args.ph_lo, hi = args.ph_hi;
#ifndef PH_MASK
#define PH_MASK 0xFFFF
#endif
#define IN(k) (((PH_MASK >> (k)) & 1) && lo <= (k) && (k) < hi)
#define BOTH(k) (IN(k) && IN((k) + 1))
#ifndef REP_MASK
#define REP_MASK 0
#endif
#define REP2(k) if constexpr (((REP_MASK >> (k)) & 1) != 0)
    LAS float* EPI = (LAS float*)(F.lds + EPI_OFF);

    if (IN(0)) { p0_prologue(F); REP2(0) p0_prologue(F); if (BOTH(0)) GRID_BAR(0); }
    if (IN(1)) {
        const int nconv = (F.G >= 8 * NCONV) ? NCONV : 0, gc = F.G - nconv;
        if ((int)blockIdx.x < gc) {
            pg8::Gemm g{F.BUFA(), F.Win_t(), M, DIN, DM}; pg8::StaticOrder S; S.init(M, DIN, gc, (int)blockIdx.x, DM / 64);
            Epi1 E{F.U(), F.Gt(), F.Qn(), F.Kn(), F.Vb(), F.out(), F.qg(), F.kg(), EPI};
            pg8::gemm_phase<Epi1, pg8::StaticOrder, true, true>(F.lds + RING_OFF, g, S, E);
        }
        conv_queue<false>(F);
        if (BOTH(1)) GRID_BAR(1);
    }
    if (IN(2)) {
        { LAS unsigned* tcnt = (LAS unsigned*)(F.lds + LDSCTL_OFF) + 16 * (F.wave >> 2); unsigned tphase = 0;
          if (F.G == 256) {
              for (int u = F.vcu * 2 + (F.wave >> 2); u < 256 * 16; u += 2 * F.G) lru_unit(F, u >> 4, u & 15, tcnt, tphase);
              if ((F.vcu & 3) == 0) { const int u = 256 * 16 + (F.vcu >> 2) * 2 + (F.wave >> 2); lru_unit(F, u >> 4, u & 15, tcnt, tphase); }
          } else for (int u = F.vcu * 2 + (F.wave >> 2); u < 264 * 16; u += 2 * F.G) lru_unit(F, u >> 4, u & 15, tcnt, tphase); }
        WG_BAR();
        for (int u = F.vcu; u < 1024; u += F.G) attn_unit<false>(F, u);
        if (F.G == 256) { if ((F.vcu & 3) == 1 || (F.vcu & 3) == 2) attn_unit<true>(F, 1024 + (F.vcu >> 2) * 2 + (F.vcu & 3) - 1); }
        else if (F.G >= 192) { if (F.vcu >= 64 && F.vcu < 192) attn_unit<true>(F, 1024 + F.vcu - 64); }
        else for (int u = 1024 + F.vcu; u < 1152; u += F.G) attn_unit<true>(F, u);
        if (BOTH(2)) GRID_BAR(2);
    }
    if (IN(3)) { lru_prefix(F); if (BOTH(3)) GRID_BAR(3); }
    if (IN(4)) { if (F.G == MP / 64) mix_rows_chunk(F); else mix_rows(F); if (BOTH(4)) GRID_BAR(4); }
    if (IN(5)) {
        pg8::Gemm g{F.Y(), F.Wout_t(), M, DM, DM}; pg8::StaticOrder S; S.init(MP, DM, F.G, (int)blockIdx.x, DM / 64, 8);
        EpiRes<0> E{F.x_p(), F.X1(), F.out(), F.Part()};
        pg8::gemm_phase<EpiRes<0>, pg8::StaticOrder, true, true>(F.lds + RING_OFF, g, S, E);
        if (BOTH(5)) GRID_BAR(5);
    }
    if (IN(6)) {
        const int gw = F.vcu * NWAVES + F.wave, NGW = F.G * NWAVES;
        hn2_rows(F);
        if (F.G * 2 == MS) sample_rows_norm<2>(F);
        else for (int r = gw; r < MS; r += NGW) sample_row_reduce(F.x_s() + (size_t)r * DM, F.Part(), r, F.out() + O_Y + (size_t)(MP + r) * DM, F.g_ffn(), F.BUFA() + (size_t)(MP + r) * DM, F.lane);
        if (BOTH(6)) GRID_BAR(6);
    }
    if (IN(7)) {
        pg8::Gemm g{F.BUFA(), F.Wup_t(), M, 2 * DFF, DM}; pg8::StaticOrder S; S.init(M, 2 * DFF, F.G, (int)blockIdx.x, DM / 64);
        EpiUp E{F.ACT(), F.fcw(), F.fcb(), F.st_ffn(), F.out(), F.Halo(), F.DefC(), F.DefV(), EPI};
        pg8::gemm_phase<EpiUp, pg8::StaticOrder, true, true>(F.lds + RING_OFF, g, S, E);
        conv_queue<true>(F);
        if (BOTH(7)) GRID_BAR(7);
    }
    if (IN(8)) { ffn_fixup(F); if (BOTH(8)) GRID_BAR(8); }
    if (IN(9)) {
        pg8::Gemm g{F.ACT(), F.Wdown_t(), M, DM, DFF}; pg8::StaticOrder S; S.init(MP, DM, F.G, (int)blockIdx.x, DFF / 64, 8);
        EpiRes<1> E{F.x_p(), F.X1(), F.out(), F.Part()};
        pg8::gemm_phase<EpiRes<1>, pg8::StaticOrder, true, true>(F.lds + RING_OFF, g, S, E);
        if (BOTH(9)) GRID_BAR(9);
    }
    if (IN(10)) sample_rows_final(F);
#undef IN
#undef BOTH
}

extern "C" void kernel_launch(void* const* d_in, const int* in_sizes, int n_in, void* d_out, int out_size, void* d_ws, size_t ws_size, hipStream_t stream) {
    static int grid = 0;
    if (grid == 0) {
        if (n_in != 26 || out_size != (int)O_END || ws_size < WS_END) { fprintf(stderr, "kernel_launch: unexpected shapes (n_in %d, out %d, ws %zu); nothing launched\n", n_in, out_size, ws_size); grid = -1; return; }
        int dev = 0, cus = 0, per_cu = 0;
        if (hipGetDevice(&dev) != hipSuccess || hipDeviceGetAttribute(&cus, hipDeviceAttributeMultiprocessorCount, dev) != hipSuccess) { grid = -1; return; }
        if (hipFuncSetAttribute((const void*)hymba_fwd, hipFuncAttributeMaxDynamicSharedMemorySize, LDS_BYTES) != hipSuccess) { fprintf(stderr, "kernel_launch: hipFuncSetAttribute failed\n"); grid = -1; return; }
        if (hipOccupancyMaxActiveBlocksPerMultiprocessor(&per_cu, (const void*)hymba_fwd, NWAVES * 64, LDS_BYTES) != hipSuccess || per_cu < 1) { fprintf(stderr, "kernel_launch: occupancy query reports %d blocks per CU\n", per_cu); }
        (void)hipGetLastError();
        grid = cus;
        if (MK_GRID) grid = MK_GRID;
    }
    if (grid < 0) return;
    if (hipMemsetAsync((char*)d_ws + WS_CTL, 0, CTL_ZERO_BYTES, stream) != hipSuccess) return;
    Args a{};
    for (int i = 0; i < 26; ++i) a.in[i] = (const float*)d_in[i];
    a.out = (float*)d_out; a.ws = (unsigned char*)d_ws;
    const int nl = MK_PER_PHASE ? NPH : 1;
    for (int li = 0; li < nl; ++li) {
        a.ph_lo = MK_PER_PHASE ? li : 0; a.ph_hi = MK_PER_PHASE ? li + 1 : NPH; a.li = li;
        hipLaunchKernelGGL(hymba_fwd, dim3(grid), dim3(NWAVES * 64), LDS_BYTES, stream, a);
        const hipError_t le = hipPeekAtLastError();
        if (le != hipSuccess) { fprintf(stderr, "kernel_launch: launch %d failed: %s\n", li, hipGetErrorName(le)); break; }
    }
}
```
